# Optimizing an MI355X kernel written in HIP

```python
import math
import jax, jax.numpy as jnp
from jax import lax
import numpy as np

D_MODEL = 1024
BATCH = 2
SEQ = 16384
DEPTH = 1

GRID_W = 64
CTX_LEN = 256
N_ADA = 9
FFN_HIDDEN = 2816
D_HYENA = 512
HYENA_N_PROJ = 3
SHORT_CONV_W = 3
FILTER_EMB_BANDS = 16
FILTER_EMB_DIM = 1 + 2 * FILTER_EMB_BANDS
FILTER_HIDDEN = 64
FILTER_INNER = 2
FILTER_OUT_SCALE = 0.02 * FILTER_HIDDEN ** -0.5
DECAY_TARGET = 1e-2
FAST_DECAY_PCT = 0.3
SLOW_DECAY_PCT = 1.5
N_DIFF_HEADS = 4
DIFF_HEAD_DIM = 64
D_DIFF = N_DIFF_HEADS * 2 * DIFF_HEAD_DIM
D_MIX = D_HYENA + D_DIFF
D_IN = HYENA_N_PROJ * D_HYENA + 3 * D_DIFF
ROPE_BASE = 10000.0
Q_BLOCK = 128
RMS_EPS = 1e-6
SUBLN_EPS = 1e-5

kernel_name = 'hybrid_hyena_diffattn_dit_layer'


def rms_norm(x, g, eps=RMS_EPS):
    xf = x.astype(jnp.float32)
    y = xf * lax.rsqrt(jnp.mean(xf * xf, axis=-1, keepdims=True) + eps)
    return (y * g.astype(jnp.float32)).astype(x.dtype)


def adaln(x, g, shift, scale):
    return rms_norm(x, g) * (1.0 + scale) + shift


def ffn_half_step(s, g, shift, scale, gate, w_gate, w_up, w_down):
    u = adaln(s, g, shift, scale)
    return s + 0.5 * gate * ((jax.nn.silu(u @ w_gate) * (u @ w_up)) @ w_down)


def centred_short_conv(z, w, b):
    zp = jnp.pad(z, ((0, 0), (1, 1), (0, 0)))
    return zp[:, :-2] * w[0] + zp[:, 1:-1] * w[1] + zp[:, 2:] * w[2] + b


def hyena_filter(L, w1, b1, w_inner, b_inner, freq, w_out):
    t = jnp.linspace(0.0, 1.0, L, dtype=jnp.float32)[:, None]
    omega = (2.0 * math.pi / L) * jnp.arange(L, dtype=jnp.float32)[:, None]
    bands = jnp.linspace(1e-4, FILTER_EMB_BANDS - 1, FILTER_EMB_BANDS, dtype=jnp.float32)[None, :]
    ang = omega * bands
    emb = jnp.concatenate([t, jnp.cos(ang), -jnp.sin(ang)], axis=-1)
    freq = freq.astype(jnp.float32)
    h = jnp.sin(freq * (emb @ w1.astype(jnp.float32) + b1.astype(jnp.float32)))
    for i in range(FILTER_INNER):
        h = jnp.sin(freq * (h @ w_inner[i].astype(jnp.float32) + b_inner[i].astype(jnp.float32)))
    h = (h @ w_out.astype(jnp.float32)).reshape(L, 2, D_HYENA)
    min_decay = math.log(DECAY_TARGET) / SLOW_DECAY_PCT
    max_decay = math.log(DECAY_TARGET) / FAST_DECAY_PCT
    deltas = jnp.abs(jnp.linspace(min_decay, max_decay, D_HYENA, dtype=jnp.float32))
    return h * jnp.exp(-t * deltas)[:, None, :]


def bidirectional_fft_conv(u, h, bias):
    L = u.shape[1]
    h_fwd, h_bwd = h[:, 0], h[:, 1]
    k_full = jnp.concatenate([h_fwd, jnp.zeros_like(h_fwd[:1]), h_bwd[:0:-1]], axis=0)
    k_f = jnp.fft.rfft(k_full, n=2 * L, axis=0)
    uf = u.astype(jnp.float32)
    u_f = jnp.fft.rfft(uf, n=2 * L, axis=1)
    y = jnp.fft.irfft(u_f * k_f[None], n=2 * L, axis=1)[:, :L]
    return (y + uf * bias.astype(jnp.float32)).astype(u.dtype)


def hyena_mixer(z, conv_w, conv_b, w1, b1, w_inner, b_inner, freq, w_out, bias):
    L = z.shape[1]
    z = centred_short_conv(z, conv_w, conv_b)
    x0, x1, v = jnp.split(z, HYENA_N_PROJ, axis=-1)
    h = hyena_filter(L, w1, b1, w_inner, b_inner, freq, w_out)
    return x0 * bidirectional_fft_conv(x1 * v, h, bias)


def axial_rope_tables(n_lat):
    rows = n_lat // GRID_W
    row = jnp.broadcast_to(jnp.arange(rows, dtype=jnp.float32)[:, None], (rows, GRID_W)).reshape(-1)
    col = jnp.broadcast_to(jnp.arange(GRID_W, dtype=jnp.float32)[None, :], (rows, GRID_W)).reshape(-1)
    axis_dim = DIFF_HEAD_DIM // 2
    inv_freq = ROPE_BASE ** (-jnp.arange(0, axis_dim, 2, dtype=jnp.float32) / axis_dim)
    ang = jnp.stack([row[:, None] * inv_freq, col[:, None] * inv_freq], axis=1)
    return jnp.cos(ang), jnp.sin(ang)


def apply_axial_rope(x, cos, sin):
    b_, n_, h_, s_, d_ = x.shape
    xr = x.astype(jnp.float32).reshape(b_, n_, h_, s_, 2, 2, d_ // 4)
    x1, x2 = xr[..., 0, :], xr[..., 1, :]
    cs, sn = cos[None, :, None, None], sin[None, :, None, None]
    out = jnp.stack([x1 * cs - x2 * sn, x2 * cs + x1 * sn], axis=-2)
    return out.reshape(x.shape).astype(x.dtype)


def diff_attention(q, k, v, lam):
    s = jnp.einsum('bqhsd,bkhsd->bhsqk', q, k).astype(jnp.float32) * (DIFF_HEAD_DIM ** -0.5)
    p = jax.nn.softmax(s, axis=-1)
    a = p[:, :, 0] - lam * p[:, :, 1]
    return jnp.einsum('bhqk,bkhe->bqhe', a.astype(v.dtype), v)


def diff_head_out(o, g, lam_init):
    o = rms_norm(o, g, SUBLN_EPS) * (1.0 - lam_init)
    return o.reshape(o.shape[0], o.shape[1], D_DIFF)


def setup_inputs(seed: int = 0) -> dict:
    key = jax.random.key(seed)
    ks = jax.random.split(key, 24)

    def nrm(k, shape, s):
        return s * jax.random.normal(k, shape, jnp.float32)

    return {
        'x': nrm(ks[0], (BATCH, SEQ, D_MODEL), 1.0),
        'c': nrm(ks[1], (BATCH, D_MODEL), 1.0),
        'ctx': nrm(ks[2], (BATCH, CTX_LEN, D_MODEL), 1.0),
        'c_ctx': nrm(ks[3], (D_MODEL,), 1.0),
        'ada_w': nrm(ks[4], (DEPTH, D_MODEL, N_ADA * D_MODEL), 0.5 * D_MODEL ** -0.5),
        'ada_b': nrm(ks[5], (DEPTH, N_ADA * D_MODEL), 0.01),
        'norm_g': 1.0 + nrm(ks[6], (DEPTH, 3, D_MODEL), 0.02),
        'ffn_w_gate': nrm(ks[7], (DEPTH, 2, D_MODEL, FFN_HIDDEN), D_MODEL ** -0.5),
        'ffn_w_up': nrm(ks[8], (DEPTH, 2, D_MODEL, FFN_HIDDEN), D_MODEL ** -0.5),
        'ffn_w_down': nrm(ks[9], (DEPTH, 2, FFN_HIDDEN, D_MODEL), FFN_HIDDEN ** -0.5),
        'w_in': nrm(ks[10], (DEPTH, D_MODEL, D_IN), D_MODEL ** -0.5),
        'w_out': nrm(ks[11], (DEPTH, D_MIX, D_MODEL), D_MIX ** -0.5),
        'hyena_conv_w': nrm(ks[12], (DEPTH, SHORT_CONV_W, HYENA_N_PROJ * D_HYENA), SHORT_CONV_W ** -0.5),
        'hyena_conv_b': nrm(ks[13], (DEPTH, HYENA_N_PROJ * D_HYENA), 0.01),
        'filt_w1': nrm(ks[14], (DEPTH, FILTER_EMB_DIM, FILTER_HIDDEN), FILTER_EMB_DIM ** -0.5),
        'filt_b1': nrm(ks[15], (DEPTH, FILTER_HIDDEN), 0.1),
        'filt_w_inner': nrm(ks[16], (DEPTH, FILTER_INNER, FILTER_HIDDEN, FILTER_HIDDEN), FILTER_HIDDEN ** -0.5),
        'filt_b_inner': nrm(ks[17], (DEPTH, FILTER_INNER, FILTER_HIDDEN), 0.1),
        'filt_sin_freq': 1.0 + nrm(ks[18], (DEPTH, FILTER_HIDDEN), 0.02),
        'filt_w_out': nrm(ks[19], (DEPTH, FILTER_HIDDEN, 2 * D_HYENA), FILTER_OUT_SCALE),
        'hyena_bias': nrm(ks[20], (DEPTH, D_HYENA), 1.0),
        'diff_lambda': nrm(ks[21], (DEPTH, 4, DIFF_HEAD_DIM), 0.1),
        'diff_subln_g': 1.0 + nrm(ks[22], (DEPTH, 2 * DIFF_HEAD_DIM), 0.02),
        'final_g': 1.0 + nrm(ks[23], (D_MODEL,), 0.02),
    }


def reference(x, c, ctx, c_ctx, ada_w, ada_b, norm_g, ffn_w_gate, ffn_w_up, ffn_w_down, w_in, w_out,
              hyena_conv_w, hyena_conv_b, filt_w1, filt_b1, filt_w_inner, filt_b_inner, filt_sin_freq,
              filt_w_out, hyena_bias, diff_lambda, diff_subln_g, final_g):
    B, N, D = x.shape
    C = ctx.shape[1]
    H, d = N_DIFF_HEADS, DIFF_HEAD_DIM
    n_blk = N // Q_BLOCK
    hy_end = HYENA_N_PROJ * D_HYENA
    q_end = hy_end + D_DIFF
    cos, sin = axial_rope_tables(N)
    h_lat, h_ctx = x, ctx
    for layer in range(DEPTH):
        last = layer == DEPTH - 1
        lam_init = 0.8 - 0.6 * math.exp(-0.3 * layer)
        mod_lat = (jax.nn.silu(c) @ ada_w[layer] + ada_b[layer]).reshape(B, N_ADA, D).transpose(1, 0, 2)[:, :, None, :]
        mod_ctx = (jax.nn.silu(c_ctx) @ ada_w[layer] + ada_b[layer]).reshape(N_ADA, 1, 1, D)
        hyena_params = (hyena_conv_w[layer], hyena_conv_b[layer], filt_w1[layer], filt_b1[layer],
                        filt_w_inner[layer], filt_b_inner[layer], filt_sin_freq[layer], filt_w_out[layer],
                        hyena_bias[layer])

        ffn0 = (ffn_w_gate[layer, 0], ffn_w_up[layer, 0], ffn_w_down[layer, 0])
        h_lat = ffn_half_step(h_lat, norm_g[layer, 0], mod_lat[0], mod_lat[1], mod_lat[2], *ffn0)
        h_ctx = ffn_half_step(h_ctx, norm_g[layer, 0], mod_ctx[0], mod_ctx[1], mod_ctx[2], *ffn0)

        u_lat = adaln(h_lat, norm_g[layer, 1], mod_lat[3], mod_lat[4])
        u_ctx = adaln(h_ctx, norm_g[layer, 1], mod_ctx[3], mod_ctx[4])
        p_lat = u_lat @ w_in[layer]
        kv_ctx = u_ctx @ w_in[layer][:, q_end:]
        lp = diff_lambda[layer].astype(jnp.float32)
        lam = jnp.exp(jnp.sum(lp[0] * lp[1])) - jnp.exp(jnp.sum(lp[2] * lp[3])) + lam_init

        q_lat = apply_axial_rope(p_lat[..., hy_end:q_end].reshape(B, N, H, 2, d), cos, sin)
        k_lat = apply_axial_rope(p_lat[..., q_end:q_end + D_DIFF].reshape(B, N, H, 2, d), cos, sin)
        v_lat = p_lat[..., q_end + D_DIFF:].reshape(B, N, H, 2 * d)
        k_ctx = kv_ctx[..., :D_DIFF].reshape(B, C, H, 2, d)
        v_ctx = kv_ctx[..., D_DIFF:].reshape(B, C, H, 2 * d)
        k_all = jnp.concatenate([k_lat, k_ctx], axis=1)
        v_all = jnp.concatenate([v_lat, v_ctx], axis=1)
        q_blocks = q_lat.reshape(B, n_blk, Q_BLOCK, H, 2, d).swapaxes(0, 1)
        o_lat = lax.map(lambda qb: diff_attention(qb, k_all, v_all, lam), q_blocks)
        o_lat = o_lat.swapaxes(0, 1).reshape(B, N, H, 2 * d)
        y_lat = jnp.concatenate([hyena_mixer(p_lat[..., :hy_end], *hyena_params),
                                 diff_head_out(o_lat, diff_subln_g[layer], lam_init)], axis=-1)
        h_lat = h_lat + mod_lat[5] * (y_lat @ w_out[layer])

        ffn1 = (ffn_w_gate[layer, 1], ffn_w_up[layer, 1], ffn_w_down[layer, 1])
        if not last:
            p_ctx = u_ctx @ w_in[layer][:, :q_end]
            q_ctx = p_ctx[..., hy_end:].reshape(B, C, H, 2, d)
            o_ctx = diff_attention(q_ctx, k_ctx, v_ctx, lam)
            y_ctx = jnp.concatenate([hyena_mixer(p_ctx[..., :hy_end], *hyena_params),
                                     diff_head_out(o_ctx, diff_subln_g[layer], lam_init)], axis=-1)
            h_ctx = h_ctx + mod_ctx[5] * (y_ctx @ w_out[layer])
            h_ctx = ffn_half_step(h_ctx, norm_g[layer, 2], mod_ctx[6], mod_ctx[7], mod_ctx[8], *ffn1)

        h_lat = ffn_half_step(h_lat, norm_g[layer, 2], mod_lat[6], mod_lat[7], mod_lat[8], *ffn1)
    return rms_norm(h_lat, final_g)
```

```cpp
#include <hip/hip_runtime.h>
#include <hip/hip_cooperative_groups.h>
#include <cstdio>
#include <cstdint>
namespace cg = cooperative_groups;
namespace pg8 {
#define PG8_LAS __attribute__((address_space(3)))
typedef unsigned short bf16_t;
typedef short bf16x8 __attribute__((ext_vector_type(8)));
typedef float f32x4 __attribute__((ext_vector_type(4)));
typedef unsigned u32x4 __attribute__((ext_vector_type(4)));
constexpr int BM = 256, BK = 64, HALF = 128, HTB = HALF * BK * 2  , STAGE_BYTES = 8 * HTB, NXCD = 8, WGM = 8;

__host__ __device__ __forceinline__ int lds_byte(int r, int c) { const int st = (r >> 4) * 2 + (c >> 5), rr = r & 15, cc = c & 31, ob = rr * 64 + cc * 2; return st * 1024 + (ob ^ (((ob >> 9) & 1) << 5)); }
__host__ __device__ __forceinline__ void stage_rc(int b, int& R, int& C) { const int st = b / 1024, sb = b % 1024, swz = sb ^ (((sb >> 9) & 1) << 5); R = (st >> 1) * 16 + swz / 64; C = (st & 1) * 32 + (swz % 64) / 2; }
__host__ __device__ __forceinline__ int perm32(int rho) { const int n = rho >> 4, i = rho & 15; return 8 * (i >> 2) + 4 * n + (i & 3); }

struct Unit { int pm, pn; };
struct Gemm { const bf16_t* A; const bf16_t* Bt; int M, N, K; };

struct StaticOrder {
    int nM, nN, nwg, G, c;
    __host__ __device__ void init(int M, int N, int G_, int c_) { nM = M / BM; nN = N / BM; nwg = nM * nN; G = G_; c = c_; }
    __host__ __device__ bool next(int i, Unit& u) const {
        const long L = (long)i * G + c; if (L >= nwg) return false;
        int wgid = (int)L; { const int q = nwg / NXCD, r = nwg % NXCD, xcd = wgid % NXCD, off = wgid / NXCD; wgid = (xcd < r ? xcd * (q + 1) : r * (q + 1) + (xcd - r) * q) + off; }
        const int nig = WGM * nN, gid = wgid / nig, fm = gid * WGM, gsz = (nM - fm) < WGM ? (nM - fm) : WGM;
        u.pm = fm + ((wgid % nig) % gsz); u.pn = (wgid % nig) / gsz; return true;
    }
    __device__ __forceinline__ void a_ready(const Unit&) const {}
    __device__ __forceinline__ void done(const Unit&) const {}
};
__device__ __forceinline__ unsigned cvt_pk_bf16(float lo, float hi) { unsigned r; asm volatile("v_cvt_pk_bf16_f32 %0, %1, %2" : "=v"(r) : "v"(lo), "v"(hi)); return r; }
typedef float f32x2 __attribute__((ext_vector_type(2)));
template <class Epi, class Sched, bool STAMP = false>
__device__ __forceinline__ void gemm_phase(PG8_LAS unsigned char* lds, const Gemm g, const Sched& S, const Epi& E, unsigned long long* stamps) {
    const int tid = threadIdx.x, wid = __builtin_amdgcn_readfirstlane(tid >> 6), lane = tid & 63, wr = wid >> 2, wc = wid & 3, fr = lane & 15, fq = lane >> 4;
    const int K = g.K, nt = K / BK;
    int ts_lo = 0, ts_hi = 0, nts = 0; const unsigned long long rt_entry = STAMP ? (unsigned long long)wall_clock64() : 0ull;
#define PG8_STAMP() do { if (STAMP && wid == 0 && nts < 64) { const unsigned long long _c = (unsigned long long)clock64(); \
        ts_lo = (lane == nts) ? (int)(unsigned)_c : ts_lo; ts_hi = (lane == nts) ? (int)(unsigned)(_c >> 32) : ts_hi; ++nts; } } while (0)
    PG8_STAMP();
    unsigned voffA[2], voffB[2];
#pragma unroll
    for (int i = 0; i < 2; ++i) { int R, C; stage_rc(tid * 16 + i * 8192, R, C); const int Rb = Epi::PERM ? ((R & ~31) + perm32(R & 31)) : R;
        voffA[i] = (unsigned)(R * K + C) * 2u; voffB[i] = (unsigned)(Rb * K + C) * 2u; }
    const size_t kstep = (size_t)(BK * 2);
    const size_t hstep = (size_t)HALF * K * 2;
    const size_t tstep = 2 * hstep;
    const unsigned ldsw = (unsigned)wid * 1024u;
    const int aoff = lds_byte(wr * 64 + fr, fq * 8), boff = lds_byte(wc * 32 + fr, fq * 8);
#define PG8_SA(b, h) (((b) * 2 + (h)) * HTB)
#define PG8_SB(b, h) ((4 + (b) * 2 + (h)) * HTB)
#define PG8_STAGE(bufoff, gbase, voff) do { _Pragma("unroll") for (int _i = 0; _i < 2; ++_i) \
        __builtin_amdgcn_global_load_lds((const unsigned*)((const char*)(gbase) + (voff)[_i]), (PG8_LAS unsigned*)(lds + (bufoff) + ldsw + _i * 8192), 16, 0, 0); } while (0)
#define PG8_LDA(dst, b, h) do { _Pragma("unroll") for (int m = 0; m < 4; ++m) _Pragma("unroll") for (int k = 0; k < 2; ++k) dst[m][k] = *(const PG8_LAS bf16x8*)(lds + PG8_SA(b, h) + aoff + m * 2048 + k * 1024); } while (0)
#define PG8_LDB(dst, b, h) do { _Pragma("unroll") for (int n = 0; n < 2; ++n) _Pragma("unroll") for (int k = 0; k < 2; ++k) dst[n][k] = *(const PG8_LAS bf16x8*)(lds + PG8_SB(b, h) + boff + n * 2048 + k * 1024); } while (0)
#define PG8_MMA(ai, bj, At, Bt) do { __builtin_amdgcn_s_setprio(1); _Pragma("unroll") for (int m = 0; m < 4; ++m) _Pragma("unroll") for (int n = 0; n < 2; ++n) _Pragma("unroll") for (int k = 0; k < 2; ++k) \
        acc[ai][bj][m][n] = __builtin_amdgcn_mfma_f32_16x16x32_bf16(Bt[n][k], At[m][k], acc[ai][bj][m][n], 0, 0, 0); __builtin_amdgcn_s_setprio(0); } while (0)
#define PG8_WAIT_V(n) asm volatile("s_waitcnt vmcnt(" #n ")" ::: "memory")
#define PG8_WAIT_L(n) asm volatile("s_waitcnt lgkmcnt(" #n ")" ::: "memory")
#define PG8_BAR __builtin_amdgcn_s_barrier()
#define PG8_SCHED __builtin_amdgcn_sched_barrier(0)
    Unit cur, nxt; int ui = 0;
    if (!S.next(0, cur)) return;
    f32x4 acc[2][2][4][2];
#pragma unroll
    for (int a = 0; a < 2; ++a)
#pragma unroll
        for (int b = 0; b < 2; ++b)
#pragma unroll
            for (int m = 0; m < 4; ++m)
#pragma unroll
                for (int n = 0; n < 2; ++n) acc[a][b][m][n] = (f32x4){0.f, 0.f, 0.f, 0.f};
    bf16x8 At[4][2], B0[2][2], B1[2][2];
    const char* cA = (const char*)g.A + (size_t)cur.pm * tstep; const char* cB = (const char*)g.Bt + (size_t)cur.pn * tstep;
    S.a_ready(cur);
    PG8_STAGE(PG8_SB(0, 0), cB, voffB); PG8_STAGE(PG8_SA(0, 0), cA, voffA); PG8_STAGE(PG8_SB(0, 1), cB + hstep, voffB); PG8_STAGE(PG8_SA(0, 1), cA + hstep, voffA);
    if (wr == 1) PG8_BAR;
    PG8_WAIT_V(4); PG8_BAR;
    PG8_STAGE(PG8_SB(1, 0), cB + kstep, voffB); PG8_STAGE(PG8_SA(1, 0), cA + kstep, voffA); PG8_STAGE(PG8_SB(1, 1), cB + hstep + kstep, voffB);
    PG8_WAIT_V(6); PG8_BAR;
    PG8_STAMP();
    for (;;) {
        const bool has_next = S.next(ui + 1, nxt);
        const char* nA = has_next ? (const char*)g.A + (size_t)nxt.pm * tstep : cA; const char* nB = has_next ? (const char*)g.Bt + (size_t)nxt.pn * tstep : cB;
        for (int t = 0; t < nt; t += 2) {
            const bool last = (t == nt - 2);
            const char* a1 = cA + (size_t)(t + 1) * kstep;
            const char* a2 = last ? nA : cA + (size_t)(t + 2) * kstep; const char* b2 = last ? nB : cB + (size_t)(t + 2) * kstep;
            const char* a3 = a2 + kstep; const char* b3 = b2 + kstep;
            if (last && has_next) S.a_ready(nxt);
            PG8_LDB(B0, 0, 0); PG8_SCHED; PG8_LDA(At, 0, 0); PG8_STAGE(PG8_SA(1, 1), a1 + hstep, voffA);
            PG8_WAIT_L(8); PG8_BAR; PG8_WAIT_L(0); PG8_MMA(0, 0, At, B0); PG8_BAR; PG8_SCHED;
            PG8_LDB(B1, 0, 1); PG8_STAGE(PG8_SB(0, 0), b2, voffB);
            PG8_BAR; PG8_WAIT_L(0); PG8_MMA(0, 1, At, B1); PG8_BAR;
            PG8_LDA(At, 0, 1); PG8_STAGE(PG8_SA(0, 0), a2, voffA);
            PG8_BAR; PG8_WAIT_L(0); PG8_MMA(1, 0, At, B0); PG8_BAR; PG8_SCHED;
            PG8_STAGE(PG8_SB(0, 1), b2 + hstep, voffB);
            PG8_WAIT_V(6); PG8_BAR; PG8_MMA(1, 1, At, B1); PG8_BAR;
            PG8_LDB(B0, 1, 0); PG8_SCHED; PG8_LDA(At, 1, 0); PG8_STAGE(PG8_SA(0, 1), a2 + hstep, voffA);
            PG8_WAIT_L(8); PG8_BAR; PG8_WAIT_L(0); PG8_MMA(0, 0, At, B0); PG8_BAR; PG8_SCHED;
            PG8_LDB(B1, 1, 1); PG8_STAGE(PG8_SB(1, 0), b3, voffB);
            PG8_BAR; PG8_WAIT_L(0); PG8_MMA(0, 1, At, B1); PG8_BAR;
            PG8_LDA(At, 1, 1); PG8_STAGE(PG8_SA(1, 0), a3, voffA);
            PG8_BAR; PG8_WAIT_L(0); PG8_MMA(1, 0, At, B0); PG8_BAR; PG8_SCHED;
            PG8_STAGE(PG8_SB(1, 1), b3 + hstep, voffB);
            PG8_WAIT_V(6); PG8_BAR; PG8_MMA(1, 1, At, B1); PG8_BAR;
        }
        PG8_STAMP();
        if constexpr (!Epi::AFTER_DRAIN) { E(acc, cur, wr, wc, fr, fq); S.done(cur); }
        PG8_STAMP();
        if (!has_next) break;
#pragma unroll
        for (int a = 0; a < 2; ++a)
#pragma unroll
            for (int b = 0; b < 2; ++b)
#pragma unroll
                for (int m = 0; m < 4; ++m)
#pragma unroll
                    for (int n = 0; n < 2; ++n) acc[a][b][m][n] = (f32x4){0.f, 0.f, 0.f, 0.f};
        cur = nxt; cA = nA; cB = nB; ++ui;
    }
    PG8_WAIT_V(0);
    if (wr == 0) PG8_BAR;
    PG8_BAR;
    if constexpr (Epi::AFTER_DRAIN) { E.fused(acc, cur, wr, wc, fr, fq, lds, wid, lane); S.done(cur); }
    PG8_STAMP();
    if (STAMP && wid == 0) { stamps[lane] = lane < nts ? (((unsigned long long)(unsigned)ts_hi << 32) | (unsigned)ts_lo) : 0ull;
        if (lane == 62) stamps[62] = rt_entry; if (lane == 63) stamps[63] = (unsigned long long)wall_clock64(); }
#undef PG8_STAMP
#undef PG8_SA
#undef PG8_SB
#undef PG8_STAGE
#undef PG8_LDA
#undef PG8_LDB
#undef PG8_MMA
#undef PG8_WAIT_V
#undef PG8_WAIT_L
#undef PG8_BAR
#undef PG8_SCHED
}
}

using pg8::f32x4; using pg8::bf16x8; using pg8::u32x4; using pg8::Unit;
typedef unsigned short u16;
#define LAS PG8_LAS
constexpr int DM = 1024, SEQ = 16384, CTXL = 256, NLAT = 2 * SEQ, NCTX = 2 * CTXL, MROWS = NLAT + NCTX;
constexpr int FF = 2816, DIN = 3072, NKEY = SEQ + CTXL, NADA = 9 * DM;
constexpr int LDS_BYTES = 131072;
#ifndef MULTI_LAUNCH
#define MULTI_LAUNCH 0
#endif
constexpr int NPHASE = 14;

constexpr size_t al256(size_t x) { return (x + 255) / 256 * 256; }
constexpr size_t WS_WB0 = 0;
constexpr size_t WS_WD0 = WS_WB0 + al256((size_t)2 * FF * DM * 2);
constexpr size_t WS_WB1 = WS_WD0 + al256((size_t)DM * FF * 2);
constexpr size_t WS_WD1 = WS_WB1 + al256((size_t)2 * FF * DM * 2);
constexpr size_t WS_WIN = WS_WD1 + al256((size_t)DM * FF * 2);
constexpr size_t WS_WOUT = WS_WIN + al256((size_t)DIN * DM * 2);
constexpr size_t WS_MOD = WS_WOUT + al256((size_t)DM * DM * 2);
constexpr size_t WS_ROPE = WS_MOD + al256((size_t)3 * NADA * 4);
constexpr size_t WS_TW = WS_ROPE + al256((size_t)256 * 16 * 8);
constexpr size_t WS_H3 = WS_TW + al256((size_t)4096 * 8);
constexpr size_t WS_HFILT = WS_H3 + al256((size_t)SEQ * 64 * 4);
constexpr size_t WS_HCTX = WS_HFILT + al256((size_t)1024 * SEQ * 2);
constexpr size_t WS_U = WS_HCTX + al256((size_t)NCTX * DM * 4);
constexpr size_t WS_R2 = WS_U + al256((size_t)MROWS * DM * 2);
constexpr size_t R2_Z = 0, R2_Q = R2_Z + (size_t)NLAT * 1536 * 2, R2_K = R2_Q + (size_t)NLAT * 512 * 2, R2_V = R2_K + (size_t)2 * NKEY * 512 * 2, R2_END = R2_V + (size_t)2 * NKEY * 512 * 2;
constexpr size_t R2_SIZE = R2_END > (size_t)MROWS * FF * 2 ? R2_END : (size_t)MROWS * FF * 2;
constexpr size_t WS_W = WS_R2 + al256(R2_SIZE);
constexpr size_t WS_SCR = WS_W + al256((size_t)512 * 2 * SEQ * 4);
constexpr size_t WS_END = WS_SCR + (size_t)256 * 262144;

struct Params {
    const float *x, *c, *ctx, *c_ctx, *ada_w, *ada_b, *norm_g, *w_gate, *w_up, *w_down, *w_in, *w_out, *conv_w, *conv_b, *f_w1, *f_b1, *f_wi, *f_bi, *f_freq, *f_wout, *hy_bias, *lam, *subln_g, *final_g;
    float* out; unsigned char* ws; int ph_lo, ph_hi;
};

__device__ __forceinline__ float bf2f(u16 b) { return __uint_as_float(((unsigned)b) << 16); }
__device__ __forceinline__ u16 f2bf(float f) { unsigned u = __float_as_uint(f); u += 0x7FFFu + ((u >> 16) & 1u); return (u16)(u >> 16); }
__device__ __forceinline__ unsigned pk2(float lo, float hi) { return pg8::cvt_pk_bf16(lo, hi); }
__device__ __forceinline__ float2 cmul(float2 a, float2 b) { return make_float2(a.x * b.x - a.y * b.y, a.x * b.y + a.y * b.x); }
__device__ __forceinline__ float silu_f(float v) { return v / (1.0f + __expf(-v)); }

__device__ __forceinline__ void transpose_tile(const float* __restrict__ src, u16* __restrict__ dst, int K, int N, int mode, int tile, float* ldsf, int tid) {
    const int ntn = N >> 6, tk = tile / ntn, tn = tile - tk * ntn, k0 = tk * 64, n0 = tn * 64;
#pragma unroll
    for (int i = 0; i < 8; ++i) { const int k = (tid >> 6) + 8 * i, n = tid & 63; ldsf[k * 65 + n] = src[(size_t)(k0 + k) * N + n0 + n]; }
    __syncthreads();
    const int nl = tid >> 3, ks = (tid & 7) * 8;
    float v[8];
#pragma unroll
    for (int j = 0; j < 8; ++j) v[j] = ldsf[(ks + j) * 65 + nl];
    const int nn = n0 + nl;
    const int row = mode == 0 ? nn : ((nn >> 7) * 256 + (nn & 127) + (mode == 2 ? 128 : 0));
    u32x4 w; w.x = pk2(v[0], v[1]); w.y = pk2(v[2], v[3]); w.z = pk2(v[4], v[5]); w.w = pk2(v[6], v[7]);
    *(u32x4*)(dst + (size_t)row * K + k0 + ks) = w;
    __syncthreads();
}

__device__ __forceinline__ void mod_item(const Params& p, int item, float* ldsf, int tid) {
    const int wave = tid >> 6, lane = tid & 63, col = item * 64 + lane;
    float a0 = 0.f, a1 = 0.f, a2 = 0.f;
    const float* aw = p.ada_w + (size_t)(wave * 128) * NADA + col;
#pragma unroll 8
    for (int k = 0; k < 128; ++k) {
        const int kk = wave * 128 + k;
        const float w = aw[(size_t)k * NADA];
        a0 += silu_f(p.c[kk]) * w; a1 += silu_f(p.c[DM + kk]) * w; a2 += silu_f(p.c_ctx[kk]) * w;
    }
    ldsf[(wave * 3 + 0) * 64 + lane] = a0; ldsf[(wave * 3 + 1) * 64 + lane] = a1; ldsf[(wave * 3 + 2) * 64 + lane] = a2;
    __syncthreads();
    if (tid < 192) { const int v = tid >> 6; float s = p.ada_b[col];
#pragma unroll
        for (int w = 0; w < 8; ++w) s += ldsf[(w * 3 + v) * 64 + lane];
        ((float*)(p.ws + WS_MOD))[v * NADA + col] = s; }
    __syncthreads();
}

__device__ __forceinline__ void filt_item(const Params& p, int item, float* ldsf, int tid) {
    const int wave = tid >> 6, lane = tid & 63, n = item * 8 + wave;
    float* hb = ldsf + wave * 128;
    const float t = (float)n / (float)(SEQ - 1);
    const float omega = (2.0f * 3.14159265358979323846f / (float)SEQ) * (float)n;
    if (lane == 0) hb[0] = t;
    if (lane < 32) { const int k = lane & 15; const float band = 1e-4f + (15.0f - 1e-4f) * (float)k / 15.0f; const float ang = omega * band;
        hb[1 + lane] = lane < 16 ? cosf(ang) : -sinf(ang); }
    __builtin_amdgcn_wave_barrier();
    __syncthreads();
    const float fr = p.f_freq[lane];
    float acc = p.f_b1[lane];
    for (int i = 0; i < 33; ++i) acc += hb[i] * p.f_w1[i * 64 + lane];
    float h = sinf(fr * acc);
    __syncthreads();
    for (int l = 0; l < 2; ++l) {
        hb[lane] = h;
        __syncthreads();
        acc = p.f_bi[l * 64 + lane];
        const float* wi = p.f_wi + l * 4096;
#pragma unroll 8
        for (int i = 0; i < 64; ++i) acc += hb[i] * wi[i * 64 + lane];
        h = sinf(fr * acc);
        __syncthreads();
    }
    ((float*)(p.ws + WS_H3))[n * 64 + lane] = h;
}

__device__ __forceinline__ void phase_prep(const Params& p, float* ldsf, int tid, int G, int bx) {
    constexpr int I_ROPE = 144, I_TW = 152, I_F = 160, I_T = 2208, I_END = I_T + 5248;
    for (int it = bx; it < I_END; it += G) {
        if (it < I_ROPE) mod_item(p, it, ldsf, tid);
        else if (it < I_TW) { const int idx = (it - I_ROPE) * 512 + tid, pos = idx >> 4, f = idx & 15;
            const float invf = powf(10000.0f, -(float)(2 * f) / 32.0f); float s, c; sincosf((float)pos * invf, &s, &c);
            ((float2*)(p.ws + WS_ROPE))[idx] = make_float2(c, s); }
        else if (it < I_F) { const int n = (it - I_TW) * 512 + tid; float s, c; sincospif((float)n / 8192.0f, &s, &c);
            ((float2*)(p.ws + WS_TW))[n] = make_float2(c, -s); }
        else if (it < I_T) filt_item(p, it - I_F, ldsf, tid);
        else { int t = it - I_T; const float* src; u16* dst; int K, N, mode;
            if (t < 2816) { const int m = t / 704; t -= m * 704; const int layer = m >> 1; K = DM; N = FF; mode = 1 + (m & 1);
                src = ((m & 1) ? p.w_up : p.w_gate) + (size_t)layer * DM * FF; dst = (u16*)(p.ws + (layer ? WS_WB1 : WS_WB0)); }
            else if (t < 4224) { t -= 2816; const int layer = t / 704; t -= layer * 704; K = FF; N = DM; mode = 0; src = p.w_down + (size_t)layer * FF * DM; dst = (u16*)(p.ws + (layer ? WS_WD1 : WS_WD0)); }
            else if (t < 4992) { t -= 4224; K = DM; N = DIN; mode = 0; src = p.w_in; dst = (u16*)(p.ws + WS_WIN); }
            else { t -= 4992; K = DM; N = DM; mode = 0; src = p.w_out; dst = (u16*)(p.ws + WS_WOUT); }
            transpose_tile(src, dst, K, N, mode, t, ldsf, tid); }
    }
}

__device__ __forceinline__ void adaln_rows(const Params& p, const float* lat, const float* ctxp, int nrows, int gi, int kshift, int kscale, u16* U, int tid, int G, int bx) {
    const int wave = tid >> 6, lane = tid & 63;
    const float* g = p.norm_g + gi * DM; const float* mod = (const float*)(p.ws + WS_MOD);
    for (int r = bx * 8 + wave; r < nrows; r += G * 8) {
        const float* src = r < NLAT ? lat + (size_t)r * DM : ctxp + (size_t)(r - NLAT) * DM;
        const int sel = r < NLAT ? (r >> 14) : 2;
        f32x4 v[4]; float ss = 0.f;
#pragma unroll
        for (int i = 0; i < 4; ++i) { v[i] = *(const f32x4*)(src + i * 256 + lane * 4); ss += v[i][0] * v[i][0] + v[i][1] * v[i][1] + v[i][2] * v[i][2] + v[i][3] * v[i][3]; }
#pragma unroll
        for (int o = 32; o >= 1; o >>= 1) ss += __shfl_xor(ss, o);
        const float rs = rsqrtf(ss * (1.0f / DM) + 1e-6f);
        const float* sh = mod + sel * NADA + kshift * DM; const float* sc = mod + sel * NADA + kscale * DM;
#pragma unroll
        for (int i = 0; i < 4; ++i) { const int c = i * 256 + lane * 4;
            const f32x4 gg = *(const f32x4*)(g + c), s4 = *(const f32x4*)(sh + c), c4 = *(const f32x4*)(sc + c);
            f32x4 y = v[i] * rs * gg * (c4 + 1.0f) + s4;
            uint2 w; w.x = pk2(y[0], y[1]); w.y = pk2(y[2], y[3]);
            *(uint2*)(U + (size_t)r * DM + c) = w; }
    }
}
__device__ __forceinline__ void final_norm(const Params& p, int tid, int G, int bx) {
    const int wave = tid >> 6, lane = tid & 63;
    for (int r = bx * 8 + wave; r < NLAT; r += G * 8) {
        float* src = p.out + (size_t)r * DM;
        f32x4 v[4]; float ss = 0.f;
#pragma unroll
        for (int i = 0; i < 4; ++i) { v[i] = *(const f32x4*)(src + i * 256 + lane * 4); ss += v[i][0] * v[i][0] + v[i][1] * v[i][1] + v[i][2] * v[i][2] + v[i][3] * v[i][3]; }
#pragma unroll
        for (int o = 32; o >= 1; o >>= 1) ss += __shfl_xor(ss, o);
        const float rs = rsqrtf(ss * (1.0f / DM) + 1e-6f);
#pragma unroll
        for (int i = 0; i < 4; ++i) { const int c = i * 256 + lane * 4; const f32x4 gg = *(const f32x4*)(p.final_g + c); *(f32x4*)(src + c) = v[i] * rs * gg; }
    }
}

__device__ __forceinline__ void hfilt_items(const Params& p, float* ldsf, int tid, int G, int bx) {
    const float* h3 = (const float*)(p.ws + WS_H3); u16* HF = (u16*)(p.ws + WS_HFILT);
    for (int it = bx; it < 512; it += G) {
        const int nblk = it >> 4, cch = it & 15, n = nblk * 512 + tid;
#pragma unroll
        for (int e = 0; e < 8; ++e) { const int idx = tid + e * 512, i = idx >> 6, cc = idx & 63; ldsf[cc * 64 + i] = p.f_wout[i * 1024 + cch * 64 + cc]; }
        f32x4 h[16];
#pragma unroll
        for (int i = 0; i < 16; ++i) h[i] = *(const f32x4*)(h3 + (size_t)n * 64 + i * 4);
        __syncthreads();
        const float t = (float)n / (float)(SEQ - 1);
        for (int cc = 0; cc < 64; ++cc) {
            float acc = 0.f;
#pragma unroll
            for (int i = 0; i < 16; ++i) { const f32x4 w = *(const f32x4*)(ldsf + cc * 64 + i * 4); acc += h[i][0] * w[0] + h[i][1] * w[1] + h[i][2] * w[2] + h[i][3] * w[3]; }
            const int cp = cch * 64 + cc, c = cp & 511;
            const float mind = -3.0701134573253944f, maxd = -15.350567286626972f;
            const float delta = fabsf(mind + (maxd - mind) * ((float)c / 511.0f));
            HF[(size_t)cp * SEQ + n] = f2bf(acc * expf(-t * delta));
        }
        __syncthreads();
    }
}

struct EpiSwiGLU {
    static constexpr bool PERM = true, AFTER_DRAIN = false;
    u16* O;
    __device__ __forceinline__ void operator()(const f32x4 (&acc)[2][2][4][2], const Unit& u, int wr, int wc, int fr, int fq) const {
        const int row0 = u.pm * 256 + wr * 64 + fr, j0 = u.pn * 128 + wc * 32 + 8 * fq;
#pragma unroll
        for (int ai = 0; ai < 2; ++ai)
#pragma unroll
            for (int m = 0; m < 4; ++m) {
                const f32x4 g0 = acc[ai][0][m][0], g1 = acc[ai][0][m][1], u0 = acc[ai][1][m][0], u1 = acc[ai][1][m][1];
                float h[8];
#pragma unroll
                for (int j = 0; j < 4; ++j) { h[j] = silu_f(g0[j]) * u0[j]; h[4 + j] = silu_f(g1[j]) * u1[j]; }
                u32x4 w; w.x = pk2(h[0], h[1]); w.y = pk2(h[2], h[3]); w.z = pk2(h[4], h[5]); w.w = pk2(h[6], h[7]);
                *(u32x4*)(O + (size_t)(row0 + ai * 128 + m * 16) * FF + j0) = w;
            }
    }
};
struct EpiResid {
    static constexpr bool PERM = false, AFTER_DRAIN = false;
    const float* src_lat; const float* src_ctx; float* dst_lat; float* dst_ctx; const float* mod; int modk; float coef;
    __device__ __forceinline__ void operator()(const f32x4 (&acc)[2][2][4][2], const Unit& u, int wr, int wc, int fr, int fq) const {
        const bool isctx = u.pm >= 128; const int sel = isctx ? 2 : (u.pm >> 6);
        const size_t rb = (size_t)(isctx ? (u.pm - 128) : u.pm) * 256 * DM;
        const float* src = (isctx ? src_ctx : src_lat) + rb; float* dst = (isctx ? dst_ctx : dst_lat) + rb;
        const float* gv = mod + sel * NADA + modk * DM;
        const int col0 = u.pn * 256 + wc * 32 + 4 * fq, r0 = wr * 64 + fr;
#pragma unroll
        for (int bj = 0; bj < 2; ++bj)
#pragma unroll
            for (int n = 0; n < 2; ++n) {
                const int c = col0 + bj * 128 + n * 16;
                const f32x4 g4 = *(const f32x4*)(gv + c) * coef;
#pragma unroll
                for (int ai = 0; ai < 2; ++ai)
#pragma unroll
                    for (int m = 0; m < 4; ++m) { const size_t o = (size_t)(r0 + ai * 128 + m * 16) * DM + c;
                        *(f32x4*)(dst + o) = *(const f32x4*)(src + o) + g4 * acc[ai][bj][m][n]; }
            }
    }
};
struct EpiInProj {
    static constexpr bool PERM = false, AFTER_DRAIN = false;
    u16 *Z, *Q, *K, *V; const float* rope;
    __device__ __forceinline__ void operator()(const f32x4 (&acc)[2][2][4][2], const Unit& u, int wr, int wc, int fr, int fq) const {
        const bool isctx = u.pm >= 128; const int pn = u.pn;
        if (isctx && pn < 8) return;
        const int rl0 = wr * 64 + fr;
        const int cl0 = wc * 32 + 4 * fq;
        if (pn < 6) {
#pragma unroll
            for (int ai = 0; ai < 2; ++ai)
#pragma unroll
                for (int m = 0; m < 4; ++m) { u16* rp = Z + (size_t)(u.pm * 256 + rl0 + ai * 128 + m * 16) * 1536 + pn * 256 + cl0;
#pragma unroll
                    for (int bj = 0; bj < 2; ++bj)
#pragma unroll
                        for (int n = 0; n < 2; ++n) { const f32x4 a = acc[ai][bj][m][n]; uint2 w; w.x = pk2(a[0], a[1]); w.y = pk2(a[2], a[3]); *(uint2*)(rp + bj * 128 + n * 16) = w; } }
            return;
        }
        const bool do_rope = (pn < 10) && !isctx;
        u16* base; size_t rowbase;
        if (pn < 8) { base = Q; rowbase = (size_t)u.pm * 256; }
        else { base = pn < 10 ? K : V; rowbase = isctx ? ((size_t)(u.pm - 128) * NKEY + SEQ) : ((size_t)(u.pm >> 6) * NKEY + (size_t)(u.pm & 63) * 256); }
        const int cbase = (pn & 1) * 256 + cl0;
        const int axis = wc & 1;
#pragma unroll
        for (int ai = 0; ai < 2; ++ai)
#pragma unroll
            for (int m = 0; m < 4; ++m) {
                const int rl = rl0 + ai * 128 + m * 16;
                u16* rp = base + (rowbase + rl) * 512 + cbase;
                f32x4 cs0 = {1.f, 0.f, 1.f, 0.f}, cs1 = {1.f, 0.f, 1.f, 0.f};
                if (do_rope) { const int t = (u.pm & 63) * 256 + rl; const int pos = axis ? (t & 63) : (t >> 6);
                    const float* rp2 = rope + (size_t)(pos * 16 + 4 * fq) * 2; cs0 = *(const f32x4*)rp2; cs1 = *(const f32x4*)(rp2 + 4); }
#pragma unroll
                for (int bj = 0; bj < 2; ++bj) {
                    const f32x4 x1 = acc[ai][bj][m][0], x2 = acc[ai][bj][m][1];
                    f32x4 o1, o2;
                    o1[0] = x1[0] * cs0[0] - x2[0] * cs0[1]; o2[0] = x2[0] * cs0[0] + x1[0] * cs0[1];
                    o1[1] = x1[1] * cs0[2] - x2[1] * cs0[3]; o2[1] = x2[1] * cs0[2] + x1[1] * cs0[3];
                    o1[2] = x1[2] * cs1[0] - x2[2] * cs1[1]; o2[2] = x2[2] * cs1[0] + x1[2] * cs1[1];
                    o1[3] = x1[3] * cs1[2] - x2[3] * cs1[3]; o2[3] = x2[3] * cs1[2] + x1[3] * cs1[3];
                    uint2 w; w.x = pk2(o1[0], o1[1]); w.y = pk2(o1[2], o1[3]); *(uint2*)(rp + bj * 128) = w;
                    w.x = pk2(o2[0], o2[1]); w.y = pk2(o2[2], o2[3]); *(uint2*)(rp + bj * 128 + 16) = w;
                }
            }
    }
};

namespace att {
using bf16x8 = __attribute__((ext_vector_type(8))) short;
using s16x4  = __attribute__((ext_vector_type(4))) short;
using f32x16 = __attribute__((ext_vector_type(16))) float;
constexpr int KVBLK = 64, LDK = 512, LDQ = 512;
constexpr float SCALE = 0.125f, THR = 8.f;
constexpr int SHM_V = KVBLK * 128 * 2, SHM_K = KVBLK * 128 * 2;
#define KSWZ(row, colB) ((row) * 256 + ((colB) ^ (((row) & 7) << 4)))
#define SBAR() __builtin_amdgcn_sched_barrier(0)
__device__ __forceinline__ int crow(int r, int hi) { return (r & 3) + 8 * (r >> 2) + 4 * hi; }
__device__ __forceinline__ unsigned cvtpk(float lo, float hi) { unsigned r; asm volatile("v_cvt_pk_bf16_f32 %0, %1, %2" : "=v"(r) : "v"(lo), "v"(hi)); return r; }
__device__ __forceinline__ void partialSM(f32x16& p0, f32x16& p1, float& m_reg, float& mn, float& alpha) {
  constexpr float C = SCALE * 1.4426950408889634f;
  float pmax = p0[0];
#pragma unroll
  for (int r = 1; r < 16; ++r) pmax = fmaxf(pmax, p0[r]);
#pragma unroll
  for (int r = 0; r < 16; ++r) pmax = fmaxf(pmax, p1[r]);
  { auto rr = __builtin_amdgcn_permlane32_swap(__float_as_uint(pmax), __float_as_uint(pmax), false, false);
    pmax = fmaxf(__uint_as_float(rr[0]), __uint_as_float(rr[1])); }
  if (__builtin_expect(__all(pmax - m_reg <= THR / SCALE), 1)) { mn = m_reg; alpha = 1.f; }
  else { mn = fmaxf(m_reg, pmax); alpha = __builtin_amdgcn_exp2f((m_reg - mn) * C); m_reg = mn; }
  float mnC = -mn * C;
#pragma unroll
  for (int r = 0; r < 16; ++r) p0[r] = fmaf(p0[r], C, mnC);
#pragma unroll
  for (int r = 0; r < 16; ++r) p1[r] = fmaf(p1[r], C, mnC);
#pragma unroll
  for (int r = 0; r < 16; ++r) p0[r] = __builtin_amdgcn_exp2f(p0[r]);
}
__device__ __forceinline__ void finishSM(f32x16& p0, f32x16& p1, float alpha, float& l_reg, bf16x8& pa0, bf16x8& pa1, bf16x8& pa2, bf16x8& pa3) {
#pragma unroll
  for (int r = 0; r < 16; ++r) p1[r] = __builtin_amdgcn_exp2f(p1[r]);
  float ps = 0;
#pragma unroll
  for (int r = 0; r < 16; ++r) ps += p0[r];
#pragma unroll
  for (int r = 0; r < 16; ++r) ps += p1[r];
  { auto rr = __builtin_amdgcn_permlane32_swap(__float_as_uint(ps), __float_as_uint(ps), false, false);
    ps = __uint_as_float(rr[0]) + __uint_as_float(rr[1]); }
  l_reg = l_reg * alpha + ps;
#define PK4(P, BASE, OUT) do { unsigned a0 = cvtpk(P[BASE + 0], P[BASE + 1]), a1 = cvtpk(P[BASE + 2], P[BASE + 3]);   \
    unsigned b0 = cvtpk(P[BASE + 4], P[BASE + 5]), b1 = cvtpk(P[BASE + 6], P[BASE + 7]);                              \
    auto r0 = __builtin_amdgcn_permlane32_swap(a0, b0, false, false); auto r1 = __builtin_amdgcn_permlane32_swap(a1, b1, false, false); \
    u32x4 w = {r0[0], r1[0], r0[1], r1[1]}; OUT = *reinterpret_cast<bf16x8*>(&w); } while (0)
  PK4(p0, 0, pa0); PK4(p0, 8, pa1); PK4(p1, 0, pa2); PK4(p1, 8, pa3);
#undef PK4
}
__device__ __forceinline__ void qkt(f32x16& p0, f32x16& p1, const char* Ks, const bf16x8* qr, int r32, int hi, int s) {
  p0 = f32x16{}; p1 = f32x16{};
#pragma unroll
  for (int d0 = 0; d0 < 4; ++d0) { int cb = (s * 64 + d0 * 16 + hi * 8) * 2;
    bf16x8 b0 = *reinterpret_cast<const bf16x8*>(Ks + KSWZ(r32, cb));
    bf16x8 b1 = *reinterpret_cast<const bf16x8*>(Ks + KSWZ(32 + r32, cb));
    p0 = __builtin_amdgcn_mfma_f32_32x32x16_bf16(b0, qr[d0], p0, 0, 0, 0);
    p1 = __builtin_amdgcn_mfma_f32_32x32x16_bf16(b1, qr[d0], p1, 0, 0, 0); }
}
__device__ __forceinline__ int v_st(int k, int c) { const int kk = (k & ~0xC) | ((k & 4) << 1) | ((k & 8) >> 1); return ((kk >> 3) * 4 + (c >> 5)) * 512 + ((kk & 7) * 32 + (c & 31)) * 2; }
__device__ __forceinline__ int v_rd_base(int lane) { return ((lane & 3) << 3) | (((lane >> 2) & 3) << 6) | (((lane >> 4) & 1) << 5) | (((lane >> 5) & 1) << 8); }
constexpr int v_rd_off(int d0, int ks, int half) { return d0 * 512 + ks * 4096 + half * 2048; }
template <int OFF> __device__ __forceinline__ s16x4 tr_read(int vb) {
  s16x4 r; asm volatile("ds_read_b64_tr_b16 %0, %1 offset:%2" : "=&v"(r) : "v"(vb), "i"(OFF) : "memory"); return r;
}
template <int D0> __device__ __forceinline__ void pv_one(f32x16& od, int vb, bf16x8 pa0, bf16x8 pa1, bf16x8 pa2, bf16x8 pa3) {
  const s16x4 l0 = tr_read<v_rd_off(D0, 0, 0)>(vb), h0 = tr_read<v_rd_off(D0, 0, 1)>(vb), l1 = tr_read<v_rd_off(D0, 1, 0)>(vb), h1 = tr_read<v_rd_off(D0, 1, 1)>(vb);
  const s16x4 l2 = tr_read<v_rd_off(D0, 2, 0)>(vb), h2 = tr_read<v_rd_off(D0, 2, 1)>(vb), l3 = tr_read<v_rd_off(D0, 3, 0)>(vb), h3 = tr_read<v_rd_off(D0, 3, 1)>(vb);
  asm volatile("s_waitcnt lgkmcnt(0)" ::: "memory"); SBAR();
#define PK(L, H) (bf16x8){L[0], L[1], L[2], L[3], H[0], H[1], H[2], H[3]}
  od = __builtin_amdgcn_mfma_f32_32x32x16_bf16(pa0, PK(l0, h0), od, 0, 0, 0);
  od = __builtin_amdgcn_mfma_f32_32x32x16_bf16(pa1, PK(l1, h1), od, 0, 0, 0);
  od = __builtin_amdgcn_mfma_f32_32x32x16_bf16(pa2, PK(l2, h2), od, 0, 0, 0);
  od = __builtin_amdgcn_mfma_f32_32x32x16_bf16(pa3, PK(l3, h3), od, 0, 0, 0);
#undef PK
}
__device__ __forceinline__ void pv_d0(f32x16* o, int vb, bf16x8 pa0, bf16x8 pa1, bf16x8 pa2, bf16x8 pa3) {
  pv_one<0>(o[0], vb, pa0, pa1, pa2, pa3); pv_one<1>(o[1], vb, pa0, pa1, pa2, pa3); pv_one<2>(o[2], vb, pa0, pa1, pa2, pa3); pv_one<3>(o[3], vb, pa0, pa1, pa2, pa3);
}

__device__ __forceinline__ void diff_attn_unit(const u16* __restrict__ Qb, const u16* __restrict__ Kh, const u16* __restrict__ Vh, u16* __restrict__ Yb,
                                               float lam, const float* __restrict__ subg, char* lds) {
  const int tid = threadIdx.x, wid = tid >> 6, lane = tid & 63, r32 = lane & 31, hi = lane >> 5, qb = wid >> 1, s = wid & 1;
  char* V_lds = lds; char* K_lds = lds + 2 * SHM_V;
  float* wsl = (float*)(lds + 2 * SHM_V + 2 * SHM_K) + wid * 64; float* li_l = wsl; float* al_l = wsl + 32;
  float m_reg = -1e30f, l_reg = 0; f32x16 o[4] = {}; bf16x8 qr[4];
  const u16* Qw = Qb + (long)(qb * 32 + r32) * LDQ + s * 64 + hi * 8;
#pragma unroll
  for (int d0 = 0; d0 < 4; ++d0) qr[d0] = *reinterpret_cast<const bf16x8*>(Qw + d0 * 16);
  const int sr = tid >> 4, sc = (tid & 15) * 8, vst0 = v_st(sr, sc), vst1 = v_st(32 + sr, sc);
  const int vb0 = (int)(uintptr_t)V_lds + v_rd_base(lane);
  struct { bf16x8 vs0, vs1, ks0, ks1; } sr_[2];
#define LD8(ptr) (*reinterpret_cast<const bf16x8*>(ptr))
#define SLOAD(i, k0) do { sr_[i].vs0 = LD8(&Vh[(long)((k0) + sr) * LDK + sc]); sr_[i].vs1 = LD8(&Vh[(long)((k0) + 32 + sr) * LDK + sc]); \
    sr_[i].ks0 = LD8(&Kh[(long)((k0) + sr) * LDK + sc]); sr_[i].ks1 = LD8(&Kh[(long)((k0) + 32 + sr) * LDK + sc]); } while (0)
#define SWRITE(b, i) do { *(bf16x8*)(V_lds + (b) * SHM_V + vst0) = sr_[i].vs0;          \
    *(bf16x8*)(V_lds + (b) * SHM_V + vst1) = sr_[i].vs1; int kc = sc * 2;               \
    *(bf16x8*)(K_lds + (b) * SHM_K + KSWZ(sr, kc)) = sr_[i].ks0;                       \
    *(bf16x8*)(K_lds + (b) * SHM_K + KSWZ(32 + sr, kc)) = sr_[i].ks1; } while (0)
#define SWAIT() asm volatile("s_waitcnt vmcnt(4)" ::: "memory")
#define RESC(a) do { if (__any((a) < 1.f)) { if (hi == 0) al_l[r32] = (a); asm volatile("s_waitcnt lgkmcnt(0)" ::: "memory"); \
    _Pragma("unroll") for (int d = 0; d < 4; ++d) _Pragma("unroll") for (int r = 0; r < 16; ++r) o[d][r] *= al_l[crow(r, hi)]; } } while (0)
  f32x16 pA0, pA1, pB0, pB1; float mnA, mnB, alA, alB; bf16x8 pa0, pa1, pa2, pa3; constexpr int NT = NKEY / KVBLK;
  constexpr int SE = 0, SO = 1;
  SLOAD(SE, 0); asm volatile("s_waitcnt vmcnt(0)" ::: "memory"); SWRITE(0, SE); __syncthreads();
  qkt(pA0, pA1, K_lds, qr, r32, hi, s); partialSM(pA0, pA1, m_reg, mnA, alA);
  SLOAD(SO, KVBLK); SLOAD(SE, 2 * KVBLK);
  SWAIT(); SWRITE(1, SO); __syncthreads();
  for (int j = 1; j + 1 < NT; j += 2) {
    SBAR(); qkt(pB0, pB1, K_lds + SHM_K, qr, r32, hi, s);
    finishSM(pA0, pA1, alA, l_reg, pa0, pa1, pa2, pa3); SBAR();
    SLOAD(SO, (j + 2) * KVBLK); SBAR();
    pv_d0(o, vb0, pa0, pa1, pa2, pa3); partialSM(pB0, pB1, m_reg, mnB, alB);
    __syncthreads(); SWAIT(); SWRITE(0, SE);
    RESC(alB); __syncthreads();
    SBAR(); qkt(pA0, pA1, K_lds, qr, r32, hi, s);
    finishSM(pB0, pB1, alB, l_reg, pa0, pa1, pa2, pa3); SBAR();
    if (j + 3 < NT) SLOAD(SE, (j + 3) * KVBLK); SBAR();
    pv_d0(o, vb0 + SHM_V, pa0, pa1, pa2, pa3); partialSM(pA0, pA1, m_reg, mnA, alA);
    __syncthreads(); SWAIT(); SWRITE(1, SO);
    RESC(alA); __syncthreads();
  }
  SBAR(); qkt(pB0, pB1, K_lds + SHM_K, qr, r32, hi, s);
  finishSM(pA0, pA1, alA, l_reg, pa0, pa1, pa2, pa3); SBAR();
  pv_d0(o, vb0, pa0, pa1, pa2, pa3); partialSM(pB0, pB1, m_reg, mnB, alB);
  __syncthreads(); RESC(alB);
  finishSM(pB0, pB1, alB, l_reg, pa0, pa1, pa2, pa3); SBAR();
  pv_d0(o, vb0 + SHM_V, pa0, pa1, pa2, pa3);
  if (hi == 0) li_l[r32] = l_reg; asm volatile("s_waitcnt lgkmcnt(0)" ::: "memory");
  int hi2 = hi; asm volatile("" : "+v"(hi2));
  float rli[16];
#pragma unroll
  for (int r = 0; r < 16; ++r) rli[r] = 1.0f / li_l[crow(r, hi2)];
  __syncthreads();
  int xoff = qb * 4096 + r32, yoff = qb * 32 * 1024 + r32;
  asm volatile("" : "+v"(xoff), "+v"(yoff));
  float* X = (float*)lds + xoff;
  if (s == 1) {
#pragma unroll
    for (int r = 0; r < 16; ++r)
#pragma unroll
      for (int d0 = 0; d0 < 4; ++d0) X[crow(r, hi2) * 128 + d0 * 32] = lam * o[d0][r] * rli[r];
  }
  __syncthreads();
  if (s == 0) {
    float gv[4];
#pragma unroll
    for (int d0 = 0; d0 < 4; ++d0) gv[d0] = subg[d0 * 32 + r32] * 0.8f;
#pragma unroll
    for (int r = 0; r < 16; ++r) {
      const int row = crow(r, hi2); float v[4]; float ss = 0.f;
#pragma unroll
      for (int d0 = 0; d0 < 4; ++d0) { v[d0] = o[d0][r] * rli[r] - X[row * 128 + d0 * 32]; ss += v[d0] * v[d0]; }
#pragma unroll
      for (int of = 16; of >= 1; of >>= 1) ss += __shfl_xor(ss, of);
      const float rs = rsqrtf(ss * (1.0f / 128.0f) + 1e-5f);
      u16* yp = Yb + (yoff + row * 1024);
#pragma unroll
      for (int d0 = 0; d0 < 4; ++d0) yp[d0 * 32] = f2bf(v[d0] * rs * gv[d0]);
    }
  }
  __syncthreads();
#undef LD8
#undef SLOAD
#undef SWRITE
#undef SWAIT
#undef RESC
}
}

__device__ __forceinline__ void attn_phase(const Params& p, char* lds, int tid, int G, int bx) {
    const int lane = tid & 63;
    float sa = p.lam[lane] * p.lam[64 + lane], sb = p.lam[128 + lane] * p.lam[192 + lane];
#pragma unroll
    for (int o = 32; o >= 1; o >>= 1) { sa += __shfl_xor(sa, o); sb += __shfl_xor(sb, o); }
    const float lam = expf(sa) - expf(sb) + 0.2f;
    const u16* Q = (const u16*)(p.ws + WS_R2 + R2_Q); const u16* K = (const u16*)(p.ws + WS_R2 + R2_K); const u16* V = (const u16*)(p.ws + WS_R2 + R2_V);
    u16* Y = (u16*)(p.ws + WS_U);
    for (int i = bx; i < 1024; i += G) {
        const int bh = i & 7, qblk = i >> 3, b = bh >> 2, h = bh & 3;
        att::diff_attn_unit(Q + ((size_t)b * SEQ + (size_t)qblk * 128) * 512 + h * 128, K + (size_t)b * NKEY * 512 + h * 128, V + (size_t)b * NKEY * 512 + h * 128,
                            Y + ((size_t)b * SEQ + (size_t)qblk * 128) * 1024 + 512 + h * 128, lam, p.subln_g, lds);
    }
}

__device__ __forceinline__ void hy_t1(const Params& p, float* ldsf, int tid, int G, int bx) {
    const u16* Z = (const u16*)(p.ws + WS_R2 + R2_Z); float* W = (float*)(p.ws + WS_W);
    for (int it = bx; it < 4096; it += G) {
        const int cb = it & 7, tb = (it >> 3) & 255, b = it >> 11, t0 = tb * 64, c0 = cb * 64;
        for (int e = tid; e < 66 * 2 * 8; e += 512) { const int piece = e & 7, seg = e >> 3, tensor = seg & 1, row = seg >> 1, t = t0 - 1 + row;
            float* d = ldsf + tensor * (66 * 65) + row * 65 + piece * 8;
            if (t < 0 || t >= SEQ) {
#pragma unroll
                for (int j = 0; j < 8; ++j) d[j] = 0.f; }
            else { const u32x4 w = *(const u32x4*)(Z + ((size_t)b * SEQ + t) * 1536 + 512 + tensor * 512 + c0 + piece * 8);
                d[0] = __uint_as_float(w.x << 16); d[1] = __uint_as_float(w.x & 0xffff0000u); d[2] = __uint_as_float(w.y << 16); d[3] = __uint_as_float(w.y & 0xffff0000u);
                d[4] = __uint_as_float(w.z << 16); d[5] = __uint_as_float(w.z & 0xffff0000u); d[6] = __uint_as_float(w.w << 16); d[7] = __uint_as_float(w.w & 0xffff0000u); }
        }
        __syncthreads();
        const int t = tid & 63, cg8 = tid >> 6;
#pragma unroll
        for (int i = 0; i < 8; ++i) { const int c = cg8 * 8 + i, ch1 = 512 + c0 + c, chv = 1024 + c0 + c;
            const float* a = ldsf + t * 65 + c; const float* v = a + 66 * 65;
            const float x1 = a[0] * p.conv_w[ch1] + a[65] * p.conv_w[1536 + ch1] + a[130] * p.conv_w[3072 + ch1] + p.conv_b[ch1];
            const float xv = v[0] * p.conv_w[chv] + v[65] * p.conv_w[1536 + chv] + v[130] * p.conv_w[3072 + chv] + p.conv_b[chv];
            W[((size_t)(c0 + c) * 2 + b) * SEQ + t0 + t] = x1 * xv; }
        __syncthreads();
    }
}
__device__ __forceinline__ void hy_t2(const Params& p, float* ldsf, int tid, int G, int bx) {
    const u16* Z = (const u16*)(p.ws + WS_R2 + R2_Z); const float* W = (const float*)(p.ws + WS_W); u16* Y = (u16*)(p.ws + WS_U);
    for (int it = bx; it < 4096; it += G) {
        const int cb = it & 7, tb = (it >> 3) & 255, b = it >> 11, t0 = tb * 64, c0 = cb * 64;
        for (int e = tid; e < 66 * 8; e += 512) { const int piece = e & 7, row = e >> 3, t = t0 - 1 + row;
            float* d = ldsf + row * 65 + piece * 8;
            if (t < 0 || t >= SEQ) {
#pragma unroll
                for (int j = 0; j < 8; ++j) d[j] = 0.f; }
            else { const u32x4 w = *(const u32x4*)(Z + ((size_t)b * SEQ + t) * 1536 + c0 + piece * 8);
                d[0] = __uint_as_float(w.x << 16); d[1] = __uint_as_float(w.x & 0xffff0000u); d[2] = __uint_as_float(w.y << 16); d[3] = __uint_as_float(w.y & 0xffff0000u);
                d[4] = __uint_as_float(w.z << 16); d[5] = __uint_as_float(w.z & 0xffff0000u); d[6] = __uint_as_float(w.w << 16); d[7] = __uint_as_float(w.w & 0xffff0000u); }
        }
        float* ly = ldsf + 66 * 65;
        { const int t = tid & 63, cg8 = tid >> 6;
#pragma unroll
          for (int i = 0; i < 8; ++i) { const int c = cg8 * 8 + i; ly[c * 65 + t] = W[((size_t)(c0 + c) * 2 + b) * SEQ + t0 + t]; } }
        __syncthreads();
        const int c = tid & 63, tg = tid >> 6, ch0 = c0 + c;
        const float w0 = p.conv_w[ch0], w1 = p.conv_w[1536 + ch0], w2 = p.conv_w[3072 + ch0], bb = p.conv_b[ch0];
#pragma unroll
        for (int i = 0; i < 8; ++i) { const int t = tg * 8 + i; const float* a = ldsf + t * 65 + c;
            const float x0 = a[0] * w0 + a[65] * w1 + a[130] * w2 + bb;
            Y[((size_t)b * SEQ + t0 + t) * 1024 + ch0] = f2bf(x0 * ly[c * 65 + t]); }
        __syncthreads();
    }
}

template <bool INV> __device__ __forceinline__ void fft16k(float2* d, const float2* __restrict__ tw, int tid) {
    if (!INV) {
        for (int q = 4096, sh = 12; q >= 1; q >>= 2, sh -= 2) {
            const int ts = 4096 >> sh;
            for (int b = tid; b < 4096; b += 512) {
                const int j = b & (q - 1), g = b >> sh, i0 = g * 4 * q + j;
                const float2 a0 = d[i0], a1 = d[i0 + q], a2 = d[i0 + 2 * q], a3 = d[i0 + 3 * q];
                const float2 w1 = tw[j * ts], w2 = cmul(w1, w1), w3 = cmul(w2, w1);
                const float2 s02 = make_float2(a0.x + a2.x, a0.y + a2.y), d02 = make_float2(a0.x - a2.x, a0.y - a2.y);
                const float2 s13 = make_float2(a1.x + a3.x, a1.y + a3.y), d13 = make_float2(a1.x - a3.x, a1.y - a3.y);
                const float2 u0 = make_float2(s02.x + s13.x, s02.y + s13.y);
                const float2 u2 = make_float2(s02.x - s13.x, s02.y - s13.y);
                const float2 u1 = make_float2(d02.x + d13.y, d02.y - d13.x);
                const float2 u3 = make_float2(d02.x - d13.y, d02.y + d13.x);
                d[i0] = u0; d[i0 + q] = cmul(u1, w1); d[i0 + 2 * q] = cmul(u2, w2); d[i0 + 3 * q] = cmul(u3, w3);
            }
            __syncthreads();
        }
    } else {
        for (int q = 1, sh = 0; q <= 4096; q <<= 2, sh += 2) {
            const int ts = 4096 >> sh;
            for (int b = tid; b < 4096; b += 512) {
                const int j = b & (q - 1), g = b >> sh, i0 = g * 4 * q + j;
                float2 w1 = tw[j * ts]; w1.y = -w1.y; const float2 w2 = cmul(w1, w1), w3 = cmul(w2, w1);
                const float2 b0 = d[i0], b1 = cmul(d[i0 + q], w1), b2 = cmul(d[i0 + 2 * q], w2), b3 = cmul(d[i0 + 3 * q], w3);
                const float2 s02 = make_float2(b0.x + b2.x, b0.y + b2.y), d02 = make_float2(b0.x - b2.x, b0.y - b2.y);
                const float2 s13 = make_float2(b1.x + b3.x, b1.y + b3.y), d13 = make_float2(b1.x - b3.x, b1.y - b3.y);
                d[i0] = make_float2(s02.x + s13.x, s02.y + s13.y);
                d[i0 + q] = make_float2(d02.x - d13.y, d02.y + d13.x);
                d[i0 + 2 * q] = make_float2(s02.x - s13.x, s02.y - s13.y);
                d[i0 + 3 * q] = make_float2(d02.x + d13.y, d02.y - d13.x);
            }
            __syncthreads();
        }
    }
}

__device__ __forceinline__ void hy_fft(const Params& p, float2* d, int tid, int G, int bx) {
    const u16* HF = (const u16*)(p.ws + WS_HFILT); float* W = (float*)(p.ws + WS_W); const float2* tw = (const float2*)(p.ws + WS_TW);
    float2* KS = (float2*)(p.ws + WS_SCR + (size_t)bx * 262144); float2* P1 = KS + SEQ;
    for (int c = bx; c < 512; c += G) {
        const float bias = p.hy_bias[c];
        float* W0 = W + (size_t)(c * 2) * SEQ; float* W1 = W0 + SEQ;
        for (int pass = 0; pass < 2; ++pass) {
            for (int n = tid; n < SEQ; n += 512) {
                const float hf = bf2f(HF[(size_t)c * SEQ + n]); const float hb = n ? bf2f(HF[(size_t)(512 + c) * SEQ + SEQ - n]) : 0.f;
                if (pass == 0) d[n] = make_float2(hf + hb, 0.f);
                else { float s, cs; sincospif((float)n * (1.0f / SEQ), &s, &cs); const float km = hf - hb; d[n] = make_float2(km * cs, -km * s); }
            }
            __syncthreads();
            fft16k<false>(d, tw, tid);
            for (int n = tid; n < SEQ; n += 512) KS[n] = d[n];
            __syncthreads();
            for (int n = tid; n < SEQ; n += 512) {
                float2 z = make_float2(W0[n], W1[n]);
                if (pass == 1) { float s, cs; sincospif((float)n * (1.0f / SEQ), &s, &cs); z = cmul(z, make_float2(cs, -s)); }
                d[n] = z;
            }
            __syncthreads();
            fft16k<false>(d, tw, tid);
            for (int n = tid; n < SEQ; n += 512) d[n] = cmul(d[n], KS[n]);
            __syncthreads();
            fft16k<true>(d, tw, tid);
            for (int n = tid; n < SEQ; n += 512) {
                float2 r = d[n]; r.x *= (1.0f / SEQ); r.y *= (1.0f / SEQ);
                if (pass == 0) P1[n] = r;
                else { float s, cs; sincospif((float)n * (1.0f / SEQ), &s, &cs); r = cmul(r, make_float2(cs, s));
                    const float2 p1 = P1[n]; const float w0 = W0[n], w1 = W1[n];
                    W0[n] = 0.5f * (p1.x + r.x) + bias * w0; W1[n] = 0.5f * (p1.y + r.y) + bias * w1; }
            }
            __syncthreads();
        }
    }
}

__global__ void __launch_bounds__(512, 2) mega(Params p) {
    extern __shared__ __attribute__((aligned(16))) unsigned char lds[];
    cg::grid_group grid = cg::this_grid();
    const int tid = threadIdx.x, G = gridDim.x, bx = blockIdx.x;
    float* ldsf = (float*)lds;
    LAS unsigned char* ldsl = (LAS unsigned char*)lds;
    const int lo = p.ph_lo, hi = p.ph_hi;
    const float* mod = (const float*)(p.ws + WS_MOD);
    u16* U = (u16*)(p.ws + WS_U); u16* HID = (u16*)(p.ws + WS_R2); float* HCTX = (float*)(p.ws + WS_HCTX);
#ifndef PHMASK
#define PHMASK 0xFFFF
#endif
#define IN(k) (((PHMASK >> (k)) & 1) && lo <= (k) && (k) < hi)
#define SYNC(k) do { if (lo <= (k) && (k) + 1 < hi) grid.sync(); } while (0)
    if (IN(0)) phase_prep(p, ldsf, tid, G, bx);
    SYNC(0);
    if (IN(1)) { adaln_rows(p, p.x, p.ctx, MROWS, 0, 0, 1, U, tid, G, bx); hfilt_items(p, ldsf, tid, G, bx); }
    SYNC(1);
    if (IN(2)) { pg8::Gemm g{U, (const u16*)(p.ws + WS_WB0), MROWS, 2 * FF, DM}; pg8::StaticOrder S; S.init(MROWS, 2 * FF, G, bx); EpiSwiGLU E{HID};
        pg8::gemm_phase<EpiSwiGLU, pg8::StaticOrder>(ldsl, g, S, E, nullptr); }
    SYNC(2);
    if (IN(3)) { pg8::Gemm g{HID, (const u16*)(p.ws + WS_WD0), MROWS, DM, FF}; pg8::StaticOrder S; S.init(MROWS, DM, G, bx); EpiResid E{p.x, p.ctx, p.out, HCTX, mod, 2, 0.5f};
        pg8::gemm_phase<EpiResid, pg8::StaticOrder>(ldsl, g, S, E, nullptr); }
    SYNC(3);
    if (IN(4)) adaln_rows(p, p.out, HCTX, MROWS, 1, 3, 4, U, tid, G, bx);
    SYNC(4);
    if (IN(5)) { pg8::Gemm g{U, (const u16*)(p.ws + WS_WIN), MROWS, DIN, DM}; pg8::StaticOrder S; S.init(MROWS, DIN, G, bx);
        EpiInProj E{(u16*)(p.ws + WS_R2 + R2_Z), (u16*)(p.ws + WS_R2 + R2_Q), (u16*)(p.ws + WS_R2 + R2_K), (u16*)(p.ws + WS_R2 + R2_V), (const float*)(p.ws + WS_ROPE)};
        pg8::gemm_phase<EpiInProj, pg8::StaticOrder>(ldsl, g, S, E, nullptr); }
    SYNC(5);
    if (IN(6)) hy_t1(p, ldsf, tid, G, bx);
    SYNC(6);
    if (IN(7)) {
#ifndef NO_ATT
        attn_phase(p, (char*)lds, tid, G, bx);
#endif
#ifndef NO_FFT
        hy_fft(p, (float2*)lds, tid, G, bx);
#endif
    }
    SYNC(7);
    if (IN(8)) hy_t2(p, ldsf, tid, G, bx);
    SYNC(8);
    if (IN(9)) { pg8::Gemm g{U, (const u16*)(p.ws + WS_WOUT), NLAT, DM, DM}; pg8::StaticOrder S; S.init(NLAT, DM, G, bx); EpiResid E{p.out, p.out, p.out, p.out, mod, 5, 1.0f};
        pg8::gemm_phase<EpiResid, pg8::StaticOrder>(ldsl, g, S, E, nullptr); }
    SYNC(9);
    if (IN(10)) adaln_rows(p, p.out, HCTX, NLAT, 2, 6, 7, U, tid, G, bx);
    SYNC(10);
    if (IN(11)) { pg8::Gemm g{U, (const u16*)(p.ws + WS_WB1), NLAT, 2 * FF, DM}; pg8::StaticOrder S; S.init(NLAT, 2 * FF, G, bx); EpiSwiGLU E{HID};
        pg8::gemm_phase<EpiSwiGLU, pg8::StaticOrder>(ldsl, g, S, E, nullptr); }
    SYNC(11);
    if (IN(12)) { pg8::Gemm g{HID, (const u16*)(p.ws + WS_WD1), NLAT, DM, FF}; pg8::StaticOrder S; S.init(NLAT, DM, G, bx); EpiResid E{p.out, p.out, p.out, p.out, mod, 8, 0.5f};
        pg8::gemm_phase<EpiResid, pg8::StaticOrder>(ldsl, g, S, E, nullptr); }
    SYNC(12);
    if (IN(13)) final_norm(p, tid, G, bx);
#undef IN
#undef SYNC
}

extern "C" void kernel_launch(void* const* d_in, const int* in_sizes, int n_in, void* d_out, int out_size, void* d_ws, size_t ws_size, hipStream_t stream) {
    static int grid = 0;
    if (grid == 0) {
        if (n_in != 24 || ws_size < WS_END) { fprintf(stderr, "kernel_launch: n_in %d ws %zu (need %zu)\n", n_in, ws_size, (size_t)WS_END); grid = -1; return; }
        int dev = 0, cus = 0, per_cu = 0;
        hipGetDevice(&dev); hipDeviceGetAttribute(&cus, hipDeviceAttributeMultiprocessorCount, dev);
        if (hipFuncSetAttribute((const void*)mega, hipFuncAttributeMaxDynamicSharedMemorySize, LDS_BYTES) != hipSuccess) { fprintf(stderr, "kernel_launch: hipFuncSetAttribute failed\n"); grid = -1; return; }
        if (hipOccupancyMaxActiveBlocksPerMultiprocessor(&per_cu, (const void*)mega, 512, LDS_BYTES) != hipSuccess || per_cu < 1) { fprintf(stderr, "kernel_launch: occupancy query gives %d\n", per_cu); per_cu = 1; }
        (void)hipGetLastError();
        grid = cus * per_cu; if (grid > 256) grid = 256;
    }
    if (grid < 0) return;
    Params p{};
    const float** pp = (const float**)&p;
    for (int i = 0; i < 24; ++i) pp[i] = (const float*)d_in[i];
    p.out = (float*)d_out; p.ws = (unsigned char*)d_ws;
#if MULTI_LAUNCH
    for (int ph = 0; ph < NPHASE; ++ph) { p.ph_lo = ph; p.ph_hi = ph + 1; hipLaunchKernelGGL(mega, dim3(grid), dim3(512), LDS_BYTES, stream, p); }
#else
    p.ph_lo = 0; p.ph_hi = NPHASE;
    void* args[] = {&p};
    hipError_t e = hipLaunchCooperativeKernel((const void*)mega, dim3(grid), dim3(512), args, LDS_BYTES, stream);
    if (e != hipSuccess) fprintf(stderr, "cooperative launch failed: %s (grid %d)\n", hipGetErrorString(e), grid);
#endif
}
```

```cpp
#include <hip/hip_runtime.h>
#include <hip/hip_cooperative_groups.h>
#include <cstdio>
#include <cstdint>
namespace cg = cooperative_groups;
#define ATT_V4 1
namespace pg8 {
#define PG8_LAS __attribute__((address_space(3)))
typedef unsigned short bf16_t;
typedef short bf16x8 __attribute__((ext_vector_type(8)));
typedef float f32x4 __attribute__((ext_vector_type(4)));
typedef unsigned u32x4 __attribute__((ext_vector_type(4)));
constexpr int BM = 256, BK = 64, HALF = 128, HTB = HALF * BK * 2  , STAGE_BYTES = 8 * HTB, NXCD = 8, WGM = 8;

__host__ __device__ __forceinline__ int lds_byte(int r, int c) { const int st = (r >> 4) * 2 + (c >> 5), rr = r & 15, cc = c & 31, ob = rr * 64 + cc * 2; return st * 1024 + (ob ^ (((ob >> 9) & 1) << 5)); }
__host__ __device__ __forceinline__ void stage_rc(int b, int& R, int& C) { const int st = b / 1024, sb = b % 1024, swz = sb ^ (((sb >> 9) & 1) << 5); R = (st >> 1) * 16 + swz / 64; C = (st & 1) * 32 + (swz % 64) / 2; }
__host__ __device__ __forceinline__ int perm32(int rho) { const int n = rho >> 4, i = rho & 15; return 8 * (i >> 2) + 4 * n + (i & 3); }

struct Unit { int pm, pn, ko; };
struct Gemm { const bf16_t* A; const bf16_t* Bt; int M, N, K, ld; };

struct StaticOrder {
    int nM, nN, nwg, G, c, dsh;
    __host__ __device__ void init(int M, int N, int G_, int c_) { nM = M / BM; nN = N / BM; nwg = nM * nN; G = G_; c = c_; dsh = 0; }
    __host__ __device__ bool next(int i, Unit& u) const {
        const long L = (long)(i >> dsh) * G + c; if (L >= nwg) return false;
        int wgid = (int)L; { const int q = nwg / NXCD, r = nwg % NXCD, xcd = wgid % NXCD, off = wgid / NXCD; wgid = (xcd < r ? xcd * (q + 1) : r * (q + 1) + (xcd - r) * q) + off; }
        const int nig = WGM * nN, gid = wgid / nig, fm = gid * WGM, gsz = (nM - fm) < WGM ? (nM - fm) : WGM;
        u.pm = fm + ((wgid % nig) % gsz); u.pn = (wgid % nig) / gsz; u.ko = 0; return true;
    }
    __device__ __forceinline__ void a_ready(const Unit&) const {}
    __device__ __forceinline__ void done(const Unit&) const {}
};
__device__ __forceinline__ unsigned cvt_pk_bf16(float lo, float hi) { unsigned r; asm volatile("v_cvt_pk_bf16_f32 %0, %1, %2" : "=v"(r) : "v"(lo), "v"(hi)); return r; }
typedef float f32x2 __attribute__((ext_vector_type(2)));
template <class Epi, class Sched, bool STAMP = false>
__device__ __forceinline__ void gemm_phase(PG8_LAS unsigned char* lds, const Gemm g, const Sched& S, const Epi& E, unsigned long long* stamps) {
    const int tid = threadIdx.x, wid = __builtin_amdgcn_readfirstlane(tid >> 6), lane = tid & 63, wr = wid >> 2, wc = wid & 3, fr = lane & 15, fq = lane >> 4;
    const int K = g.K, nt = K / BK;
    int ts_lo = 0, ts_hi = 0, nts = 0; const unsigned long long rt_entry = STAMP ? (unsigned long long)wall_clock64() : 0ull;
#define PG8_STAMP() do { if (STAMP && wid == 0 && nts < 64) { const unsigned long long _c = (unsigned long long)clock64(); \
        ts_lo = (lane == nts) ? (int)(unsigned)_c : ts_lo; ts_hi = (lane == nts) ? (int)(unsigned)(_c >> 32) : ts_hi; ++nts; } } while (0)
    PG8_STAMP();
    unsigned voffA[2], voffB[2];
#pragma unroll
    for (int i = 0; i < 2; ++i) { int R, C; stage_rc(tid * 16 + i * 8192, R, C); const int Rb = Epi::PERM ? ((R & ~31) + perm32(R & 31)) : R;
        voffA[i] = (unsigned)(R * g.ld + C) * 2u; voffB[i] = (unsigned)(Rb * g.ld + C) * 2u; }
    const size_t kstep = (size_t)(BK * 2);
    const size_t hstep = (size_t)HALF * g.ld * 2;
    const size_t tstep = 2 * hstep;
    const unsigned ldsw = (unsigned)wid * 1024u;
    const int aoff = lds_byte(wr * 64 + fr, fq * 8), boff = lds_byte(wc * 32 + fr, fq * 8);
#define PG8_SA(b, h) (((b) * 2 + (h)) * HTB)
#define PG8_SB(b, h) ((4 + (b) * 2 + (h)) * HTB)
#define PG8_STAGE(bufoff, gbase, voff) do { _Pragma("unroll") for (int _i = 0; _i < 2; ++_i) \
        __builtin_amdgcn_global_load_lds((const unsigned*)((const char*)(gbase) + (voff)[_i]), (PG8_LAS unsigned*)(lds + (bufoff) + ldsw + _i * 8192), 16, 0, 0); } while (0)
#define PG8_LDA(dst, b, h) do { _Pragma("unroll") for (int m = 0; m < 4; ++m) _Pragma("unroll") for (int k = 0; k < 2; ++k) dst[m][k] = *(const PG8_LAS bf16x8*)(lds + PG8_SA(b, h) + aoff + m * 2048 + k * 1024); } while (0)
#define PG8_LDB(dst, b, h) do { _Pragma("unroll") for (int n = 0; n < 2; ++n) _Pragma("unroll") for (int k = 0; k < 2; ++k) dst[n][k] = *(const PG8_LAS bf16x8*)(lds + PG8_SB(b, h) + boff + n * 2048 + k * 1024); } while (0)
#define PG8_MMA(ai, bj, At, Bt) do { __builtin_amdgcn_s_setprio(1); _Pragma("unroll") for (int m = 0; m < 4; ++m) _Pragma("unroll") for (int n = 0; n < 2; ++n) _Pragma("unroll") for (int k = 0; k < 2; ++k) \
        acc[ai][bj][m][n] = __builtin_amdgcn_mfma_f32_16x16x32_bf16(Bt[n][k], At[m][k], acc[ai][bj][m][n], 0, 0, 0); __builtin_amdgcn_s_setprio(0); } while (0)
#define PG8_WAIT_V(n) asm volatile("s_waitcnt vmcnt(" #n ")" ::: "memory")
#define PG8_WAIT_L(n) asm volatile("s_waitcnt lgkmcnt(" #n ")" ::: "memory")
#define PG8_BAR __builtin_amdgcn_s_barrier()
#define PG8_SCHED __builtin_amdgcn_sched_barrier(0)
    Unit cur, nxt; int ui = 0;
    if (!S.next(0, cur)) return;
    f32x4 acc[2][2][4][2];
#pragma unroll
    for (int a = 0; a < 2; ++a)
#pragma unroll
        for (int b = 0; b < 2; ++b)
#pragma unroll
            for (int m = 0; m < 4; ++m)
#pragma unroll
                for (int n = 0; n < 2; ++n) acc[a][b][m][n] = (f32x4){0.f, 0.f, 0.f, 0.f};
    bf16x8 At[4][2], B0[2][2], B1[2][2];
    const char* cA = (const char*)g.A + (size_t)cur.pm * tstep + cur.ko; const char* cB = (const char*)g.Bt + (size_t)cur.pn * tstep + cur.ko;
    S.a_ready(cur);
    PG8_STAGE(PG8_SB(0, 0), cB, voffB); PG8_STAGE(PG8_SA(0, 0), cA, voffA); PG8_STAGE(PG8_SB(0, 1), cB + hstep, voffB); PG8_STAGE(PG8_SA(0, 1), cA + hstep, voffA);
    if (wr == 1) PG8_BAR;
    PG8_WAIT_V(4); PG8_BAR;
    PG8_STAGE(PG8_SB(1, 0), cB + kstep, voffB); PG8_STAGE(PG8_SA(1, 0), cA + kstep, voffA); PG8_STAGE(PG8_SB(1, 1), cB + hstep + kstep, voffB);
    PG8_WAIT_V(6); PG8_BAR;
    PG8_STAMP();
    for (;;) {
        const bool has_next = S.next(ui + 1, nxt);
        const char* nA = has_next ? (const char*)g.A + (size_t)nxt.pm * tstep + nxt.ko : cA; const char* nB = has_next ? (const char*)g.Bt + (size_t)nxt.pn * tstep + nxt.ko : cB;
        for (int t = 0; t < nt; t += 2) {
            const bool last = (t == nt - 2);
            const char* a1 = cA + (size_t)(t + 1) * kstep;
            const char* a2 = last ? nA : cA + (size_t)(t + 2) * kstep; const char* b2 = last ? nB : cB + (size_t)(t + 2) * kstep;
            const char* a3 = a2 + kstep; const char* b3 = b2 + kstep;
            if (last && has_next) S.a_ready(nxt);
            PG8_LDB(B0, 0, 0); PG8_SCHED; PG8_LDA(At, 0, 0); PG8_STAGE(PG8_SA(1, 1), a1 + hstep, voffA);
            PG8_WAIT_L(8); PG8_BAR; PG8_WAIT_L(0); PG8_MMA(0, 0, At, B0); PG8_BAR; PG8_SCHED;
            PG8_LDB(B1, 0, 1); PG8_STAGE(PG8_SB(0, 0), b2, voffB);
            PG8_BAR; PG8_WAIT_L(0); PG8_MMA(0, 1, At, B1); PG8_BAR;
            PG8_LDA(At, 0, 1); PG8_STAGE(PG8_SA(0, 0), a2, voffA);
            PG8_BAR; PG8_WAIT_L(0); PG8_MMA(1, 0, At, B0); PG8_BAR; PG8_SCHED;
            PG8_STAGE(PG8_SB(0, 1), b2 + hstep, voffB);
            PG8_WAIT_V(6); PG8_BAR; PG8_MMA(1, 1, At, B1); PG8_BAR;
            PG8_LDB(B0, 1, 0); PG8_SCHED; PG8_LDA(At, 1, 0); PG8_STAGE(PG8_SA(0, 1), a2 + hstep, voffA);
            PG8_WAIT_L(8); PG8_BAR; PG8_WAIT_L(0); PG8_MMA(0, 0, At, B0); PG8_BAR; PG8_SCHED;
            PG8_LDB(B1, 1, 1); PG8_STAGE(PG8_SB(1, 0), b3, voffB);
            PG8_BAR; PG8_WAIT_L(0); PG8_MMA(0, 1, At, B1); PG8_BAR;
            PG8_LDA(At, 1, 1); PG8_STAGE(PG8_SA(1, 0), a3, voffA);
            PG8_BAR; PG8_WAIT_L(0); PG8_MMA(1, 0, At, B0); PG8_BAR; PG8_SCHED;
            PG8_STAGE(PG8_SB(1, 1), b3 + hstep, voffB);
            PG8_WAIT_V(6); PG8_BAR; PG8_MMA(1, 1, At, B1); PG8_BAR;
        }
        PG8_STAMP();
        if constexpr (!Epi::AFTER_DRAIN) { E(acc, cur, wr, wc, fr, fq); S.done(cur); }
        PG8_STAMP();
        if (!has_next) break;
#pragma unroll
        for (int a = 0; a < 2; ++a)
#pragma unroll
            for (int b = 0; b < 2; ++b)
#pragma unroll
                for (int m = 0; m < 4; ++m)
#pragma unroll
                    for (int n = 0; n < 2; ++n) acc[a][b][m][n] = (f32x4){0.f, 0.f, 0.f, 0.f};
        cur = nxt; cA = nA; cB = nB; ++ui;
    }
    PG8_WAIT_V(0);
    if (wr == 0) PG8_BAR;
    PG8_BAR;
    if constexpr (Epi::AFTER_DRAIN) { E.fused(acc, cur, wr, wc, fr, fq, lds, wid, lane); S.done(cur); }
    PG8_STAMP();
    if (STAMP && wid == 0) { stamps[lane] = lane < nts ? (((unsigned long long)(unsigned)ts_hi << 32) | (unsigned)ts_lo) : 0ull;
        if (lane == 62) stamps[62] = rt_entry; if (lane == 63) stamps[63] = (unsigned long long)wall_clock64(); }
#undef PG8_STAMP
#undef PG8_SA
#undef PG8_SB
#undef PG8_STAGE
#undef PG8_LDA
#undef PG8_LDB
#undef PG8_MMA
#undef PG8_WAIT_V
#undef PG8_WAIT_L
#undef PG8_BAR
#undef PG8_SCHED
}
}
#define XB_LAS __attribute__((address_space(3)))

#define XB_TMO      128
#define XB_XCNT(j)  (256  + 64 * (j))
#define XB_XSUB(j)  (1280 + 64 * (j))
#define XB_XGEN(j)  (2304 + 64 * (j))
#define XB_TOP      3328
#define XB_TOPGEN   3392
#define XCD_BAR_WORDS 3456
#define XB_SPIN_CAP (1u << 18)

__device__ __forceinline__ unsigned xb_ld(unsigned* p)              { return __hip_atomic_load(p, __ATOMIC_RELAXED, __HIP_MEMORY_SCOPE_AGENT); }
__device__ __forceinline__ unsigned xb_add(unsigned* p, unsigned v) { return __hip_atomic_fetch_add(p, v, __ATOMIC_RELAXED, __HIP_MEMORY_SCOPE_AGENT); }
__device__ __forceinline__ unsigned xb_xcc_id() { return (unsigned)__builtin_amdgcn_s_getreg((3 << 11) | 20) & 0xFu; }
#define XB_SPIN(cond, bar) do { unsigned _sp = 0; while (cond) { __builtin_amdgcn_s_sleep(1); \
    if ((++_sp & 255u) == 0u) { if (xb_ld(&(bar)[XB_TMO])) break; if (_sp > XB_SPIN_CAP) { atomicAdd(&(bar)[XB_TMO], 1u); break; } } } } while (0)

struct XcdBarrier {
    unsigned* bar; unsigned x;
    volatile XB_LAS unsigned* st;
};

__device__ __forceinline__ XcdBarrier xcd_barrier_post(unsigned* bar, volatile XB_LAS unsigned* st) {
    XcdBarrier b; b.bar = bar; b.x = xb_xcc_id(); b.st = st;
    if (threadIdx.x == 0) (void)xb_add(&bar[XB_XCNT(b.x)], 1u);
    return b;
}
__device__ __forceinline__ void xcd_barrier_complete(unsigned* bar, unsigned x, unsigned& nloc, unsigned& nx) {
    const unsigned G = gridDim.x * gridDim.y * gridDim.z;
    unsigned sum, cnt, mine, sp = 0u;
    for (;;) {
        sum = 0u; cnt = 0u; mine = 0u;
#pragma unroll
        for (unsigned j = 0; j < 16; ++j) { const unsigned c = xb_ld(&bar[XB_XCNT(j)]); sum += c; cnt += (c > 0u) ? 1u : 0u; mine = (j == x) ? c : mine; }
        if (sum == G) break;
        __builtin_amdgcn_s_sleep(1);
        if ((++sp & 255u) == 0u) { if (xb_ld(&bar[XB_TMO])) break; if (sp > XB_SPIN_CAP) { atomicAdd(&bar[XB_TMO], 1u); break; } }
    }
    nloc = mine > 0u ? mine : 1u; nx = cnt > 0u ? cnt : 1u;
}

__device__ __forceinline__ void xcd_barrier(const XcdBarrier& b) {
    asm volatile("s_waitcnt vmcnt(0)" ::: "memory");
    __syncthreads();
    if (threadIdx.x == 0) {
        unsigned* bar = b.bar;
        __builtin_amdgcn_s_waitcnt(0);
        unsigned nloc = b.st[0], nx = b.st[1];
        if (nloc == 0u) { xcd_barrier_complete(bar, b.x, nloc, nx); b.st[0] = nloc; b.st[1] = nx; }
        const unsigned old = xb_add(&bar[XB_XSUB(b.x)], 1u);
        const unsigned gen = old / nloc;
        if (old + 1u == (gen + 1u) * nloc) {
            __builtin_amdgcn_fence(__ATOMIC_RELEASE, "agent");
            asm volatile("s_waitcnt vmcnt(0)" ::: "memory");
            const unsigned og = xb_add(&bar[XB_TOP], 1u);
            const unsigned tg = og / nx;
            if (og + 1u == (tg + 1u) * nx) xb_add(&bar[XB_TOPGEN], 1u);
            else XB_SPIN(xb_ld(&bar[XB_TOPGEN]) == tg, bar);
            __builtin_amdgcn_fence(__ATOMIC_ACQUIRE, "agent");
            xb_add(&bar[XB_XGEN(b.x)], 1u);
            asm volatile("s_waitcnt vmcnt(0)" ::: "memory");
        } else {
            XB_SPIN(xb_ld(&bar[XB_XGEN(b.x)]) == gen, bar);
            __builtin_amdgcn_fence(__ATOMIC_ACQUIRE, "agent");
            asm volatile("s_waitcnt vmcnt(0)" ::: "memory");
        }
    }
    __syncthreads();
}


using pg8::f32x4; using pg8::bf16x8; using pg8::u32x4; using pg8::Unit;
typedef unsigned short u16;
#define LAS PG8_LAS
constexpr int DM = 1024, SEQ = 16384, CTXL = 256, NLAT = 2 * SEQ, NCTX = 2 * CTXL, MROWS = NLAT + NCTX;
constexpr int FF = 2816, DIN = 3072, NKEY = SEQ + CTXL, NADA = 9 * DM;
constexpr int LDS_MAIN = 150528;
constexpr int LDS_BYTES = LDS_MAIN + 16;
#ifndef MULTI_LAUNCH
#define MULTI_LAUNCH 0
#endif
constexpr int NPHASE = 14;

constexpr size_t al256(size_t x) { return (x + 255) / 256 * 256; }
constexpr size_t WS_WB0 = 0;
constexpr size_t WS_WD0 = WS_WB0 + al256((size_t)2 * FF * DM * 2);
constexpr size_t WS_WB1 = WS_WD0 + al256((size_t)DM * FF * 2);
constexpr size_t WS_WD1 = WS_WB1 + al256((size_t)2 * FF * DM * 2);
constexpr size_t WS_WIN = WS_WD1 + al256((size_t)DM * FF * 2);
constexpr size_t WS_WOUT = WS_WIN + al256((size_t)DIN * DM * 2);
constexpr size_t WS_MOD = WS_WOUT + al256((size_t)DM * DM * 2);
constexpr size_t WS_ROPE = WS_MOD + al256((size_t)3 * NADA * 4);
constexpr size_t WS_TW = WS_ROPE + al256((size_t)256 * 16 * 8);
constexpr size_t WS_OM = WS_TW + al256((size_t)4096 * 8);
constexpr size_t WS_H3 = WS_OM + al256((size_t)SEQ * 8);
constexpr size_t WS_HFILT = WS_H3 + al256((size_t)SEQ * 64 * 4);
constexpr size_t WS_HCTX = WS_HFILT + al256((size_t)1024 * SEQ * 2);
constexpr size_t WS_U = WS_HCTX + al256((size_t)NCTX * DM * 4);
constexpr size_t WS_R2 = WS_U + al256((size_t)MROWS * DM * 2);
constexpr size_t R2_Z = 0, R2_Q = R2_Z + (size_t)NLAT * 1536 * 2, R2_K = R2_Q + (size_t)NLAT * 512 * 2, R2_V = R2_K + (size_t)2 * NKEY * 512 * 2, R2_END = R2_V + (size_t)2 * NKEY * 512 * 2;
constexpr size_t R2_SIZE = R2_END > (size_t)MROWS * FF * 2 ? R2_END : (size_t)MROWS * FF * 2;
constexpr size_t WS_W = WS_R2 + al256(R2_SIZE);
constexpr size_t WS_SCR = WS_W + al256((size_t)512 * 2 * SEQ * 4);
constexpr size_t WS_BAR = WS_SCR + (size_t)256 * 262144;
constexpr size_t WS_KN2 = WS_BAR + al256((size_t)XCD_BAR_WORDS * 4);
constexpr size_t WS_END = WS_KN2 + 256;

struct Params {
    const float *x, *c, *ctx, *c_ctx, *ada_w, *ada_b, *norm_g, *w_gate, *w_up, *w_down, *w_in, *w_out, *conv_w, *conv_b, *f_w1, *f_b1, *f_wi, *f_bi, *f_freq, *f_wout, *hy_bias, *lam, *subln_g, *final_g;
    float* out; unsigned char* ws; int ph_lo, ph_hi;
};

__device__ __forceinline__ float bf2f(u16 b) { return __uint_as_float(((unsigned)b) << 16); }
__device__ __forceinline__ u16 f2bf(float f) { unsigned u = __float_as_uint(f); u += 0x7FFFu + ((u >> 16) & 1u); return (u16)(u >> 16); }
__device__ __forceinline__ unsigned pk2(float lo, float hi) { return pg8::cvt_pk_bf16(lo, hi); }
__device__ __forceinline__ float2 cmul(float2 a, float2 b) { return make_float2(a.x * b.x - a.y * b.y, a.x * b.y + a.y * b.x); }
__device__ __forceinline__ float silu_f(float v) { return v * __builtin_amdgcn_rcpf(1.0f + __builtin_amdgcn_exp2f(-1.4426950408889634f * v)); }

__device__ __forceinline__ void transpose_tile(const float* __restrict__ src, u16* __restrict__ dst, int K, int N, int mode, int tile, float* ldsf, int tid) {
    const int ntn = N >> 6, tk = tile / ntn, tn = tile - tk * ntn, k0 = tk * 64, n0 = tn * 64;
#pragma unroll
    for (int i = 0; i < 8; ++i) { const int k = (tid >> 6) + 8 * i, n = tid & 63; ldsf[k * 65 + n] = src[(size_t)(k0 + k) * N + n0 + n]; }
    __syncthreads();
    const int nl = tid >> 3, ks = (tid & 7) * 8;
    float v[8];
#pragma unroll
    for (int j = 0; j < 8; ++j) v[j] = ldsf[(ks + j) * 65 + nl];
    const int nn = n0 + nl;
    const int row = mode == 0 ? nn : ((nn >> 7) * 256 + (nn & 127) + (mode == 2 ? 128 : 0));
    u32x4 w; w.x = pk2(v[0], v[1]); w.y = pk2(v[2], v[3]); w.z = pk2(v[4], v[5]); w.w = pk2(v[6], v[7]);
    *(u32x4*)(dst + (size_t)row * K + k0 + ks) = w;
    __syncthreads();
}

__device__ __forceinline__ void mod_item(const Params& p, int item, float* ldsf, int tid_) {
    int tid = tid_; asm volatile("" : "+v"(tid));
    const int wave = tid >> 6, lane = tid & 63, col = item * 64 + lane;
    float a0 = 0.f, a1 = 0.f, a2 = 0.f;
    const float* aw = p.ada_w + (size_t)(wave * 128) * NADA + col;
#pragma unroll 16
    for (int k = 0; k < 128; ++k) {
        const int kk = wave * 128 + k;
        const float w = aw[(size_t)k * NADA];
        a0 += silu_f(p.c[kk]) * w; a1 += silu_f(p.c[DM + kk]) * w; a2 += silu_f(p.c_ctx[kk]) * w;
    }
    ldsf[(wave * 3 + 0) * 64 + lane] = a0; ldsf[(wave * 3 + 1) * 64 + lane] = a1; ldsf[(wave * 3 + 2) * 64 + lane] = a2;
    __syncthreads();
    if (tid < 192) { const int v = tid >> 6; float s = p.ada_b[col];
#pragma unroll
        for (int w = 0; w < 8; ++w) s += ldsf[(w * 3 + v) * 64 + lane];
        ((float*)(p.ws + WS_MOD))[v * NADA + col] = s; }
    __syncthreads();
}

__device__ __forceinline__ void filt_block(const Params& p, int blk, float* ldsf, int tid_) {
    int tid = tid_; asm volatile("" : "+v"(tid));
    const int wave = tid >> 6, lane = tid & 63, n0 = (blk * 8 + wave) * 8;
    float* hb = ldsf + wave * 512;
#pragma unroll 1
    for (int q = 0; q < 8; ++q) { const int n = n0 + q;
        const float t = (float)n / (float)(SEQ - 1);
        const float omega = (2.0f * 3.14159265358979323846f / (float)SEQ) * (float)n;
        if (lane == 0) hb[q * 64] = t;
        if (lane < 32) { const int k = lane & 15; const float band = 1e-4f + (15.0f - 1e-4f) * (float)k / 15.0f; const float ang = omega * band;
            hb[q * 64 + 1 + lane] = lane < 16 ? cosf(ang) : -sinf(ang); } }
    __syncthreads();
    const float fr = p.f_freq[lane];
    float acc[8], h[8];
#pragma unroll
    for (int q = 0; q < 8; ++q) acc[q] = p.f_b1[lane];
    for (int i = 0; i < 33; ++i) { const float w = p.f_w1[i * 64 + lane];
#pragma unroll
        for (int q = 0; q < 8; ++q) acc[q] += hb[q * 64 + i] * w; }
#pragma unroll
    for (int q = 0; q < 8; ++q) h[q] = __sinf(fr * acc[q]);
    __syncthreads();
    for (int l = 0; l < 2; ++l) {
#pragma unroll
        for (int q = 0; q < 8; ++q) hb[q * 64 + lane] = h[q];
        __syncthreads();
        const float* wi = p.f_wi + l * 4096;
#pragma unroll
        for (int q = 0; q < 8; ++q) acc[q] = p.f_bi[l * 64 + lane];
#pragma unroll 4
        for (int i = 0; i < 64; ++i) { const float w = wi[i * 64 + lane];
#pragma unroll
            for (int q = 0; q < 8; ++q) acc[q] += hb[q * 64 + i] * w; }
#pragma unroll
        for (int q = 0; q < 8; ++q) h[q] = __sinf(fr * acc[q]);
        __syncthreads();
    }
#pragma unroll
    for (int q = 0; q < 8; ++q) ((float*)(p.ws + WS_H3))[(n0 + q) * 64 + lane] = h[q];
}

__device__ __forceinline__ void tr_decode(const Params& p, int t, const float*& src, u16*& dst, int& K, int& N, int& mode, int& k0, int& n0) {
    if (t < 2816) { const int mm = t / 704; t -= mm * 704; const int layer = mm >> 1; K = DM; N = FF; mode = 1 + (mm & 1);
        src = ((mm & 1) ? p.w_up : p.w_gate) + (size_t)layer * DM * FF; dst = (u16*)(p.ws + (layer ? WS_WB1 : WS_WB0)); }
    else if (t < 4224) { t -= 2816; const int layer = t / 704; t -= layer * 704; K = FF; N = DM; mode = 0; src = p.w_down + (size_t)layer * FF * DM; dst = (u16*)(p.ws + (layer ? WS_WD1 : WS_WD0)); }
    else if (t < 4992) { t -= 4224; K = DM; N = DIN; mode = 0; src = p.w_in; dst = (u16*)(p.ws + WS_WIN); }
    else { t -= 4992; K = DM; N = DM; mode = 0; src = p.w_out; dst = (u16*)(p.ws + WS_WOUT); }
    const int ntn = N >> 6, tk = t / ntn, tn = t - tk * ntn; k0 = tk * 64; n0 = tn * 64;
}
__device__ __forceinline__ void transpose_all(const Params& p, float* ldsf, int tid_, int G, int bx) {
    int tid = tid_; asm volatile("" : "+v"(tid));
    constexpr int NTILE = 5248, BUF = 64 * 65;
    float va[8], vb[8];
#define TR_LOAD(v, t_) do { const float* s_; u16* d_; int K_, N_, m_, k0_, n0_; tr_decode(p, (t_), s_, d_, K_, N_, m_, k0_, n0_);               \
        _Pragma("unroll") for (int i = 0; i < 8; ++i) v[i] = s_[(size_t)(k0_ + (tid >> 6) + 8 * i) * N_ + n0_ + (tid & 63)]; } while (0)
#define TR_EMIT(v, t_, buf_) do { float* lb_ = ldsf + (buf_) * BUF;                                                                            \
        _Pragma("unroll") for (int i = 0; i < 8; ++i) lb_[((tid >> 6) + 8 * i) * 65 + (tid & 63)] = v[i];                                      \
        __syncthreads();                                                                                                                        \
        if ((t_) + 2 * G < NTILE) TR_LOAD(v, (t_) + 2 * G);                                                                                     \
        { const float* s_; u16* d_; int K_, N_, m_, k0_, n0_; tr_decode(p, (t_), s_, d_, K_, N_, m_, k0_, n0_);                                 \
          const int nl = tid >> 3, ks = (tid & 7) * 8; float w_[8];                                                                             \
          _Pragma("unroll") for (int j = 0; j < 8; ++j) w_[j] = lb_[(ks + j) * 65 + nl];                                                        \
          const int nn = n0_ + nl; const int row = m_ == 0 ? nn : ((nn >> 7) * 256 + (nn & 127) + (m_ == 2 ? 128 : 0));                         \
          u32x4 o_; o_.x = pk2(w_[0], w_[1]); o_.y = pk2(w_[2], w_[3]); o_.z = pk2(w_[4], w_[5]); o_.w = pk2(w_[6], w_[7]);                      \
          *(u32x4*)(d_ + (size_t)row * K_ + k0_ + ks) = o_; } } while (0)
    int t = bx;
    if (t < NTILE) TR_LOAD(va, t);
    if (t + G < NTILE) TR_LOAD(vb, t + G);
    for (; t < NTILE; t += 2 * G) {
        TR_EMIT(va, t, 0);
        if (t + G < NTILE) TR_EMIT(vb, t + G, 1);
    }
    __syncthreads();
#undef TR_LOAD
#undef TR_EMIT
}
__device__ __forceinline__ void phase_prep(const Params& p, float* ldsf, int tid, int G, int bx) {
    if (bx == 0 && tid < 16) ((float*)(p.ws + WS_KN2))[tid] = 0.f;
    for (int it = bx; it < 144; it += G) mod_item(p, it, ldsf, tid);
    for (int it = bx; it < 256; it += G) filt_block(p, (it + 144) % 256, ldsf, tid);
    for (int it = bx; it < 8; it += G) { const int idx = it * 512 + tid, pos = idx >> 4, f = idx & 15;
        const float invf = powf(10000.0f, -(float)(2 * f) / 32.0f); float s, c; sincosf((float)pos * invf, &s, &c);
        ((float2*)(p.ws + WS_ROPE))[idx] = make_float2(c, s); }
    for (int it = bx; it < 40; it += G) {
        if (it < 8) { const int n = it * 512 + tid; float s, c; sincospif((float)n / 8192.0f, &s, &c); ((float2*)(p.ws + WS_TW))[n] = make_float2(c, -s); }
        else { const int n = (it - 8) * 512 + tid; float s, c; sincospif((float)n * (1.0f / SEQ), &s, &c); ((float2*)(p.ws + WS_OM))[n] = make_float2(c, -s); } }
    __syncthreads();
    transpose_all(p, ldsf, tid, G, bx);
}

__device__ __forceinline__ void adaln_rows(const Params& p, const float* lat, const float* ctxp, int rbeg, int nrows, int gi, int kshift, int kscale, u16* U, float* copy_ctx, int tid, int G, int bx) {
    const int wave = tid >> 6, lane = tid & 63;
    const float* g = p.norm_g + gi * DM; const float* mod = (const float*)(p.ws + WS_MOD);
    const int stride = G * 8;
    for (int r0 = rbeg + bx * 8 + wave; r0 < nrows; r0 += 4 * stride) {
        f32x4 v[4][4]; float ss[4] = {0.f, 0.f, 0.f, 0.f};
#pragma unroll
        for (int q = 0; q < 4; ++q) { const int r = r0 + q * stride; const int rr = r < nrows ? r : r0;
            const float* src = rr < NLAT ? lat + (size_t)rr * DM : ctxp + (size_t)(rr - NLAT) * DM;
#pragma unroll
            for (int i = 0; i < 4; ++i) v[q][i] = *(const f32x4*)(src + i * 256 + lane * 4); }
#pragma unroll
        for (int q = 0; q < 4; ++q) {
#pragma unroll
            for (int i = 0; i < 4; ++i) ss[q] += v[q][i][0] * v[q][i][0] + v[q][i][1] * v[q][i][1] + v[q][i][2] * v[q][i][2] + v[q][i][3] * v[q][i][3];
#pragma unroll
            for (int o = 32; o >= 1; o >>= 1) ss[q] += __shfl_xor(ss[q], o); }
#pragma unroll
        for (int q = 0; q < 4; ++q) { const int r = r0 + q * stride; if (r >= nrows) break;
            const int sel = r < NLAT ? (r >> 14) : 2;
            const float rs = rsqrtf(ss[q] * (1.0f / DM) + 1e-6f);
            const float* sh = mod + sel * NADA + kshift * DM; const float* sc = mod + sel * NADA + kscale * DM;
#pragma unroll
            for (int i = 0; i < 4; ++i) { const int c = i * 256 + lane * 4;
                const f32x4 gg = *(const f32x4*)(g + c), s4 = *(const f32x4*)(sh + c), c4 = *(const f32x4*)(sc + c);
                f32x4 y = v[q][i] * rs * gg * (c4 + 1.0f) + s4;
                uint2 w; w.x = pk2(y[0], y[1]); w.y = pk2(y[2], y[3]);
                *(uint2*)(U + (size_t)r * DM + c) = w;
                if (copy_ctx && r >= NLAT) *(f32x4*)(copy_ctx + (size_t)(r - NLAT) * DM + c) = v[q][i]; } }
    }
}
__device__ __forceinline__ void final_norm(const Params& p, int tid, int G, int bx) {
    const int wave = tid >> 6, lane = tid & 63, stride = G * 8;
    for (int r0 = bx * 8 + wave; r0 < NLAT; r0 += 4 * stride) {
        f32x4 v[4][4]; float ss[4] = {0.f, 0.f, 0.f, 0.f};
#pragma unroll
        for (int q = 0; q < 4; ++q) { const int r = r0 + q * stride < NLAT ? r0 + q * stride : r0; const float* src = p.out + (size_t)r * DM;
#pragma unroll
            for (int i = 0; i < 4; ++i) v[q][i] = *(const f32x4*)(src + i * 256 + lane * 4); }
#pragma unroll
        for (int q = 0; q < 4; ++q) {
#pragma unroll
            for (int i = 0; i < 4; ++i) ss[q] += v[q][i][0] * v[q][i][0] + v[q][i][1] * v[q][i][1] + v[q][i][2] * v[q][i][2] + v[q][i][3] * v[q][i][3];
#pragma unroll
            for (int o = 32; o >= 1; o >>= 1) ss[q] += __shfl_xor(ss[q], o); }
#pragma unroll
        for (int q = 0; q < 4; ++q) { const int r = r0 + q * stride; if (r >= NLAT) break;
            const float rs = rsqrtf(ss[q] * (1.0f / DM) + 1e-6f); float* dst = p.out + (size_t)r * DM;
#pragma unroll
            for (int i = 0; i < 4; ++i) { const int c = i * 256 + lane * 4; const f32x4 gg = *(const f32x4*)(p.final_g + c); *(f32x4*)(dst + c) = v[q][i] * rs * gg; } }
    }
}

__device__ __forceinline__ void hfilt_items(const Params& p, float* ldsf, int tid, int G, int bx) {
    const float* h3 = (const float*)(p.ws + WS_H3); u16* HF = (u16*)(p.ws + WS_HFILT);
    for (int it = bx; it < 512; it += G) {
        const int nblk = it >> 4, cch = it & 15, n = nblk * 512 + tid;
#pragma unroll
        for (int e = 0; e < 8; ++e) { const int idx = tid + e * 512, i = idx >> 6, cc = idx & 63; ldsf[cc * 64 + i] = p.f_wout[i * 1024 + cch * 64 + cc]; }
        f32x4 h[16];
#pragma unroll
        for (int i = 0; i < 16; ++i) h[i] = *(const f32x4*)(h3 + (size_t)n * 64 + i * 4);
        __syncthreads();
        const float t = (float)n / (float)(SEQ - 1);
        for (int cc = 0; cc < 64; ++cc) {
            float acc = 0.f;
#pragma unroll
            for (int i = 0; i < 16; ++i) { const f32x4 w = *(const f32x4*)(ldsf + cc * 64 + i * 4); acc += h[i][0] * w[0] + h[i][1] * w[1] + h[i][2] * w[2] + h[i][3] * w[3]; }
            const int cp = cch * 64 + cc, c = cp & 511;
            const float mind = -3.0701134573253944f, maxd = -15.350567286626972f;
            const float delta = fabsf(mind + (maxd - mind) * ((float)c / 511.0f));
            HF[(size_t)cp * SEQ + n] = f2bf(acc * __expf(-t * delta));
        }
        __syncthreads();
    }
}

struct EpiSwiGLU {
    static constexpr bool PERM = true, AFTER_DRAIN = false;
    u16* O;
    __device__ __forceinline__ void operator()(const f32x4 (&acc)[2][2][4][2], const Unit& u, int wr, int wc, int fr, int fq) const {
        const int row0 = u.pm * 256 + wr * 64 + fr, j0 = u.pn * 128 + wc * 32 + 8 * fq;
#pragma unroll
        for (int ai = 0; ai < 2; ++ai)
#pragma unroll
            for (int m = 0; m < 4; ++m) {
                const f32x4 g0 = acc[ai][0][m][0], g1 = acc[ai][0][m][1], u0 = acc[ai][1][m][0], u1 = acc[ai][1][m][1];
                float h[8];
#pragma unroll
                for (int j = 0; j < 4; ++j) { h[j] = silu_f(g0[j]) * u0[j]; h[4 + j] = silu_f(g1[j]) * u1[j]; }
                u32x4 w; w.x = pk2(h[0], h[1]); w.y = pk2(h[2], h[3]); w.z = pk2(h[4], h[5]); w.w = pk2(h[6], h[7]);
                *(u32x4*)(O + (size_t)(row0 + ai * 128 + m * 16) * FF + j0) = w;
            }
    }
};
struct EpiResid {
    static constexpr bool PERM = false, AFTER_DRAIN = false;
    const float* src_lat; const float* src_ctx; float* dst_lat; float* dst_ctx; const float* mod; int modk; float coef;
    __device__ __forceinline__ void operator()(const f32x4 (&acc)[2][2][4][2], const Unit& u, int wr, int wc, int fr, int fq) const {
        const bool isctx = u.pm >= 128; const int sel = isctx ? 2 : (u.pm >> 6);
        const size_t rb = (size_t)(isctx ? (u.pm - 128) : u.pm) * 256 * DM;
        const float* src = (isctx ? src_ctx : src_lat) + rb; float* dst = (isctx ? dst_ctx : dst_lat) + rb;
        const float* gv = mod + sel * NADA + modk * DM;
        const int col0 = u.pn * 256 + wc * 32 + 4 * fq, r0 = wr * 64 + fr;
#pragma unroll
        for (int bj = 0; bj < 2; ++bj)
#pragma unroll
            for (int n = 0; n < 2; ++n) {
                const int c = col0 + bj * 128 + n * 16;
                const f32x4 g4 = *(const f32x4*)(gv + c) * coef;
                f32x4 sv[2][4];
#pragma unroll
                for (int ai = 0; ai < 2; ++ai)
#pragma unroll
                    for (int m = 0; m < 4; ++m) sv[ai][m] = *(const f32x4*)(src + (size_t)(r0 + ai * 128 + m * 16) * DM + c);
#pragma unroll
                for (int ai = 0; ai < 2; ++ai)
#pragma unroll
                    for (int m = 0; m < 4; ++m) *(f32x4*)(dst + (size_t)(r0 + ai * 128 + m * 16) * DM + c) = sv[ai][m] + g4 * acc[ai][bj][m][n];
            }
    }
};
struct EpiInProj {
    static constexpr bool PERM = false, AFTER_DRAIN = false;
    u16 *Z, *Q, *K, *V; const float* rope;
    __device__ __forceinline__ void operator()(const f32x4 (&acc)[2][2][4][2], const Unit& u, int wr, int wc, int fr, int fq) const {
        const bool isctx = u.pm >= 128; const int pn = u.pn;
        if (isctx && pn < 8) return;
        const int rl0 = wr * 64 + fr;
        const int cl0 = wc * 32 + 4 * fq;
        if (pn < 6) {
#pragma unroll
            for (int ai = 0; ai < 2; ++ai)
#pragma unroll
                for (int m = 0; m < 4; ++m) { u16* rp = Z + (size_t)(u.pm * 256 + rl0 + ai * 128 + m * 16) * 1536 + pn * 256 + cl0;
#pragma unroll
                    for (int bj = 0; bj < 2; ++bj)
#pragma unroll
                        for (int n = 0; n < 2; ++n) { const f32x4 a = acc[ai][bj][m][n]; uint2 w; w.x = pk2(a[0], a[1]); w.y = pk2(a[2], a[3]); *(uint2*)(rp + bj * 128 + n * 16) = w; } }
            return;
        }
        const bool do_rope = (pn < 10) && !isctx;
        u16* base; size_t rowbase;
        if (pn < 8) { base = Q; rowbase = (size_t)u.pm * 256; }
        else { base = pn < 10 ? K : V; rowbase = isctx ? ((size_t)(u.pm - 128) * NKEY + SEQ) : ((size_t)(u.pm >> 6) * NKEY + (size_t)(u.pm & 63) * 256); }
        const int cbase = (pn & 1) * 256 + cl0;
        const int axis = wc & 1;
#pragma unroll
        for (int ai = 0; ai < 2; ++ai)
#pragma unroll
            for (int m = 0; m < 4; ++m) {
                const int rl = rl0 + ai * 128 + m * 16;
                u16* rp = base + (rowbase + rl) * 512 + cbase;
                f32x4 cs0 = {1.f, 0.f, 1.f, 0.f}, cs1 = {1.f, 0.f, 1.f, 0.f};
                if (do_rope) { const int t = (u.pm & 63) * 256 + rl; const int pos = axis ? (t & 63) : (t >> 6);
                    const float* rp2 = rope + (size_t)(pos * 16 + 4 * fq) * 2; cs0 = *(const f32x4*)rp2; cs1 = *(const f32x4*)(rp2 + 4); }
#pragma unroll
                for (int bj = 0; bj < 2; ++bj) {
                    const f32x4 x1 = acc[ai][bj][m][0], x2 = acc[ai][bj][m][1];
                    f32x4 o1, o2;
                    o1[0] = x1[0] * cs0[0] - x2[0] * cs0[1]; o2[0] = x2[0] * cs0[0] + x1[0] * cs0[1];
                    o1[1] = x1[1] * cs0[2] - x2[1] * cs0[3]; o2[1] = x2[1] * cs0[2] + x1[1] * cs0[3];
                    o1[2] = x1[2] * cs1[0] - x2[2] * cs1[1]; o2[2] = x2[2] * cs1[0] + x1[2] * cs1[1];
                    o1[3] = x1[3] * cs1[2] - x2[3] * cs1[3]; o2[3] = x2[3] * cs1[2] + x1[3] * cs1[3];
                    uint2 w; w.x = pk2(o1[0], o1[1]); w.y = pk2(o1[2], o1[3]); *(uint2*)(rp + bj * 128) = w;
                    w.x = pk2(o2[0], o2[1]); w.y = pk2(o2[2], o2[3]); *(uint2*)(rp + bj * 128 + 16) = w;
                }
            }
    }
};

struct CtxSplitOrder {
    int G, c;
    __device__ __forceinline__ bool next(int i, Unit& u) const { const int L = i * G + c; if (L >= 88) return false; u.pm = 128 + (L & 1); u.pn = (L >> 1) & 3; u.ko = (L >> 3) * 512; return true; }
    __device__ __forceinline__ void a_ready(const Unit&) const {}
    __device__ __forceinline__ void done(const Unit&) const {}
};
struct CtxKvOrder {
    int G, c;
    __device__ __forceinline__ bool next(int i, Unit& u) const { const int L = i * G + c; if (L >= 8) return false; u.pm = 128 + (L & 1); u.pn = 8 + (L >> 1); u.ko = 0; return true; }
    __device__ __forceinline__ void a_ready(const Unit&) const {}
    __device__ __forceinline__ void done(const Unit&) const {}
};
struct EpiCtxAtomic {
    static constexpr bool PERM = false, AFTER_DRAIN = false;
    float* dst_ctx; const float* mod; int modk; float coef;
    __device__ __forceinline__ void operator()(const f32x4 (&acc)[2][2][4][2], const Unit& u, int wr, int wc, int fr, int fq) const {
        float* dst = dst_ctx + (size_t)(u.pm - 128) * 256 * DM; const float* gv = mod + 2 * NADA + modk * DM;
        const int col0 = u.pn * 256 + wc * 32 + 4 * fq, r0 = wr * 64 + fr;
        f32x4 g4[2][2];
#pragma unroll
        for (int bj = 0; bj < 2; ++bj)
#pragma unroll
            for (int n = 0; n < 2; ++n) g4[bj][n] = *(const f32x4*)(gv + col0 + bj * 128 + n * 16) * coef;
#pragma unroll
        for (int ai = 0; ai < 2; ++ai)
#pragma unroll
            for (int m = 0; m < 4; ++m) {
                unsigned ro = (unsigned)((r0 + ai * 128 + m * 16) * DM + col0); asm volatile("" : "+v"(ro));
                float* o = dst + ro;
#pragma unroll
                for (int bj = 0; bj < 2; ++bj)
#pragma unroll
                    for (int n = 0; n < 2; ++n) { const f32x4 v = g4[bj][n] * acc[ai][bj][m][n];
#pragma unroll
                        for (int j = 0; j < 4; ++j) __hip_atomic_fetch_add(o + bj * 128 + n * 16 + j, v[j], __ATOMIC_RELAXED, __HIP_MEMORY_SCOPE_AGENT); } }
    }
};

namespace att {
using bf16x8 = __attribute__((ext_vector_type(8))) short;
using s16x4  = __attribute__((ext_vector_type(4))) short;
using f32x16 = __attribute__((ext_vector_type(16))) float;
constexpr int KVBLK = 64, LDK = 512, LDQ = 512;
constexpr float SCALE = 0.125f, THR = 8.f;
constexpr int SHM_V = KVBLK * 128 * 2, SHM_K = KVBLK * 128 * 2;
#define KSWZ(row, colB) ((row) * 256 + ((colB) ^ (((row) & 7) << 4)))
#define SBAR() __builtin_amdgcn_sched_barrier(0)
template <int M> __device__ __forceinline__ float swz_xor(float v) { return __int_as_float(__builtin_amdgcn_ds_swizzle(__float_as_int(v), 0x1F | (M << 10))); }
__device__ __forceinline__ int crow(int r, int hi) { return (r & 3) + 8 * (r >> 2) + 4 * hi; }
__device__ __forceinline__ unsigned cvtpk(float lo, float hi) { unsigned r; asm volatile("v_cvt_pk_bf16_f32 %0, %1, %2" : "=v"(r) : "v"(lo), "v"(hi)); return r; }
__device__ __forceinline__ void partialSM(f32x16& p0, f32x16& p1, float& m_reg, float& mn, float& alpha) {
  constexpr float C = SCALE * 1.4426950408889634f;
  float pmax = p0[0];
#pragma unroll
  for (int r = 1; r < 16; ++r) pmax = fmaxf(pmax, p0[r]);
#pragma unroll
  for (int r = 0; r < 16; ++r) pmax = fmaxf(pmax, p1[r]);
  { auto rr = __builtin_amdgcn_permlane32_swap(__float_as_uint(pmax), __float_as_uint(pmax), false, false);
    pmax = fmaxf(__uint_as_float(rr[0]), __uint_as_float(rr[1])); }
  if (__builtin_expect(__all(pmax - m_reg <= THR / SCALE), 1)) { mn = m_reg; alpha = 1.f; }
  else { mn = fmaxf(m_reg, pmax); alpha = __builtin_amdgcn_exp2f((m_reg - mn) * C); m_reg = mn; }
  float mnC = -mn * C;
#pragma unroll
  for (int r = 0; r < 16; ++r) p0[r] = fmaf(p0[r], C, mnC);
#pragma unroll
  for (int r = 0; r < 16; ++r) p1[r] = fmaf(p1[r], C, mnC);
#pragma unroll
  for (int r = 0; r < 16; ++r) p0[r] = __builtin_amdgcn_exp2f(p0[r]);
}
__device__ __forceinline__ void finishSM(f32x16& p0, f32x16& p1, float alpha, float& l_reg, bf16x8& pa0, bf16x8& pa1, bf16x8& pa2, bf16x8& pa3) {
#pragma unroll
  for (int r = 0; r < 16; ++r) p1[r] = __builtin_amdgcn_exp2f(p1[r]);
  float ps = 0;
#pragma unroll
  for (int r = 0; r < 16; ++r) ps += p0[r];
#pragma unroll
  for (int r = 0; r < 16; ++r) ps += p1[r];
  { auto rr = __builtin_amdgcn_permlane32_swap(__float_as_uint(ps), __float_as_uint(ps), false, false);
    ps = __uint_as_float(rr[0]) + __uint_as_float(rr[1]); }
  l_reg = l_reg * alpha + ps;
#define PK4(P, BASE, OUT) do { unsigned a0 = cvtpk(P[BASE + 0], P[BASE + 1]), a1 = cvtpk(P[BASE + 2], P[BASE + 3]);   \
    unsigned b0 = cvtpk(P[BASE + 4], P[BASE + 5]), b1 = cvtpk(P[BASE + 6], P[BASE + 7]);                              \
    auto r0 = __builtin_amdgcn_permlane32_swap(a0, b0, false, false); auto r1 = __builtin_amdgcn_permlane32_swap(a1, b1, false, false); \
    u32x4 w = {r0[0], r1[0], r0[1], r1[1]}; OUT = *reinterpret_cast<bf16x8*>(&w); } while (0)
  PK4(p0, 0, pa0); PK4(p0, 8, pa1); PK4(p1, 0, pa2); PK4(p1, 8, pa3);
#undef PK4
}
__device__ __forceinline__ void qkt(f32x16& p0, f32x16& p1, const char* Ks, const bf16x8* qr, int r32, int hi, int s) {
  p0 = f32x16{}; p1 = f32x16{};
#pragma unroll
  for (int d0 = 0; d0 < 4; ++d0) { int cb = (s * 64 + d0 * 16 + hi * 8) * 2;
    bf16x8 b0 = *reinterpret_cast<const bf16x8*>(Ks + KSWZ(r32, cb));
    bf16x8 b1 = *reinterpret_cast<const bf16x8*>(Ks + KSWZ(32 + r32, cb));
    p0 = __builtin_amdgcn_mfma_f32_32x32x16_bf16(b0, qr[d0], p0, 0, 0, 0);
    p1 = __builtin_amdgcn_mfma_f32_32x32x16_bf16(b1, qr[d0], p1, 0, 0, 0); }
}
__device__ __forceinline__ int v_st(int k, int c) { const int kk = (k & ~0xC) | ((k & 4) << 1) | ((k & 8) >> 1); return ((kk >> 3) * 4 + (c >> 5)) * 512 + ((kk & 7) * 32 + (c & 31)) * 2; }
__device__ __forceinline__ int v_rd_base(int lane) { return ((lane & 3) << 3) | (((lane >> 2) & 3) << 6) | (((lane >> 4) & 1) << 5) | (((lane >> 5) & 1) << 8); }
constexpr int v_rd_off(int d0, int ks, int half) { return d0 * 512 + ks * 4096 + half * 2048; }
template <int OFF> __device__ __forceinline__ s16x4 tr_read(int vb) {
  s16x4 r; asm volatile("ds_read_b64_tr_b16 %0, %1 offset:%2" : "=&v"(r) : "v"(vb), "i"(OFF) : "memory"); return r;
}
template <int D0> __device__ __forceinline__ void pv_one(f32x16& od, int vb, bf16x8 pa0, bf16x8 pa1, bf16x8 pa2, bf16x8 pa3) {
  const s16x4 l0 = tr_read<v_rd_off(D0, 0, 0)>(vb), h0 = tr_read<v_rd_off(D0, 0, 1)>(vb), l1 = tr_read<v_rd_off(D0, 1, 0)>(vb), h1 = tr_read<v_rd_off(D0, 1, 1)>(vb);
  const s16x4 l2 = tr_read<v_rd_off(D0, 2, 0)>(vb), h2 = tr_read<v_rd_off(D0, 2, 1)>(vb), l3 = tr_read<v_rd_off(D0, 3, 0)>(vb), h3 = tr_read<v_rd_off(D0, 3, 1)>(vb);
  asm volatile("s_waitcnt lgkmcnt(0)" ::: "memory"); SBAR();
#define PK(L, H) (bf16x8){L[0], L[1], L[2], L[3], H[0], H[1], H[2], H[3]}
  od = __builtin_amdgcn_mfma_f32_32x32x16_bf16(pa0, PK(l0, h0), od, 0, 0, 0);
  od = __builtin_amdgcn_mfma_f32_32x32x16_bf16(pa1, PK(l1, h1), od, 0, 0, 0);
  od = __builtin_amdgcn_mfma_f32_32x32x16_bf16(pa2, PK(l2, h2), od, 0, 0, 0);
  od = __builtin_amdgcn_mfma_f32_32x32x16_bf16(pa3, PK(l3, h3), od, 0, 0, 0);
#undef PK
}
__device__ __forceinline__ void pv_d0(f32x16* o, int vb, bf16x8 pa0, bf16x8 pa1, bf16x8 pa2, bf16x8 pa3) {
  pv_one<0>(o[0], vb, pa0, pa1, pa2, pa3); pv_one<1>(o[1], vb, pa0, pa1, pa2, pa3); pv_one<2>(o[2], vb, pa0, pa1, pa2, pa3); pv_one<3>(o[3], vb, pa0, pa1, pa2, pa3);
}

__device__ __forceinline__ void diff_attn_unit(const u16* __restrict__ Qb, const u16* __restrict__ Kh, const u16* __restrict__ Vh, u16* __restrict__ Yb,
                                               float lam, const float* __restrict__ subg, char* lds) {
  const int tid = threadIdx.x, wid = tid >> 6, lane = tid & 63, r32 = lane & 31, hi = lane >> 5, qb = wid >> 1, s = wid & 1;
  char* V_lds = lds; char* K_lds = lds + 2 * SHM_V;
  float* wsl = (float*)(lds + 2 * SHM_V + 2 * SHM_K) + wid * 64; float* li_l = wsl; float* al_l = wsl + 32;
  float m_reg = -1e30f, l_reg = 0; f32x16 o[4] = {}; bf16x8 qr[4];
  const u16* Qw = Qb + (long)(qb * 32 + r32) * LDQ + s * 64 + hi * 8;
#pragma unroll
  for (int d0 = 0; d0 < 4; ++d0) qr[d0] = *reinterpret_cast<const bf16x8*>(Qw + d0 * 16);
  const int sr = tid >> 4, sc = (tid & 15) * 8, vst0 = v_st(sr, sc), vst1 = v_st(32 + sr, sc);
  const int vb0 = (int)(uintptr_t)V_lds + v_rd_base(lane);
  struct { bf16x8 vs0, vs1, ks0, ks1; } sr_[2];
#define LD8(ptr) (*reinterpret_cast<const bf16x8*>(ptr))
#define SLOAD(i, k0) do { sr_[i].vs0 = LD8(&Vh[(long)((k0) + sr) * LDK + sc]); sr_[i].vs1 = LD8(&Vh[(long)((k0) + 32 + sr) * LDK + sc]); \
    sr_[i].ks0 = LD8(&Kh[(long)((k0) + sr) * LDK + sc]); sr_[i].ks1 = LD8(&Kh[(long)((k0) + 32 + sr) * LDK + sc]); } while (0)
#define SWRITE(b, i) do { *(bf16x8*)(V_lds + (b) * SHM_V + vst0) = sr_[i].vs0;          \
    *(bf16x8*)(V_lds + (b) * SHM_V + vst1) = sr_[i].vs1; int kc = sc * 2;               \
    *(bf16x8*)(K_lds + (b) * SHM_K + KSWZ(sr, kc)) = sr_[i].ks0;                       \
    *(bf16x8*)(K_lds + (b) * SHM_K + KSWZ(32 + sr, kc)) = sr_[i].ks1; } while (0)
#define SWAIT() asm volatile("s_waitcnt vmcnt(4)" ::: "memory")
#define RESC(a) do { if (__any((a) < 1.f)) { if (hi == 0) al_l[r32] = (a); asm volatile("s_waitcnt lgkmcnt(0)" ::: "memory"); \
    _Pragma("unroll") for (int d = 0; d < 4; ++d) _Pragma("unroll") for (int r = 0; r < 16; ++r) o[d][r] *= al_l[crow(r, hi)]; } } while (0)
  f32x16 pA0, pA1, pB0, pB1; float mnA, mnB, alA, alB; bf16x8 pa0, pa1, pa2, pa3; constexpr int NT = NKEY / KVBLK;
  constexpr int SE = 0, SO = 1;
  SLOAD(SE, 0); asm volatile("s_waitcnt vmcnt(0)" ::: "memory"); SWRITE(0, SE); __syncthreads();
  qkt(pA0, pA1, K_lds, qr, r32, hi, s); partialSM(pA0, pA1, m_reg, mnA, alA);
  SLOAD(SO, KVBLK); SLOAD(SE, 2 * KVBLK);
  SWAIT(); SWRITE(1, SO); __syncthreads();
  for (int j = 1; j + 1 < NT; j += 2) {
    SBAR(); qkt(pB0, pB1, K_lds + SHM_K, qr, r32, hi, s);
    finishSM(pA0, pA1, alA, l_reg, pa0, pa1, pa2, pa3); SBAR();
    SLOAD(SO, (j + 2) * KVBLK); SBAR();
    pv_d0(o, vb0, pa0, pa1, pa2, pa3); partialSM(pB0, pB1, m_reg, mnB, alB);
    __syncthreads(); SWAIT(); SWRITE(0, SE);
    RESC(alB); __syncthreads();
    SBAR(); qkt(pA0, pA1, K_lds, qr, r32, hi, s);
    finishSM(pB0, pB1, alB, l_reg, pa0, pa1, pa2, pa3); SBAR();
    if (j + 3 < NT) SLOAD(SE, (j + 3) * KVBLK); SBAR();
    pv_d0(o, vb0 + SHM_V, pa0, pa1, pa2, pa3); partialSM(pA0, pA1, m_reg, mnA, alA);
    __syncthreads(); SWAIT(); SWRITE(1, SO);
    RESC(alA); __syncthreads();
  }
  SBAR(); qkt(pB0, pB1, K_lds + SHM_K, qr, r32, hi, s);
  finishSM(pA0, pA1, alA, l_reg, pa0, pa1, pa2, pa3); SBAR();
  pv_d0(o, vb0, pa0, pa1, pa2, pa3); partialSM(pB0, pB1, m_reg, mnB, alB);
  __syncthreads(); RESC(alB);
  finishSM(pB0, pB1, alB, l_reg, pa0, pa1, pa2, pa3); SBAR();
  pv_d0(o, vb0 + SHM_V, pa0, pa1, pa2, pa3);
  if (hi == 0) li_l[r32] = l_reg; asm volatile("s_waitcnt lgkmcnt(0)" ::: "memory");
  int hi2 = hi; asm volatile("" : "+v"(hi2));
  float rli[16];
#pragma unroll
  for (int r = 0; r < 16; ++r) rli[r] = 1.0f / li_l[crow(r, hi2)];
  __syncthreads();
  int xoff = qb * 4096 + r32, yoff = qb * 32 * 1024 + r32;
  asm volatile("" : "+v"(xoff), "+v"(yoff));
  float* X = (float*)lds + xoff;
  if (s == 1) {
#pragma unroll
    for (int r = 0; r < 16; ++r)
#pragma unroll
      for (int d0 = 0; d0 < 4; ++d0) X[crow(r, hi2) * 128 + d0 * 32] = lam * o[d0][r] * rli[r];
  }
  __syncthreads();
  if (s == 0) {
    float gv[4];
#pragma unroll
    for (int d0 = 0; d0 < 4; ++d0) gv[d0] = subg[d0 * 32 + r32] * 0.8f;
#pragma unroll
    for (int r = 0; r < 16; ++r) {
      const int row = crow(r, hi2); float v[4]; float ss = 0.f;
#pragma unroll
      for (int d0 = 0; d0 < 4; ++d0) { v[d0] = o[d0][r] * rli[r] - X[row * 128 + d0 * 32]; ss += v[d0] * v[d0]; }
      ss += swz_xor<16>(ss); ss += swz_xor<8>(ss); ss += swz_xor<4>(ss); ss += swz_xor<2>(ss); ss += swz_xor<1>(ss);
      const float rs = rsqrtf(ss * (1.0f / 128.0f) + 1e-5f);
      u16* yp = Yb + (yoff + row * 1024);
#pragma unroll
      for (int d0 = 0; d0 < 4; ++d0) yp[d0 * 32] = f2bf(v[d0] * rs * gv[d0]);
    }
  }
  __syncthreads();
#undef LD8
#undef SLOAD
#undef SWRITE
#undef SWAIT
#undef RESC
}

#ifndef PROBE_ATT_VALU
#define PROBE_ATT_VALU 0
#endif
#ifndef PROBE_ATT_MFMA
#define PROBE_ATT_MFMA 0
#endif
__device__ __forceinline__ void sm_half(f32x16& p, float& m_reg, float& l_reg, float& alpha, bf16x8& paA, bf16x8& paB) {
  constexpr float C = SCALE * 1.4426950408889634f * (PROBE_ATT_MFMA ? 0.5f : 1.0f);
  float pmax = p[0];
#pragma unroll
  for (int r = 1; r < 16; ++r) pmax = fmaxf(pmax, p[r]);
  { auto rr = __builtin_amdgcn_permlane32_swap(__float_as_uint(pmax), __float_as_uint(pmax), false, false);
    pmax = fmaxf(__uint_as_float(rr[0]), __uint_as_float(rr[1])); }
  float mn;
  if (__builtin_expect(__all(pmax - m_reg <= THR / SCALE * (PROBE_ATT_MFMA ? 2.0f : 1.0f)), 1)) { mn = m_reg; alpha = 1.f; }
  else { mn = fmaxf(m_reg, pmax); alpha = __builtin_amdgcn_exp2f((m_reg - mn) * C); m_reg = mn; }
  const float mnC = -mn * C;
#if PROBE_ATT_VALU
  { float junk = 0.f;
#pragma unroll
    for (int r = 0; r < 16; ++r) junk += __builtin_amdgcn_exp2f(fmaf(p[r], C, mnC - 1.0f));
    l_reg += junk * 0.0f; }
#endif
#pragma unroll
  for (int r = 0; r < 16; ++r) p[r] = __builtin_amdgcn_exp2f(fmaf(p[r], C, mnC));
  float ps = 0;
#pragma unroll
  for (int r = 0; r < 16; ++r) ps += p[r];
  { auto rr = __builtin_amdgcn_permlane32_swap(__float_as_uint(ps), __float_as_uint(ps), false, false);
    ps = __uint_as_float(rr[0]) + __uint_as_float(rr[1]); }
  l_reg = l_reg * alpha + ps;
#define PK4(P, BASE, OUT) do { unsigned a0 = cvtpk(P[BASE + 0], P[BASE + 1]), a1 = cvtpk(P[BASE + 2], P[BASE + 3]);   \
    unsigned b0 = cvtpk(P[BASE + 4], P[BASE + 5]), b1 = cvtpk(P[BASE + 6], P[BASE + 7]);                              \
    auto r0 = __builtin_amdgcn_permlane32_swap(a0, b0, false, false); auto r1 = __builtin_amdgcn_permlane32_swap(a1, b1, false, false); \
    u32x4 w = {r0[0], r1[0], r0[1], r1[1]}; OUT = *reinterpret_cast<bf16x8*>(&w); } while (0)
  PK4(p, 0, paA); PK4(p, 8, paB);
#undef PK4
}

__device__ __forceinline__ void sm_half_b(f32x16& p, float mnC, float& l_reg, bf16x8& paA, bf16x8& paB) {
  constexpr float C = SCALE * 1.4426950408889634f;
#pragma unroll
  for (int r = 0; r < 16; ++r) p[r] = __builtin_amdgcn_exp2f(fmaf(p[r], C, mnC));
  float ps0 = p[0] + p[1], ps1 = p[2] + p[3], ps2 = p[4] + p[5], ps3 = p[6] + p[7];
  ps0 += p[8] + p[9]; ps1 += p[10] + p[11]; ps2 += p[12] + p[13]; ps3 += p[14] + p[15];
  float ps = (ps0 + ps1) + (ps2 + ps3);
  { auto rr = __builtin_amdgcn_permlane32_swap(__float_as_uint(ps), __float_as_uint(ps), false, false);
    ps = __uint_as_float(rr[0]) + __uint_as_float(rr[1]); }
  l_reg += ps;
#define PK4(P, BASE, OUT) do { unsigned a0 = cvtpk(P[BASE + 0], P[BASE + 1]), a1 = cvtpk(P[BASE + 2], P[BASE + 3]);   \
    unsigned b0 = cvtpk(P[BASE + 4], P[BASE + 5]), b1 = cvtpk(P[BASE + 6], P[BASE + 7]);                              \
    auto r0 = __builtin_amdgcn_permlane32_swap(a0, b0, false, false); auto r1 = __builtin_amdgcn_permlane32_swap(a1, b1, false, false); \
    u32x4 w = {r0[0], r1[0], r0[1], r1[1]}; OUT = *reinterpret_cast<bf16x8*>(&w); } while (0)
  PK4(p, 0, paA); PK4(p, 8, paB);
#undef PK4
}
__device__ __forceinline__ float sumsq8(bf16x8 v) {
  const u32x4 w = *reinterpret_cast<const u32x4*>(&v); float s = 0.f;
#pragma unroll
  for (int i = 0; i < 4; ++i) { const float lo = __uint_as_float(w[i] << 16), hi = __uint_as_float(w[i] & 0xffff0000u); s += lo * lo + hi * hi; }
  return s;
}
typedef short s16x4w __attribute__((ext_vector_type(4)));
template <int HF> __device__ __forceinline__ void pv_half2(f32x16* o0, f32x16* o1, LAS unsigned char* vbp, bf16x8 p0a, bf16x8 p0b, bf16x8 p1a, bf16x8 p1b) {
#define TR(off) __builtin_amdgcn_ds_read_tr16_b64_v4i16((LAS s16x4w*)(vbp + (off)))
#define PK(L, H) (bf16x8){L[0], L[1], L[2], L[3], H[0], H[1], H[2], H[3]}
  s16x4w la[4], ha[4], lb[4], hb[4];
#pragma unroll
  for (int d0 = 0; d0 < 4; ++d0) { la[d0] = TR(v_rd_off(d0, 2 * HF, 0)); ha[d0] = TR(v_rd_off(d0, 2 * HF, 1)); lb[d0] = TR(v_rd_off(d0, 2 * HF + 1, 0)); hb[d0] = TR(v_rd_off(d0, 2 * HF + 1, 1)); }
#pragma unroll
  for (int d0 = 0; d0 < 4; ++d0) { const bf16x8 va = PK(la[d0], ha[d0]);
    o0[d0] = __builtin_amdgcn_mfma_f32_32x32x16_bf16(p0a, va, o0[d0], 0, 0, 0); o1[d0] = __builtin_amdgcn_mfma_f32_32x32x16_bf16(p1a, va, o1[d0], 0, 0, 0); }
#pragma unroll
  for (int d0 = 0; d0 < 4; ++d0) { const bf16x8 vb = PK(lb[d0], hb[d0]);
    o0[d0] = __builtin_amdgcn_mfma_f32_32x32x16_bf16(p0b, vb, o0[d0], 0, 0, 0); o1[d0] = __builtin_amdgcn_mfma_f32_32x32x16_bf16(p1b, vb, o1[d0], 0, 0, 0); }
#undef TR
#undef PK
}
__device__ __forceinline__ void diff_attn_unit2(const u16* __restrict__ Qb, const u16* __restrict__ Kh, const u16* __restrict__ Vh, u16* __restrict__ Yb,
                                                float lam, const float* __restrict__ subg, const float* __restrict__ kn2, char* lds, LAS unsigned char* ldsl) {
  const int tid = threadIdx.x, wid = __builtin_amdgcn_readfirstlane(tid >> 6), lane = tid & 63, r32 = lane & 31, hi = lane >> 5;
  char* V_lds = lds; char* K_lds = lds + 2 * SHM_V;
  float* wsl = (float*)(lds + 2 * SHM_V + 2 * SHM_K) + wid * 96; float* li0 = wsl; float* li1 = wsl + 32; float* al_l = wsl + 64;
  float l0 = 0.f, l1 = 0.f; f32x16 o0[4] = {}, o1[4] = {}; bf16x8 q0[4], q1[4];
  { unsigned qoff = (unsigned)((wid * 32 + r32) * LDQ + hi * 8) * 2u; asm volatile("" : "+v"(qoff));
    const char* Qw = (const char*)Qb + qoff;
#pragma unroll
    for (int d0 = 0; d0 < 4; ++d0) { q0[d0] = *reinterpret_cast<const bf16x8*>(Qw + d0 * 32); q1[d0] = *reinterpret_cast<const bf16x8*>(Qw + 128 + d0 * 32); } }
  float mnC0, mnC1;
  {
    float* cmax = (float*)(lds + 2 * SHM_V + 2 * SHM_K + 8 * 96 * 4);
    int t_ = tid; asm volatile("" : "+v"(t_));
    const int ck = t_ >> 1, cs = t_ & 1; const char* kp_ = (const char*)Kh + (unsigned)(((SEQ + ck) * LDK + cs * 64) * 2); const u16* kp = (const u16*)kp_; float ss = 0.f;
#pragma unroll
    for (int i = 0; i < 8; ++i) ss += sumsq8(*reinterpret_cast<const bf16x8*>(kp + i * 8));
    ss = fmaxf(ss, swz_xor<2>(ss)); ss = fmaxf(ss, swz_xor<4>(ss)); ss = fmaxf(ss, swz_xor<8>(ss)); ss = fmaxf(ss, swz_xor<16>(ss));
    { auto rr = __builtin_amdgcn_permlane32_swap(__float_as_uint(ss), __float_as_uint(ss), false, false); ss = fmaxf(__uint_as_float(rr[0]), __uint_as_float(rr[1])); }
    if (lane < 2) cmax[wid * 2 + lane] = ss;
    __syncthreads();
    float c0 = cmax[0], c1 = cmax[1];
#pragma unroll
    for (int w = 1; w < 8; ++w) { c0 = fmaxf(c0, cmax[2 * w]); c1 = fmaxf(c1, cmax[2 * w + 1]); }
    const float kb0 = fmaxf(kn2[0], c0), kb1 = fmaxf(kn2[1], c1);
    float qa = 0.f, qb = 0.f;
#pragma unroll
    for (int d0 = 0; d0 < 4; ++d0) { qa += sumsq8(q0[d0]); qb += sumsq8(q1[d0]); }
    { auto rr = __builtin_amdgcn_permlane32_swap(__float_as_uint(qa), __float_as_uint(qa), false, false); qa = __uint_as_float(rr[0]) + __uint_as_float(rr[1]); }
    { auto rr = __builtin_amdgcn_permlane32_swap(__float_as_uint(qb), __float_as_uint(qb), false, false); qb = __uint_as_float(rr[0]) + __uint_as_float(rr[1]); }
    constexpr float C = SCALE * 1.4426950408889634f;
    mnC0 = -sqrtf(qa * kb0) * C * 1.0001f - 1e-6f; mnC1 = -sqrtf(qb * kb1) * C * 1.0001f - 1e-6f;
  }
  LAS unsigned char* vbl = ldsl + v_rd_base(lane);
  int kb[4];
#pragma unroll
  for (int d0 = 0; d0 < 4; ++d0) kb[d0] = r32 * 256 + ((d0 * 32 + hi * 16) ^ ((r32 & 7) << 4));
  unsigned koff[2], voff[2];
#pragma unroll
  for (int i = 0; i < 2; ++i) { const int L = (wid + 8 * i) * 64 + lane;
    { const int row = L >> 4, pos = L & 15; koff[i] = (unsigned)(row * 1024 + ((pos ^ (row & 7)) << 4)); }
    { const int sub = L >> 5, within = L & 31, kk = (sub >> 2) * 8 + (within >> 2), k = (kk & ~0xC) | ((kk & 4) << 1) | ((kk & 8) >> 1), c = (sub & 3) * 32 + (within & 3) * 8;
      voff[i] = (unsigned)(k * 1024 + c * 2); } }
#define SDMA(b, k0) do { const char* vg = (const char*)Vh + (size_t)(k0) * (LDK * 2); const char* kg = (const char*)Kh + (size_t)(k0) * (LDK * 2); \
    _Pragma("unroll") for (int i = 0; i < 2; ++i) {                                                                                                  \
      __builtin_amdgcn_global_load_lds((const unsigned*)(kg + i * 32768 + koff[0]), (LAS unsigned*)(ldsl + 2 * SHM_V + (b) * SHM_K + (wid + 8 * i) * 1024), 16, 0, 0); \
      __builtin_amdgcn_global_load_lds((const unsigned*)(vg + i * 32768 + voff[0]), (LAS unsigned*)(ldsl + (b) * SHM_V + (wid + 8 * i) * 1024), 16, 0, 0); } } while (0)
#define VWAIT() asm volatile("s_waitcnt vmcnt(0)" ::: "memory")
#define RESC(o, a) do { if (__any((a) < 1.f)) { if (hi == 0) al_l[r32] = (a); asm volatile("s_waitcnt lgkmcnt(0)" ::: "memory"); \
    _Pragma("unroll") for (int d = 0; d < 4; ++d) _Pragma("unroll") for (int r = 0; r < 16; ++r) o[d][r] *= al_l[crow(r, hi)]; } } while (0)
#define HALF(b, HF) do { const char* Kt = K_lds + (b) * SHM_K; f32x16 s0 = {}, s1 = {}; bf16x8 kf0[4], kf1[4];                  \
    _Pragma("unroll") for (int d0 = 0; d0 < 4; ++d0) {                                                                     \
      kf0[d0] = *reinterpret_cast<const bf16x8*>(Kt + kb[d0] + (HF) * 8192);                                               \
      kf1[d0] = *reinterpret_cast<const bf16x8*>(Kt + kb[d0] + (HF) * 8192 + 128); }                                       \
    _Pragma("unroll") for (int d0 = 0; d0 < 4; ++d0) {                                                                     \
      s0 = __builtin_amdgcn_mfma_f32_32x32x16_bf16(kf0[d0], q0[d0], s0, 0, 0, 0);                                           \
      s1 = __builtin_amdgcn_mfma_f32_32x32x16_bf16(kf1[d0], q1[d0], s1, 0, 0, 0); }                                         \
    bf16x8 p0a, p0b, p1a, p1b;                                                                                              \
    sm_half_b(s0, mnC0, l0, p0a, p0b);                                                                                      \
    sm_half_b(s1, mnC1, l1, p1a, p1b);                                                                                      \
    pv_half2<HF>(o0, o1, vbl + (b) * SHM_V, p0a, p0b, p1a, p1b); } while (0)
  constexpr int NT = NKEY / KVBLK;
  SDMA(0, 0); VWAIT(); __syncthreads();
  for (int j = 0; j < NT; j += 2) {
    SDMA(1, (j + 1) * KVBLK);
    HALF(0, 0); HALF(0, 1);
    VWAIT(); __syncthreads();
    if (j + 2 < NT) SDMA(0, (j + 2) * KVBLK);
    HALF(1, 0); HALF(1, 1);
    VWAIT(); __syncthreads();
  }
  if (hi == 0) { li0[r32] = l0; li1[r32] = l1; } asm volatile("s_waitcnt lgkmcnt(0)" ::: "memory");
  int hi2 = hi, yoff = wid * 32 * 1024 + r32; asm volatile("" : "+v"(hi2), "+v"(yoff));
  float gv[4];
#pragma unroll
  for (int d0 = 0; d0 < 4; ++d0) gv[d0] = subg[d0 * 32 + (yoff & 31)] * 0.8f;
#pragma unroll
  for (int r = 0; r < 16; ++r) {
    const int row = crow(r, hi2); const float r0 = 1.0f / li0[row], r1 = lam / li1[row]; float v[4]; float ss = 0.f;
#pragma unroll
    for (int d0 = 0; d0 < 4; ++d0) { v[d0] = o0[d0][r] * r0 - o1[d0][r] * r1; ss += v[d0] * v[d0]; }
    ss += swz_xor<16>(ss); ss += swz_xor<8>(ss); ss += swz_xor<4>(ss); ss += swz_xor<2>(ss); ss += swz_xor<1>(ss);
    const float rs = rsqrtf(ss * (1.0f / 128.0f) + 1e-5f);
    u16* yp = Yb + (yoff + row * 1024);
#pragma unroll
    for (int d0 = 0; d0 < 4; ++d0) yp[d0 * 32] = f2bf(v[d0] * rs * gv[d0]);
  }
  __syncthreads();
#undef SDMA
#undef VWAIT
#undef RESC
#undef HALF
}

constexpr int L3_V = 0, L3_K = 3 * SHM_V, L3_Q = L3_K + 2 * SHM_K, L3_S = L3_Q + 65536, L3_END = L3_S + 8 * 96 * 4;
typedef short s16x4v __attribute__((ext_vector_type(4)));
__device__ __forceinline__ void sm3(f32x16& p, float& m_reg, float& l_reg, float& alpha, bf16x8& paA, bf16x8& paB) {
  constexpr float C = SCALE * 1.4426950408889634f;
  float pmax = fmaxf(fmaxf(p[0], p[1]), fmaxf(p[2], p[3]));
#pragma unroll
  for (int r = 4; r < 16; r += 2) pmax = fmaxf(pmax, fmaxf(p[r], p[r + 1]));
  { auto rr = __builtin_amdgcn_permlane32_swap(__float_as_uint(pmax), __float_as_uint(pmax), false, false);
    pmax = fmaxf(__uint_as_float(rr[0]), __uint_as_float(rr[1])); }
  const float mn = (pmax - m_reg <= THR / SCALE) ? m_reg : fmaxf(m_reg, pmax);
  alpha = __builtin_amdgcn_exp2f((m_reg - mn) * C); m_reg = mn;
  const float mnC = -mn * C;
#pragma unroll
  for (int r = 0; r < 16; ++r) p[r] = __builtin_amdgcn_exp2f(fmaf(p[r], C, mnC));
  float ps0 = p[0] + p[1], ps1 = p[2] + p[3], ps2 = p[4] + p[5], ps3 = p[6] + p[7];
  ps0 += p[8] + p[9]; ps1 += p[10] + p[11]; ps2 += p[12] + p[13]; ps3 += p[14] + p[15];
  float ps = (ps0 + ps1) + (ps2 + ps3);
  { auto rr = __builtin_amdgcn_permlane32_swap(__float_as_uint(ps), __float_as_uint(ps), false, false);
    ps = __uint_as_float(rr[0]) + __uint_as_float(rr[1]); }
  l_reg = l_reg * alpha + ps;
#define PK4(P, BASE, OUT) do { unsigned a0 = cvtpk(P[BASE + 0], P[BASE + 1]), a1 = cvtpk(P[BASE + 2], P[BASE + 3]);   \
    unsigned b0 = cvtpk(P[BASE + 4], P[BASE + 5]), b1 = cvtpk(P[BASE + 6], P[BASE + 7]);                              \
    auto r0 = __builtin_amdgcn_permlane32_swap(a0, b0, false, false); auto r1 = __builtin_amdgcn_permlane32_swap(a1, b1, false, false); \
    u32x4 w = {r0[0], r1[0], r0[1], r1[1]}; OUT = *reinterpret_cast<bf16x8*>(&w); } while (0)
  PK4(p, 0, paA); PK4(p, 8, paB);
#undef PK4
}
template <int HF> __device__ __forceinline__ void pv_all(f32x16* o0, f32x16* o1, LAS unsigned char* vbp, bf16x8 p0a, bf16x8 p0b, bf16x8 p1a, bf16x8 p1b) {
#define TR(off) __builtin_amdgcn_ds_read_tr16_b64_v4i16((LAS s16x4v*)(vbp + (off)))
#define PK(L, H) (bf16x8){L[0], L[1], L[2], L[3], H[0], H[1], H[2], H[3]}
#pragma unroll
  for (int d0 = 0; d0 < 4; ++d0) {
    const s16x4v la = TR(v_rd_off(d0, 2 * HF, 0)), ha = TR(v_rd_off(d0, 2 * HF, 1)), lb = TR(v_rd_off(d0, 2 * HF + 1, 0)), hb = TR(v_rd_off(d0, 2 * HF + 1, 1));
    const bf16x8 va = PK(la, ha), vb = PK(lb, hb);
    o0[d0] = __builtin_amdgcn_mfma_f32_32x32x16_bf16(p0a, va, o0[d0], 0, 0, 0);
    o1[d0] = __builtin_amdgcn_mfma_f32_32x32x16_bf16(p1a, va, o1[d0], 0, 0, 0);
    o0[d0] = __builtin_amdgcn_mfma_f32_32x32x16_bf16(p0b, vb, o0[d0], 0, 0, 0);
    o1[d0] = __builtin_amdgcn_mfma_f32_32x32x16_bf16(p1b, vb, o1[d0], 0, 0, 0);
  }
#undef TR
#undef PK
}
__device__ __forceinline__ void diff_attn_unit3(const u16* __restrict__ Qb, const u16* __restrict__ Kh, const u16* __restrict__ Vh, u16* __restrict__ Yb,
                                                float lam, const float* __restrict__ subg, LAS unsigned char* ldsl) {
  const int tid = threadIdx.x, wid = __builtin_amdgcn_readfirstlane(tid >> 6), lane = tid & 63, r32 = lane & 31, hi = lane >> 5;
  LAS float* wsl = (LAS float*)(ldsl + L3_S) + wid * 96; LAS float* li0 = wsl; LAS float* li1 = wsl + 32; LAS float* al_l = wsl + 64;
  float m0 = -1e30f, l0 = 0.f, m1 = -1e30f, l1 = 0.f; f32x16 o0[4] = {}, o1[4] = {};
  int kb[4];
#pragma unroll
  for (int d0 = 0; d0 < 4; ++d0) kb[d0] = r32 * 256 + ((d0 * 32 + hi * 16) ^ ((r32 & 7) << 4));
  LAS unsigned char* Qw_l = ldsl + L3_Q + wid * 8192;
  { unsigned qoff = (unsigned)((wid * 32 + r32) * LDQ + hi * 8) * 2u; asm volatile("" : "+v"(qoff));
    const char* Qw = (const char*)Qb + qoff;
#pragma unroll
    for (int d0 = 0; d0 < 4; ++d0) { const bf16x8 a = *reinterpret_cast<const bf16x8*>(Qw + d0 * 32), b = *reinterpret_cast<const bf16x8*>(Qw + 128 + d0 * 32);
      *(LAS bf16x8*)(Qw_l + kb[d0]) = a; *(LAS bf16x8*)(Qw_l + kb[d0] + 128) = b; } }
  LAS unsigned char* vb0 = ldsl + L3_V + v_rd_base(lane);
  unsigned koff[2], voff[2];
#pragma unroll
  for (int i = 0; i < 2; ++i) { const int L = (wid + 8 * i) * 64 + lane;
    { const int row = L >> 4, pos = L & 15; koff[i] = (unsigned)(row * 1024 + ((pos ^ (row & 7)) << 4)); }
    { const int sub = L >> 5, within = L & 31, kk = (sub >> 2) * 8 + (within >> 2), k = (kk & ~0xC) | ((kk & 4) << 1) | ((kk & 8) >> 1), c = (sub & 3) * 32 + (within & 3) * 8;
      voff[i] = (unsigned)(k * 1024 + c * 2); } }
#define SDMA(ko, vo, k0) do { const char* vg = (const char*)Vh + (size_t)(k0) * (LDK * 2); const char* kg = (const char*)Kh + (size_t)(k0) * (LDK * 2); \
    _Pragma("unroll") for (int i = 0; i < 2; ++i) {                                                                                                  \
      __builtin_amdgcn_global_load_lds((const unsigned*)(kg + i * 32768 + koff[0]), (LAS unsigned*)(ldsl + L3_K + (ko) + (wid + 8 * i) * 1024), 16, 0, 0);      \
      __builtin_amdgcn_global_load_lds((const unsigned*)(vg + i * 32768 + voff[0]), (LAS unsigned*)(ldsl + L3_V + (vo) + (wid + 8 * i) * 1024), 16, 0, 0); } } while (0)
#define VWAIT() asm volatile("s_waitcnt vmcnt(0)" ::: "memory")
#define RESC(o, a) do { if (__any((a) < 1.f)) { if (hi == 0) al_l[r32] = (a); asm volatile("s_waitcnt lgkmcnt(0)" ::: "memory"); \
    _Pragma("unroll") for (int d = 0; d < 4; ++d) _Pragma("unroll") for (int r = 0; r < 16; ++r) o[d][r] *= al_l[crow(r, hi)]; } } while (0)
#define QKH(ko, HF) do { s0 = f32x16{}; s1 = f32x16{};                                                                      \
    _Pragma("unroll") for (int d0 = 0; d0 < 4; ++d0) {                                                                     \
      const bf16x8 k0 = *(const LAS bf16x8*)(ldsl + L3_K + (ko) + kb[d0] + (HF) * 8192);                                   \
      const bf16x8 k1 = *(const LAS bf16x8*)(ldsl + L3_K + (ko) + kb[d0] + (HF) * 8192 + 128);                             \
      const bf16x8 qa = *(const LAS bf16x8*)(Qw_l + kb[d0]); const bf16x8 qb = *(const LAS bf16x8*)(Qw_l + kb[d0] + 128);   \
      s0 = __builtin_amdgcn_mfma_f32_32x32x16_bf16(k0, qa, s0, 0, 0, 0);                                                    \
      s1 = __builtin_amdgcn_mfma_f32_32x32x16_bf16(k1, qb, s1, 0, 0, 0); } } while (0)
#define SMBOTH() do { float a0, a1; bf16x8 n0a, n0b, n1a, n1b;                                                              \
    sm3(s0, m0, l0, a0, n0a, n0b); sm3(s1, m1, l1, a1, n1a, n1b);                                                           \
    p0a = n0a; p0b = n0b; p1a = n1a; p1b = n1b; RESC(o0, a0); RESC(o1, a1); } while (0)
#define TR(off) __builtin_amdgcn_ds_read_tr16_b64_v4i16((LAS s16x4v*)(vp_ + (off)))
#define PKV(L, H) (bf16x8){L[0], L[1], L[2], L[3], H[0], H[1], H[2], H[3]}
#define TRD(S, d0, HF) do { S##0 = TR(v_rd_off(d0, 2 * (HF), 0)); S##1 = TR(v_rd_off(d0, 2 * (HF), 1)); S##2 = TR(v_rd_off(d0, 2 * (HF) + 1, 0)); S##3 = TR(v_rd_off(d0, 2 * (HF) + 1, 1)); } while (0)
#define PVD(S, d0) do { const bf16x8 va_ = PKV(S##0, S##1), vb_ = PKV(S##2, S##3);                                          \
    o0[d0] = __builtin_amdgcn_mfma_f32_32x32x16_bf16(p0a, va_, o0[d0], 0, 0, 0); o1[d0] = __builtin_amdgcn_mfma_f32_32x32x16_bf16(p1a, va_, o1[d0], 0, 0, 0); \
    o0[d0] = __builtin_amdgcn_mfma_f32_32x32x16_bf16(p0b, vb_, o0[d0], 0, 0, 0); o1[d0] = __builtin_amdgcn_mfma_f32_32x32x16_bf16(p1b, vb_, o1[d0], 0, 0, 0); } while (0)
#define ROWMAX(p, out) do { float t_ = fmaxf(fmaxf(p[0], p[1]), fmaxf(p[2], p[3]));                                        \
    _Pragma("unroll") for (int r = 4; r < 16; r += 2) t_ = fmaxf(t_, fmaxf(p[r], p[r + 1]));                               \
    auto rr_ = __builtin_amdgcn_permlane32_swap(__float_as_uint(t_), __float_as_uint(t_), false, false);                    \
    out = fmaxf(__uint_as_float(rr_[0]), __uint_as_float(rr_[1])); } while (0)
#define ROWSUM(p, out) do { float q0_ = p[0] + p[1], q1_ = p[2] + p[3], q2_ = p[4] + p[5], q3_ = p[6] + p[7];               \
    q0_ += p[8] + p[9]; q1_ += p[10] + p[11]; q2_ += p[12] + p[13]; q3_ += p[14] + p[15]; float t_ = (q0_ + q1_) + (q2_ + q3_); \
    auto rr_ = __builtin_amdgcn_permlane32_swap(__float_as_uint(t_), __float_as_uint(t_), false, false);                    \
    out = __uint_as_float(rr_[0]) + __uint_as_float(rr_[1]); } while (0)
#define PK4(P, BASE, OUT) do { unsigned a0_ = cvtpk(P[BASE + 0], P[BASE + 1]), a1_ = cvtpk(P[BASE + 2], P[BASE + 3]);       \
    unsigned b0_ = cvtpk(P[BASE + 4], P[BASE + 5]), b1_ = cvtpk(P[BASE + 6], P[BASE + 7]);                                  \
    auto r0_ = __builtin_amdgcn_permlane32_swap(a0_, b0_, false, false); auto r1_ = __builtin_amdgcn_permlane32_swap(a1_, b1_, false, false); \
    u32x4 w_ = {r0_[0], r1_[0], r0_[1], r1_[1]}; OUT = *reinterpret_cast<bf16x8*>(&w_); } while (0)
#define STEP(ko, QHF, vp, PVHF) do { LAS unsigned char* vp_ = (vp); constexpr float C_ = SCALE * 1.4426950408889634f;       \
    s16x4v A0, A1, A2, A3, B0, B1, B2, B3; float a0, a1, c0_, c1_; bf16x8 n0a, n0b, n1a, n1b;                                \
    TRD(A, 0, PVHF);                                                                                                        \
    QKH(ko, QHF);                                                                                                           \
    SBAR();                                                                                                                 \
    PVD(A, 0); TRD(B, 1, PVHF);                                                                                             \
    { float pm0, pm1; ROWMAX(s0, pm0); ROWMAX(s1, pm1);                                                                     \
      const float mn0 = (pm0 - m0 <= THR / SCALE) ? m0 : fmaxf(m0, pm0), mn1 = (pm1 - m1 <= THR / SCALE) ? m1 : fmaxf(m1, pm1); \
      a0 = __builtin_amdgcn_exp2f((m0 - mn0) * C_); a1 = __builtin_amdgcn_exp2f((m1 - mn1) * C_); m0 = mn0; m1 = mn1; c0_ = -mn0 * C_; c1_ = -mn1 * C_; } \
    SBAR();                                                                                                                 \
    PVD(B, 1); TRD(A, 2, PVHF);                                                                                             \
    _Pragma("unroll") for (int r = 0; r < 16; ++r) s0[r] = __builtin_amdgcn_exp2f(fmaf(s0[r], C_, c0_));                    \
    SBAR();                                                                                                                 \
    PVD(A, 2); TRD(B, 3, PVHF);                                                                                             \
    _Pragma("unroll") for (int r = 0; r < 16; ++r) s1[r] = __builtin_amdgcn_exp2f(fmaf(s1[r], C_, c1_));                    \
    SBAR();                                                                                                                 \
    PVD(B, 3);                                                                                                              \
    { float ps0, ps1; ROWSUM(s0, ps0); ROWSUM(s1, ps1); l0 = l0 * a0 + ps0; l1 = l1 * a1 + ps1;                             \
      PK4(s0, 0, n0a); PK4(s0, 8, n0b); PK4(s1, 0, n1a); PK4(s1, 8, n1b); }                                                  \
    SBAR();                                                                                                                 \
    p0a = n0a; p0b = n0b; p1a = n1a; p1b = n1b; RESC(o0, a0); RESC(o1, a1); } while (0)
  constexpr int NT = NKEY / KVBLK;
  f32x16 s0, s1; bf16x8 p0a, p0b, p1a, p1b;
  SDMA(0, 0, 0); VWAIT(); __syncthreads();
  SDMA(SHM_K, SHM_V, KVBLK);
  QKH(0, 0); SMBOTH();
  int vcur = 0;
  for (int j = 0; j < NT; ++j) {
    const int kcur = (j & 1) * SHM_K, knext = SHM_K - kcur;
    const int vnext = vcur == 2 * SHM_V ? 0 : vcur + SHM_V, vnn = vnext == 2 * SHM_V ? 0 : vnext + SHM_V;
    STEP(kcur, 1, vb0 + vcur, 0);
    VWAIT(); __syncthreads();
    if (j + 2 < NT) SDMA(kcur, vnn, (j + 2) * KVBLK);
    if (j + 1 < NT) { STEP(knext, 0, vb0 + vcur, 1); }
    else pv_all<1>(o0, o1, vb0 + vcur, p0a, p0b, p1a, p1b);
    vcur = vnext;
  }
  if (hi == 0) { li0[r32] = l0; li1[r32] = l1; } asm volatile("s_waitcnt lgkmcnt(0)" ::: "memory");
  int hi2 = hi, yoff = wid * 32 * 1024 + r32; asm volatile("" : "+v"(hi2), "+v"(yoff));
  float gv[4];
#pragma unroll
  for (int d0 = 0; d0 < 4; ++d0) gv[d0] = subg[d0 * 32 + (yoff & 31)] * 0.8f;
#pragma unroll
  for (int r = 0; r < 16; ++r) {
    const int row = crow(r, hi2); const float r0 = 1.0f / li0[row], r1 = lam / li1[row]; float v[4]; float ss = 0.f;
#pragma unroll
    for (int d0 = 0; d0 < 4; ++d0) { v[d0] = o0[d0][r] * r0 - o1[d0][r] * r1; ss += v[d0] * v[d0]; }
    ss += swz_xor<16>(ss); ss += swz_xor<8>(ss); ss += swz_xor<4>(ss); ss += swz_xor<2>(ss); ss += swz_xor<1>(ss);
    const float rs = rsqrtf(ss * (1.0f / 128.0f) + 1e-5f);
    u16* yp = Yb + (yoff + row * 1024);
#pragma unroll
    for (int d0 = 0; d0 < 4; ++d0) yp[d0 * 32] = f2bf(v[d0] * rs * gv[d0]);
  }
  __syncthreads();
#undef SDMA
#undef VWAIT
#undef RESC
#undef QKH
#undef SMBOTH
#undef STEP
#undef TR
#undef PKV
#undef TRD
#undef PVD
#undef ROWMAX
#undef ROWSUM
#undef PK4
}

__device__ __forceinline__ void diff_attn_unit4(const u16* __restrict__ Qb, const u16* __restrict__ Kh, const u16* __restrict__ Vh, u16* __restrict__ Yb,
                                                float lam, const float* __restrict__ subg, const float* __restrict__ kn2, LAS unsigned char* ldsl) {
  const int tid = threadIdx.x, wid = __builtin_amdgcn_readfirstlane(tid >> 6), lane = tid & 63, r32 = lane & 31, hi = lane >> 5;
  LAS float* wsl = (LAS float*)(ldsl + L3_S) + wid * 96; LAS float* li0 = wsl; LAS float* li1 = wsl + 32; LAS float* al_l = wsl + 64;
  float l0 = 0.f, l1 = 0.f; f32x16 o0[4] = {}, o1[4] = {}; bf16x8 q0[4], q1[4];
  int kb[4];
#pragma unroll
  for (int d0 = 0; d0 < 4; ++d0) kb[d0] = r32 * 256 + ((d0 * 32 + hi * 16) ^ ((r32 & 7) << 4));
  { unsigned qoff = (unsigned)((wid * 32 + r32) * LDQ + hi * 8) * 2u; asm volatile("" : "+v"(qoff));
    const char* Qw = (const char*)Qb + qoff;
#pragma unroll
    for (int d0 = 0; d0 < 4; ++d0) { q0[d0] = *reinterpret_cast<const bf16x8*>(Qw + d0 * 32); q1[d0] = *reinterpret_cast<const bf16x8*>(Qw + 128 + d0 * 32); } }
  float mnC0, mnC1;
  { LAS float* cmax = (LAS float*)(ldsl + L3_S) + 8 * 96 - 16;
    int t_ = tid; asm volatile("" : "+v"(t_));
    const int ck = t_ >> 1, cs = t_ & 1; const char* kp_ = (const char*)Kh + (unsigned)(((SEQ + ck) * LDK + cs * 64) * 2); const u16* kp = (const u16*)kp_; float ss = 0.f;
#pragma unroll
    for (int i = 0; i < 8; ++i) ss += sumsq8(*reinterpret_cast<const bf16x8*>(kp + i * 8));
    ss = fmaxf(ss, swz_xor<2>(ss)); ss = fmaxf(ss, swz_xor<4>(ss)); ss = fmaxf(ss, swz_xor<8>(ss)); ss = fmaxf(ss, swz_xor<16>(ss));
    { auto rr = __builtin_amdgcn_permlane32_swap(__float_as_uint(ss), __float_as_uint(ss), false, false); ss = fmaxf(__uint_as_float(rr[0]), __uint_as_float(rr[1])); }
    if (lane < 2) cmax[wid * 2 + lane] = ss;
    __syncthreads();
    float c0 = cmax[0], c1 = cmax[1];
#pragma unroll
    for (int w = 1; w < 8; ++w) { c0 = fmaxf(c0, cmax[2 * w]); c1 = fmaxf(c1, cmax[2 * w + 1]); }
    const float kb0 = fmaxf(kn2[0], c0), kb1 = fmaxf(kn2[1], c1);
    float qa = 0.f, qb = 0.f;
#pragma unroll
    for (int d0 = 0; d0 < 4; ++d0) { qa += sumsq8(q0[d0]); qb += sumsq8(q1[d0]); }
    { auto rr = __builtin_amdgcn_permlane32_swap(__float_as_uint(qa), __float_as_uint(qa), false, false); qa = __uint_as_float(rr[0]) + __uint_as_float(rr[1]); }
    { auto rr = __builtin_amdgcn_permlane32_swap(__float_as_uint(qb), __float_as_uint(qb), false, false); qb = __uint_as_float(rr[0]) + __uint_as_float(rr[1]); }
    constexpr float C = SCALE * 1.4426950408889634f;
    mnC0 = -sqrtf(qa * kb0) * C * 1.0001f - 1e-6f; mnC1 = -sqrtf(qb * kb1) * C * 1.0001f - 1e-6f;
    __syncthreads(); }
  LAS unsigned char* Qw_l = ldsl + L3_Q + wid * 8192;
#pragma unroll
  for (int d0 = 0; d0 < 4; ++d0) { *(LAS bf16x8*)(Qw_l + kb[d0]) = q0[d0]; *(LAS bf16x8*)(Qw_l + kb[d0] + 128) = q1[d0]; }
  LAS unsigned char* vb0 = ldsl + L3_V + v_rd_base(lane);
  unsigned koff[2], voff[2];
#pragma unroll
  for (int i = 0; i < 2; ++i) { const int L = (wid + 8 * i) * 64 + lane;
    { const int row = L >> 4, pos = L & 15; koff[i] = (unsigned)(row * 1024 + ((pos ^ (row & 7)) << 4)); }
    { const int sub = L >> 5, within = L & 31, kk = (sub >> 2) * 8 + (within >> 2), k = (kk & ~0xC) | ((kk & 4) << 1) | ((kk & 8) >> 1), c = (sub & 3) * 32 + (within & 3) * 8;
      voff[i] = (unsigned)(k * 1024 + c * 2); } }
#define SDMA(ko, vo, k0) do { const char* vg = (const char*)Vh + (size_t)(k0) * (LDK * 2); const char* kg = (const char*)Kh + (size_t)(k0) * (LDK * 2); \
    _Pragma("unroll") for (int i = 0; i < 2; ++i) {                                                                                                  \
      __builtin_amdgcn_global_load_lds((const unsigned*)(kg + i * 32768 + koff[0]), (LAS unsigned*)(ldsl + L3_K + (ko) + (wid + 8 * i) * 1024), 16, 0, 0);      \
      __builtin_amdgcn_global_load_lds((const unsigned*)(vg + i * 32768 + voff[0]), (LAS unsigned*)(ldsl + L3_V + (vo) + (wid + 8 * i) * 1024), 16, 0, 0); } } while (0)
#define VWAIT() asm volatile("s_waitcnt vmcnt(0)" ::: "memory")
#define RESC(o, a) do { if (__any((a) < 1.f)) { if (hi == 0) al_l[r32] = (a); asm volatile("s_waitcnt lgkmcnt(0)" ::: "memory"); \
    _Pragma("unroll") for (int d = 0; d < 4; ++d) _Pragma("unroll") for (int r = 0; r < 16; ++r) o[d][r] *= al_l[crow(r, hi)]; } } while (0)
#define QKH(ko, HF) do { s0 = f32x16{}; s1 = f32x16{}; int kx_ = kb[0]; asm volatile("" : "+v"(kx_));                            \
    _Pragma("unroll") for (int d0 = 0; d0 < 4; ++d0) { const int ka_ = kx_ ^ (d0 << 5);                                     \
      const bf16x8 k0 = *(const LAS bf16x8*)(ldsl + L3_K + (ko) + ka_ + (HF) * 8192);                                      \
      const bf16x8 k1 = *(const LAS bf16x8*)(ldsl + L3_K + (ko) + ka_ + (HF) * 8192 + 128);                                \
      const bf16x8 qa_ = *(const LAS bf16x8*)(Qw_l + ka_); const bf16x8 qb_ = *(const LAS bf16x8*)(Qw_l + ka_ + 128);       \
      s0 = __builtin_amdgcn_mfma_f32_32x32x16_bf16(k0, qa_, s0, 0, 0, 0);                                                  \
      s1 = __builtin_amdgcn_mfma_f32_32x32x16_bf16(k1, qb_, s1, 0, 0, 0); } } while (0)
#define SMBOTH() do { bf16x8 n0a, n0b, n1a, n1b; sm_half_b(s0, mnC0, l0, n0a, n0b); sm_half_b(s1, mnC1, l1, n1a, n1b);               \
    p0a = n0a; p0b = n0b; p1a = n1a; p1b = n1b; } while (0)
#define TR(off) __builtin_amdgcn_ds_read_tr16_b64_v4i16((LAS s16x4v*)(vp_ + (off)))
#define PKV(L, H) (bf16x8){L[0], L[1], L[2], L[3], H[0], H[1], H[2], H[3]}
#define TRD(S, d0, HF) do { S##0 = TR(v_rd_off(d0, 2 * (HF), 0)); S##1 = TR(v_rd_off(d0, 2 * (HF), 1)); S##2 = TR(v_rd_off(d0, 2 * (HF) + 1, 0)); S##3 = TR(v_rd_off(d0, 2 * (HF) + 1, 1)); } while (0)
#define PVD(S, d0) do { const bf16x8 va_ = PKV(S##0, S##1), vb_ = PKV(S##2, S##3);                                          \
    o0[d0] = __builtin_amdgcn_mfma_f32_32x32x16_bf16(p0a, va_, o0[d0], 0, 0, 0); o1[d0] = __builtin_amdgcn_mfma_f32_32x32x16_bf16(p1a, va_, o1[d0], 0, 0, 0); \
    o0[d0] = __builtin_amdgcn_mfma_f32_32x32x16_bf16(p0b, vb_, o0[d0], 0, 0, 0); o1[d0] = __builtin_amdgcn_mfma_f32_32x32x16_bf16(p1b, vb_, o1[d0], 0, 0, 0); } while (0)
#define ROWMAX(p, out) do { float t_ = fmaxf(fmaxf(p[0], p[1]), fmaxf(p[2], p[3]));                                        \
    _Pragma("unroll") for (int r = 4; r < 16; r += 2) t_ = fmaxf(t_, fmaxf(p[r], p[r + 1]));                               \
    auto rr_ = __builtin_amdgcn_permlane32_swap(__float_as_uint(t_), __float_as_uint(t_), false, false);                    \
    out = fmaxf(__uint_as_float(rr_[0]), __uint_as_float(rr_[1])); } while (0)
#define ROWSUM(p, out) do { float q0_ = p[0] + p[1], q1_ = p[2] + p[3], q2_ = p[4] + p[5], q3_ = p[6] + p[7];               \
    q0_ += p[8] + p[9]; q1_ += p[10] + p[11]; q2_ += p[12] + p[13]; q3_ += p[14] + p[15]; float t_ = (q0_ + q1_) + (q2_ + q3_); \
    auto rr_ = __builtin_amdgcn_permlane32_swap(__float_as_uint(t_), __float_as_uint(t_), false, false);                    \
    out = __uint_as_float(rr_[0]) + __uint_as_float(rr_[1]); } while (0)
#define PK4(P, BASE, OUT) do { unsigned a0_ = cvtpk(P[BASE + 0], P[BASE + 1]), a1_ = cvtpk(P[BASE + 2], P[BASE + 3]);       \
    unsigned b0_ = cvtpk(P[BASE + 4], P[BASE + 5]), b1_ = cvtpk(P[BASE + 6], P[BASE + 7]);                                  \
    auto r0_ = __builtin_amdgcn_permlane32_swap(a0_, b0_, false, false); auto r1_ = __builtin_amdgcn_permlane32_swap(a1_, b1_, false, false); \
    u32x4 w_ = {r0_[0], r1_[0], r0_[1], r1_[1]}; OUT = *reinterpret_cast<bf16x8*>(&w_); } while (0)
#define STEP(ko, QHF, vp, PVHF) do { LAS unsigned char* vp_ = (vp); constexpr float C_ = SCALE * 1.4426950408889634f;       \
    s16x4v A0, A1, A2, A3, B0, B1, B2, B3; bf16x8 n0a, n0b, n1a, n1b;                                                       \
    TRD(A, 0, PVHF);                                                                                                        \
    QKH(ko, QHF);                                                                                                           \
    SBAR();                                                                                                                 \
    PVD(A, 0); TRD(B, 1, PVHF);                                                                                             \
    _Pragma("unroll") for (int r = 0; r < 16; ++r) s0[r] = __builtin_amdgcn_exp2f(fmaf(s0[r], C_, mnC0));                   \
    SBAR();                                                                                                                 \
    PVD(B, 1); TRD(A, 2, PVHF);                                                                                             \
    _Pragma("unroll") for (int r = 0; r < 16; ++r) s1[r] = __builtin_amdgcn_exp2f(fmaf(s1[r], C_, mnC1));                   \
    SBAR();                                                                                                                 \
    PVD(A, 2); TRD(B, 3, PVHF);                                                                                             \
    { float ps0, ps1; ROWSUM(s0, ps0); ROWSUM(s1, ps1); l0 += ps0; l1 += ps1; PK4(s0, 0, n0a); PK4(s0, 8, n0b); }            \
    SBAR();                                                                                                                 \
    PVD(B, 3);                                                                                                              \
    { PK4(s1, 0, n1a); PK4(s1, 8, n1b); }                                                                                    \
    SBAR();                                                                                                                 \
    p0a = n0a; p0b = n0b; p1a = n1a; p1b = n1b; } while (0)
  constexpr int NT = NKEY / KVBLK;
  f32x16 s0, s1; bf16x8 p0a, p0b, p1a, p1b;
  SDMA(0, 0, 0); VWAIT(); __syncthreads();
  SDMA(SHM_K, SHM_V, KVBLK);
  QKH(0, 0); SMBOTH();
  int vcur = 0;
  for (int j = 0; j < NT; ++j) {
    const int kcur = (j & 1) * SHM_K, knext = SHM_K - kcur;
    const int vnext = vcur == 2 * SHM_V ? 0 : vcur + SHM_V, vnn = vnext == 2 * SHM_V ? 0 : vnext + SHM_V;
    STEP(kcur, 1, vb0 + vcur, 0);
    VWAIT(); __syncthreads();
    if (j + 2 < NT) SDMA(kcur, vnn, (j + 2) * KVBLK);
    if (j + 1 < NT) { STEP(knext, 0, vb0 + vcur, 1); }
    else pv_all<1>(o0, o1, vb0 + vcur, p0a, p0b, p1a, p1b);
    vcur = vnext;
  }
  int te = tid; asm volatile("" : "+v"(te));
  const int r32e = te & 31; int hi2 = (te >> 5) & 1, yoff = wid * 32 * 1024 + r32e;
  if (hi2 == 0) { li0[r32e] = l0; li1[r32e] = l1; } asm volatile("s_waitcnt lgkmcnt(0)" ::: "memory");
  float gv[4];
#pragma unroll
  for (int d0 = 0; d0 < 4; ++d0) gv[d0] = subg[d0 * 32 + (yoff & 31)] * 0.8f;
#pragma unroll
  for (int r = 0; r < 16; ++r) {
    const int row = crow(r, hi2); const float r0 = 1.0f / li0[row], r1 = lam / li1[row]; float v[4]; float ss = 0.f;
#pragma unroll
    for (int d0 = 0; d0 < 4; ++d0) { v[d0] = o0[d0][r] * r0 - o1[d0][r] * r1; ss += v[d0] * v[d0]; }
    ss += swz_xor<16>(ss); ss += swz_xor<8>(ss); ss += swz_xor<4>(ss); ss += swz_xor<2>(ss); ss += swz_xor<1>(ss);
    const float rs = rsqrtf(ss * (1.0f / 128.0f) + 1e-5f);
    u16* yp = Yb + (yoff + row * 1024);
#pragma unroll
    for (int d0 = 0; d0 < 4; ++d0) yp[d0 * 32] = f2bf(v[d0] * rs * gv[d0]);
  }
  __syncthreads();
#undef SDMA
#undef VWAIT
#undef RESC
#undef QKH
#undef SMBOTH
#undef STEP
#undef TR
#undef PKV
#undef TRD
#undef PVD
#undef ROWMAX
#undef ROWSUM
#undef PK4
}
}


__device__ __forceinline__ void key_norm_pass(const Params& p, int tid, int G, int bx) {
    const u16* K = (const u16*)(p.ws + WS_R2 + R2_K); int* KN = (int*)(p.ws + WS_KN2);
    const int lane = tid & 63, gw = bx * 8 + (tid >> 6), nw = G * 8;
    float mx0 = 0.f, mx1 = 0.f;
    for (int rb = gw; rb < 2 * SEQ; rb += 8 * nw) {
        att::bf16x8 v[8];
#pragma unroll
        for (int k = 0; k < 8; ++k) { const int r = rb + k * nw < 2 * SEQ ? rb + k * nw : rb; v[k] = *reinterpret_cast<const att::bf16x8*>(K + ((size_t)(r >> 14) * NKEY + (r & (SEQ - 1))) * 512 + lane * 8); }
#pragma unroll
        for (int k = 0; k < 8; ++k) { const int r = rb + k * nw < 2 * SEQ ? rb + k * nw : rb;
            float s = att::sumsq8(v[k]); s += att::swz_xor<1>(s); s += att::swz_xor<2>(s); s += att::swz_xor<4>(s);
            if (r >> 14) mx1 = fmaxf(mx1, s); else mx0 = fmaxf(mx0, s); }
    }
    if ((lane & 7) == 0) { if (mx0 > 0.f) atomicMax(KN + (lane >> 3), __float_as_int(mx0)); if (mx1 > 0.f) atomicMax(KN + 8 + (lane >> 3), __float_as_int(mx1)); }
}

__device__ __forceinline__ void attn_phase(const Params& p, char* lds, LAS unsigned char* ldsl, int tid, int G, int bx) {
    const int lane = tid & 63;
    float sa = p.lam[lane] * p.lam[64 + lane], sb = p.lam[128 + lane] * p.lam[192 + lane];
    sa += att::swz_xor<1>(sa); sa += att::swz_xor<2>(sa); sa += att::swz_xor<4>(sa); sa += att::swz_xor<8>(sa); sa += att::swz_xor<16>(sa);
    sb += att::swz_xor<1>(sb); sb += att::swz_xor<2>(sb); sb += att::swz_xor<4>(sb); sb += att::swz_xor<8>(sb); sb += att::swz_xor<16>(sb);
    { auto rr = __builtin_amdgcn_permlane32_swap(__float_as_uint(sa), __float_as_uint(sa), false, false); sa = __uint_as_float(rr[0]) + __uint_as_float(rr[1]); }
    { auto rr = __builtin_amdgcn_permlane32_swap(__float_as_uint(sb), __float_as_uint(sb), false, false); sb = __uint_as_float(rr[0]) + __uint_as_float(rr[1]); }
    const float lam = expf(sa) - expf(sb) + 0.2f;
    const u16* Q = (const u16*)(p.ws + WS_R2 + R2_Q); const u16* K = (const u16*)(p.ws + WS_R2 + R2_K); const u16* V = (const u16*)(p.ws + WS_R2 + R2_V);
    u16* Y = (u16*)(p.ws + WS_U);
#if ATT_V1
    for (int i = bx; i < 1024; i += G) {
        const int bh = i & 7, qblk = i >> 3, b = bh >> 2, h = bh & 3;
        att::diff_attn_unit(Q + ((size_t)b * SEQ + (size_t)qblk * 128) * 512 + h * 128, K + (size_t)b * NKEY * 512 + h * 128, V + (size_t)b * NKEY * 512 + h * 128,
                            Y + ((size_t)b * SEQ + (size_t)qblk * 128) * 1024 + 512 + h * 128, lam, p.subln_g, lds);
    }
#elif ATT_V2
    for (int i = bx; i < 512; i += G) {
        const int bh = i & 7, qblk = i >> 3, b = bh >> 2, h = bh & 3;
        att::diff_attn_unit2(Q + ((size_t)b * SEQ + (size_t)qblk * 256) * 512 + h * 128, K + (size_t)b * NKEY * 512 + h * 128, V + (size_t)b * NKEY * 512 + h * 128,
                             Y + ((size_t)b * SEQ + (size_t)qblk * 256) * 1024 + 512 + h * 128, lam, p.subln_g, (const float*)(p.ws + WS_KN2) + bh * 2, lds, ldsl);
    }
#elif ATT_V4
    for (int i = bx; i < 512; i += G) {
        const int bh = i & 7, qblk = i >> 3, b = bh >> 2, h = bh & 3;
        att::diff_attn_unit4(Q + ((size_t)b * SEQ + (size_t)qblk * 256) * 512 + h * 128, K + (size_t)b * NKEY * 512 + h * 128, V + (size_t)b * NKEY * 512 + h * 128,
                             Y + ((size_t)b * SEQ + (size_t)qblk * 256) * 1024 + 512 + h * 128, lam, p.subln_g, (const float*)(p.ws + WS_KN2) + bh * 2, ldsl);
    }
#else
    for (int i = bx; i < 512; i += G) {
        const int bh = i & 7, qblk = i >> 3, b = bh >> 2, h = bh & 3;
        att::diff_attn_unit3(Q + ((size_t)b * SEQ + (size_t)qblk * 256) * 512 + h * 128, K + (size_t)b * NKEY * 512 + h * 128, V + (size_t)b * NKEY * 512 + h * 128,
                             Y + ((size_t)b * SEQ + (size_t)qblk * 256) * 1024 + 512 + h * 128, lam, p.subln_g, ldsl);
    }
#endif
}

#define UNPK8(d, V_) do { const u32x4 q_ = (V_); d[0] = __uint_as_float(q_.x << 16); d[1] = __uint_as_float(q_.x & 0xffff0000u); d[2] = __uint_as_float(q_.y << 16); d[3] = __uint_as_float(q_.y & 0xffff0000u); \
    d[4] = __uint_as_float(q_.z << 16); d[5] = __uint_as_float(q_.z & 0xffff0000u); d[6] = __uint_as_float(q_.w << 16); d[7] = __uint_as_float(q_.w & 0xffff0000u); } while (0)
__device__ __forceinline__ void hy_t1(const Params& p, float* ldsf, int tid, int G, int bx) {
    const u16* Z = (const u16*)(p.ws + WS_R2 + R2_Z); float* W = (float*)(p.ws + WS_W);
    constexpr int BUF = 8704;
    u32x4 w[3];
#define T1_LOAD(it_) do { const int cb_ = (it_) & 7, tb_ = ((it_) >> 3) & 255, b_ = (it_) >> 11, t0_ = tb_ * 64, c0_ = cb_ * 64;                  \
        _Pragma("unroll") for (int k = 0; k < 3; ++k) { const int e = tid + 512 * k, piece = e & 7, seg = e >> 3, tensor = seg & 1, row = seg >> 1, t = t0_ - 1 + row; \
            w[k] = (e < 1056 && t >= 0 && t < SEQ) ? *(const u32x4*)(Z + ((size_t)b_ * SEQ + t) * 1536 + 512 + tensor * 512 + c0_ + piece * 8) : (u32x4){0u, 0u, 0u, 0u}; } } while (0)
#define T1_STORE(buf_) do { _Pragma("unroll") for (int k = 0; k < 3; ++k) { const int e = tid + 512 * k, piece = e & 7, seg = e >> 3, tensor = seg & 1, row = seg >> 1; \
            if (e < 1056) { float* d = (buf_) + tensor * (66 * 65) + row * 65 + piece * 8; UNPK8(d, w[k]); } } } while (0)
    int it = bx, cur = 0;
    if (it < 4096) { T1_LOAD(it); T1_STORE(ldsf); }
    __syncthreads();
    for (; it < 4096; it += G) {
        const int nxt = it + G;
        if (nxt < 4096) T1_LOAD(nxt);
        const int cb = it & 7, tb = (it >> 3) & 255, b = it >> 11, t0 = tb * 64, c0 = cb * 64;
        const float* lb = ldsf + cur * BUF;
        const int t = tid & 63, cg8 = tid >> 6;
#pragma unroll
        for (int i = 0; i < 8; ++i) { const int c = cg8 * 8 + i, ch1 = 512 + c0 + c, chv = 1024 + c0 + c;
            const float* a = lb + t * 65 + c; const float* v = a + 66 * 65;
            const float x1 = a[0] * p.conv_w[ch1] + a[65] * p.conv_w[1536 + ch1] + a[130] * p.conv_w[3072 + ch1] + p.conv_b[ch1];
            const float xv = v[0] * p.conv_w[chv] + v[65] * p.conv_w[1536 + chv] + v[130] * p.conv_w[3072 + chv] + p.conv_b[chv];
            W[((size_t)(c0 + c) * 2 + b) * SEQ + t0 + t] = x1 * xv; }
        if (nxt < 4096) T1_STORE(ldsf + (cur ^ 1) * BUF);
        __syncthreads();
        cur ^= 1;
    }
#undef T1_LOAD
#undef T1_STORE
}
__device__ __forceinline__ void hy_t2(const Params& p, float* ldsf, int tid, int G, int bx) {
    const u16* Z = (const u16*)(p.ws + WS_R2 + R2_Z); const float* W = (const float*)(p.ws + WS_W); u16* Y = (u16*)(p.ws + WS_U);
    constexpr int BUF = 8704;
    u32x4 w[2]; float yv[8];
#define T2_LOAD(it_) do { const int cb_ = (it_) & 7, tb_ = ((it_) >> 3) & 255, b_ = (it_) >> 11, t0_ = tb_ * 64, c0_ = cb_ * 64;                  \
        _Pragma("unroll") for (int k = 0; k < 2; ++k) { const int e = tid + 512 * k, piece = e & 7, row = e >> 3, t = t0_ - 1 + row;             \
            w[k] = (e < 528 && t >= 0 && t < SEQ) ? *(const u32x4*)(Z + ((size_t)b_ * SEQ + t) * 1536 + c0_ + piece * 8) : (u32x4){0u, 0u, 0u, 0u}; } \
        _Pragma("unroll") for (int i = 0; i < 8; ++i) yv[i] = W[((size_t)(c0_ + (tid >> 6) * 8 + i) * 2 + b_) * SEQ + t0_ + (tid & 63)]; } while (0)
#define T2_STORE(buf_) do { _Pragma("unroll") for (int k = 0; k < 2; ++k) { const int e = tid + 512 * k, piece = e & 7, row = e >> 3;           \
            if (e < 528) { float* d = (buf_) + row * 65 + piece * 8; UNPK8(d, w[k]); } }                                                       \
        _Pragma("unroll") for (int i = 0; i < 8; ++i) (buf_)[66 * 65 + ((tid >> 6) * 8 + i) * 65 + (tid & 63)] = yv[i]; } while (0)
    int it = bx, cur = 0;
    if (it < 4096) { T2_LOAD(it); T2_STORE(ldsf); }
    __syncthreads();
    for (; it < 4096; it += G) {
        const int nxt = it + G;
        if (nxt < 4096) T2_LOAD(nxt);
        const int cb = it & 7, tb = (it >> 3) & 255, b = it >> 11, t0 = tb * 64, c0 = cb * 64;
        const float* lb = ldsf + cur * BUF; const float* ly = lb + 66 * 65;
        const int c = tid & 63, tg = tid >> 6, ch0 = c0 + c;
        const float w0 = p.conv_w[ch0], w1 = p.conv_w[1536 + ch0], w2 = p.conv_w[3072 + ch0], bb = p.conv_b[ch0];
#pragma unroll
        for (int i = 0; i < 8; ++i) { const int t = tg * 8 + i; const float* a = lb + t * 65 + c;
            const float x0 = a[0] * w0 + a[65] * w1 + a[130] * w2 + bb;
            Y[((size_t)b * SEQ + t0 + t) * 1024 + ch0] = f2bf(x0 * ly[c * 65 + t]); }
        if (nxt < 4096) T2_STORE(ldsf + (cur ^ 1) * BUF);
        __syncthreads();
        cur ^= 1;
    }
#undef T2_LOAD
#undef T2_STORE
}

__device__ __forceinline__ int fsw(int i) { return i ^ ((i >> 5) & 3) ^ (((i >> 6) & 7) << 2); }
struct FftTw { float2 a1[8], b1[2], a2[4], b2, a3[4], b3; };
__device__ __forceinline__ void fft_load_tw(FftTw& T, const float2* __restrict__ tw, int tid) {
#pragma unroll
    for (int b = 0; b < 4; ++b) { T.a1[2 * b] = tw[b * 1024 + tid]; T.a1[2 * b + 1] = tw[b * 1024 + tid + 512];
        T.a2[b] = tw[b * 1024 + (tid & 63) * 16]; T.a3[b] = tw[b * 1024 + (tid & 3) * 256]; }
    T.b1[0] = tw[tid * 4]; T.b1[1] = tw[(tid + 512) * 4]; T.b2 = tw[(tid & 63) * 64]; T.b3 = tw[(tid & 3) * 1024];
}
__device__ __forceinline__ void bf4_fwd(float2& a0, float2& a1, float2& a2, float2& a3, float2 w1) {
    const float2 w2 = cmul(w1, w1), w3 = cmul(w2, w1);
    const float2 s02 = make_float2(a0.x + a2.x, a0.y + a2.y), d02 = make_float2(a0.x - a2.x, a0.y - a2.y);
    const float2 s13 = make_float2(a1.x + a3.x, a1.y + a3.y), d13 = make_float2(a1.x - a3.x, a1.y - a3.y);
    a0 = make_float2(s02.x + s13.x, s02.y + s13.y);
    a1 = cmul(make_float2(d02.x + d13.y, d02.y - d13.x), w1);
    a2 = cmul(make_float2(s02.x - s13.x, s02.y - s13.y), w2);
    a3 = cmul(make_float2(d02.x - d13.y, d02.y + d13.x), w3);
}
__device__ __forceinline__ void bf4_inv(float2& a0, float2& a1, float2& a2, float2& a3, float2 w1  ) {
    const float2 w2 = cmul(w1, w1), w3 = cmul(w2, w1);
    const float2 b1 = cmul(a1, w1), b2 = cmul(a2, w2), b3 = cmul(a3, w3);
    const float2 s02 = make_float2(a0.x + b2.x, a0.y + b2.y), d02 = make_float2(a0.x - b2.x, a0.y - b2.y);
    const float2 s13 = make_float2(b1.x + b3.x, b1.y + b3.y), d13 = make_float2(b1.x - b3.x, b1.y - b3.y);
    a0 = make_float2(s02.x + s13.x, s02.y + s13.y);
    a1 = make_float2(d02.x - d13.y, d02.y + d13.x);
    a2 = make_float2(s02.x - s13.x, s02.y - s13.y);
    a3 = make_float2(d02.x + d13.y, d02.y - d13.x);
}
struct FftNoPre {};
struct FftLdsIO { typedef FftNoPre Pre; float2* d; __device__ __forceinline__ float2 ld(int n) const { return d[fsw(n)]; } __device__ __forceinline__ Pre pre(int) const { return Pre{}; }
    __device__ __forceinline__ void st(int n, float2 v, const Pre&) const { d[fsw(n)] = v; } };
template <int QB, int SHB, bool INV, int PAIR, class In = FftLdsIO, class Out = FftLdsIO> __device__ __forceinline__ void fft_pair_io(const In& in, const Out& out, const FftTw& T, int tid_) {
    int tid = tid_; asm volatile("" : "+v"(tid));
    float2 wa[2][4], wb[2];
#pragma unroll
    for (int i = 0; i < 2; ++i) {
#pragma unroll
        for (int b = 0; b < 4; ++b) wa[i][b] = PAIR == 1 ? T.a1[2 * b + i] : (PAIR == 2 ? T.a2[b] : T.a3[b]);
        wb[i] = PAIR == 1 ? T.b1[i] : (PAIR == 2 ? T.b2 : T.b3); }
    asm volatile("" : "+v"(wa[0][0].x), "+v"(wa[0][0].y), "+v"(wa[0][1].x), "+v"(wa[0][1].y), "+v"(wa[0][2].x), "+v"(wa[0][2].y), "+v"(wa[0][3].x), "+v"(wa[0][3].y), "+v"(wb[0].x), "+v"(wb[0].y));
    if (PAIR == 1) asm volatile("" : "+v"(wa[1][0].x), "+v"(wa[1][0].y), "+v"(wa[1][1].x), "+v"(wa[1][1].y), "+v"(wa[1][2].x), "+v"(wa[1][2].y), "+v"(wa[1][3].x), "+v"(wa[1][3].y), "+v"(wb[1].x), "+v"(wb[1].y));
#pragma unroll
    for (int i = 0; i < 2; ++i) {
        const int ii = PAIR == 1 ? i : 0;
        const int G = tid + 512 * i, j = G & (QB - 1), g = G >> SHB, base = g * 16 * QB + j;
        float2 x[4][4];
#pragma unroll
        for (int a = 0; a < 4; ++a)
#pragma unroll
            for (int b = 0; b < 4; ++b) x[a][b] = in.ld(base + (4 * a + b) * QB);
        if (!INV) {
#pragma unroll
            for (int b = 0; b < 4; ++b) bf4_fwd(x[0][b], x[1][b], x[2][b], x[3][b], wa[ii][b]);
#pragma unroll
            for (int a = 0; a < 4; ++a) bf4_fwd(x[a][0], x[a][1], x[a][2], x[a][3], wb[ii]);
        } else {
#pragma unroll
            for (int a = 0; a < 4; ++a) bf4_inv(x[a][0], x[a][1], x[a][2], x[a][3], make_float2(wb[ii].x, -wb[ii].y));
#pragma unroll
            for (int b = 0; b < 4; ++b) bf4_inv(x[0][b], x[1][b], x[2][b], x[3][b], make_float2(wa[ii][b].x, -wa[ii][b].y));
        }
#pragma unroll
        for (int ah = 0; ah < 4; ah += 2) {
            typename Out::Pre pr[2][4];
#pragma unroll
            for (int a = 0; a < 2; ++a)
#pragma unroll
                for (int b = 0; b < 4; ++b) pr[a][b] = out.pre(base + (4 * (ah + a) + b) * QB);
#pragma unroll
            for (int a = 0; a < 2; ++a)
#pragma unroll
                for (int b = 0; b < 4; ++b) out.st(base + (4 * (ah + a) + b) * QB, x[ah + a][b], pr[a][b]);
        }
    }
    __syncthreads();
}
template <int QB, int SHB, bool INV, int PAIR> __device__ __forceinline__ void fft_pair(float2* d, const FftTw& T, int tid) { const FftLdsIO io{d}; fft_pair_io<QB, SHB, INV, PAIR>(io, io, T, tid); }
template <bool INV, int MODE> __device__ __forceinline__ void fft_q1(float2* d, int tid_, float2* __restrict__ KS) {
    int tid = tid_; asm volatile("" : "+v"(tid));
#pragma unroll
    for (int h = 0; h < 2; ++h) {
        float2 ks[4][4];
        if (MODE == 2) {
#pragma unroll
            for (int i = 0; i < 4; ++i) { const float4* kp = (const float4*)(KS + (tid + 512 * (4 * h + i)) * 4); const float4 k01 = kp[0], k23 = kp[1];
                ks[i][0] = make_float2(k01.x, k01.y); ks[i][1] = make_float2(k01.z, k01.w); ks[i][2] = make_float2(k23.x, k23.y); ks[i][3] = make_float2(k23.z, k23.w); } }
#pragma unroll
        for (int i = 0; i < 4; ++i) {
            const int i0 = (tid + 512 * (4 * h + i)) * 4, p0 = fsw(i0), p1 = fsw(i0 + 1), p2 = fsw(i0 + 2), p3 = fsw(i0 + 3);
            const float2 a0 = d[p0], a1 = d[p1], a2 = d[p2], a3 = d[p3];
            const float2 s02 = make_float2(a0.x + a2.x, a0.y + a2.y), d02 = make_float2(a0.x - a2.x, a0.y - a2.y);
            const float2 s13 = make_float2(a1.x + a3.x, a1.y + a3.y), d13 = make_float2(a1.x - a3.x, a1.y - a3.y);
            float2 u0 = make_float2(s02.x + s13.x, s02.y + s13.y), u2 = make_float2(s02.x - s13.x, s02.y - s13.y), u1, u3;
            if (!INV) { u1 = make_float2(d02.x + d13.y, d02.y - d13.x); u3 = make_float2(d02.x - d13.y, d02.y + d13.x); }
            else      { u1 = make_float2(d02.x - d13.y, d02.y + d13.x); u3 = make_float2(d02.x + d13.y, d02.y - d13.x); }
            if (MODE == 1) { float4* kp = (float4*)(KS + i0); kp[0] = make_float4(u0.x, u0.y, u1.x, u1.y); kp[1] = make_float4(u2.x, u2.y, u3.x, u3.y); }
            else {
                if (MODE == 2) { u0 = cmul(u0, ks[i][0]); u1 = cmul(u1, ks[i][1]); u2 = cmul(u2, ks[i][2]); u3 = cmul(u3, ks[i][3]); }
                d[p0] = u0; d[p1] = u1; d[p2] = u2; d[p3] = u3; }
        }
    }
    __syncthreads();
}
template <bool INV, int MODE, class IO> __device__ __forceinline__ void fft16k(float2* d, const FftTw& T, int tid, float2* KS, const IO& gio) {
    const FftLdsIO lio{d};
    if (!INV) { fft_pair_io<1024, 10, false, 1>(gio, lio, T, tid);
                fft_pair<64, 6, false, 2>(d, T, tid); fft_pair<4, 2, false, 3>(d, T, tid); fft_q1<false, MODE>(d, tid, KS); }
    else      { fft_q1<true, 0>(d, tid, KS); fft_pair<4, 2, true, 3>(d, T, tid); fft_pair<64, 6, true, 2>(d, T, tid);
                fft_pair_io<1024, 10, true, 1>(lio, gio, T, tid); }
}
struct KernIn { typedef FftNoPre Pre; const u16* hf; const u16* hb; const float2* om; int pass;
    __device__ __forceinline__ float2 ld(int n) const { const float f = bf2f(hf[n]), g = n ? bf2f(hb[(SEQ - n) & (SEQ - 1)]) : 0.f;
        if (pass == 0) return make_float2(f + g, 0.f); const float2 o = om[n]; const float kv = f - g; return make_float2(kv * o.x, kv * o.y); }
    __device__ __forceinline__ Pre pre(int) const { return Pre{}; }
    __device__ __forceinline__ void st(int, float2, const Pre&) const {} };
struct DataPre { float2 o, q; float a, b; };
struct DataIO { typedef DataPre Pre; float* w0; float* w1; const float2* om; float2* p1; float bias; int pass; bool dummy;
    __device__ __forceinline__ float2 ld(int n) const { const float2 z = make_float2(w0[n], w1[n]); return pass ? cmul(z, om[n]) : z; }
    __device__ __forceinline__ Pre pre(int n) const { Pre r; if (pass == 0 || dummy) { r.o = make_float2(1.f, 0.f); r.q = make_float2(0.f, 0.f); r.a = 0.f; r.b = 0.f; }
        else { r.o = om[n]; r.q = p1[n]; r.a = w0[n]; r.b = w1[n]; } return r; }
    __device__ __forceinline__ void st(int n, float2 r, const Pre& pr) const { r.x *= (1.0f / SEQ); r.y *= (1.0f / SEQ);
        if (pass == 0 || dummy) { p1[n] = r; return; }
        r = cmul(r, make_float2(pr.o.x, -pr.o.y));
        w0[n] = 0.5f * (pr.q.x + r.x) + bias * pr.a; w1[n] = 0.5f * (pr.q.y + r.y) + bias * pr.b; } };

__device__ __forceinline__ void hy_fft(const Params& p, float2* d, int tid, int G, int bx, bool dummy) {
    const u16* HF = (const u16*)(p.ws + WS_HFILT); float* W = (float*)(p.ws + WS_W); const float2* tw = (const float2*)(p.ws + WS_TW); const float2* OM = (const float2*)(p.ws + WS_OM);
    float2* KS = (float2*)(p.ws + WS_SCR + (size_t)bx * 262144); float2* P1 = KS + SEQ;
    FftTw T; fft_load_tw(T, tw, tid);
    for (int c = bx; c < 512; c += G) {
        float* W0 = W + (size_t)(c * 2) * SEQ; float* W1 = W0 + SEQ;
        for (int pass = 0; pass < 2; ++pass) {
            const KernIn kin{HF + (size_t)c * SEQ, HF + (size_t)(512 + c) * SEQ, OM, pass};
            const DataIO dio{W0, W1, OM, P1, p.hy_bias[c], pass, dummy};
            fft16k<false, 1>(d, T, tid, KS, kin);
            fft16k<false, 2>(d, T, tid, KS, dio);
            fft16k<true, 0>(d, T, tid, KS, dio);
        }
    }
}

__global__ void __launch_bounds__(512, 2) mega(Params p) {
    extern __shared__ __attribute__((aligned(16))) unsigned char lds[];
    cg::grid_group grid = cg::this_grid();
    const int tid = threadIdx.x, G = gridDim.x, bx = blockIdx.x;
    float* ldsf = (float*)lds;
    LAS unsigned char* ldsl = (LAS unsigned char*)lds;
    const int lo = p.ph_lo, hi = p.ph_hi;
    if (p.ph_hi > 1000) grid.sync();
    if (tid < 4) ((unsigned*)(lds + LDS_MAIN))[tid] = 0u;
    __syncthreads();
    XcdBarrier xbar = xcd_barrier_post((unsigned*)(p.ws + WS_BAR), (volatile XB_LAS unsigned*)(ldsl + LDS_MAIN));
#define mod ((const float*)(p.ws + WS_MOD))
#define U ((u16*)(p.ws + WS_U))
#define HID ((u16*)(p.ws + WS_R2))
#define HCTX ((float*)(p.ws + WS_HCTX))
#ifndef PHMASK
#define PHMASK 0xFFFF
#endif
#define IN(k) (((PHMASK >> (k)) & 1) && lo <= (k) && (k) < hi)
#ifndef PROBE_REP_MASK
#define PROBE_REP_MASK 0
#endif
#ifndef ATT_V1
#define ATT_V1 0
#endif
#ifndef PROBE_FFT
#define PROBE_FFT 0
#endif
#ifndef PROBE_SYNC
#define PROBE_SYNC 0
#endif
#define REPS(k) _Pragma("nounroll") for (int rep_ = 0; rep_ < 1 + ((PROBE_REP_MASK >> (k)) & 1); ++rep_)
#define SYNC(k) do { if (lo <= (k) && (k) + 1 < hi) { xcd_barrier(xbar); } } while (0)
    if (IN(0)) REPS(0) phase_prep(p, ldsf, tid, G, bx);
    SYNC(0);
    if (IN(1)) REPS(1) { adaln_rows(p, p.x, p.ctx, 0, MROWS, 0, 0, 1, U, HCTX, tid, G, bx); hfilt_items(p, ldsf, tid, G, bx); }
    SYNC(1);
    if (IN(2)) { pg8::Gemm g{U, (const u16*)(p.ws + WS_WB0), MROWS, 2 * FF, DM, DM}; pg8::StaticOrder S; S.init(MROWS, 2 * FF, G, bx); S.dsh = (PROBE_REP_MASK >> 2) & 1; EpiSwiGLU E{HID};
        pg8::gemm_phase<EpiSwiGLU, pg8::StaticOrder>(ldsl, g, S, E, nullptr); }
    SYNC(2);
    if (IN(3)) { pg8::Gemm g{HID, (const u16*)(p.ws + WS_WD0), NLAT, DM, FF, FF}; pg8::StaticOrder S; S.init(NLAT, DM, G, bx); S.dsh = (PROBE_REP_MASK >> 3) & 1; EpiResid E{p.x, p.ctx, p.out, HCTX, mod, 2, 0.5f};
        pg8::gemm_phase<EpiResid, pg8::StaticOrder>(ldsl, g, S, E, nullptr); }
    SYNC(3);
    if (IN(4)) { adaln_rows(p, p.out, HCTX, 0, NLAT, 1, 3, 4, U, nullptr, tid, G, bx);
        pg8::Gemm g{HID, (const u16*)(p.ws + WS_WD0), MROWS, DM, 256, FF}; CtxSplitOrder S{G, bx}; EpiCtxAtomic E{HCTX, mod, 2, 0.5f};
        pg8::gemm_phase<EpiCtxAtomic, CtxSplitOrder>(ldsl, g, S, E, nullptr); }
    SYNC(4);
    if (IN(5)) { pg8::Gemm g{U, (const u16*)(p.ws + WS_WIN), NLAT, DIN, DM, DM}; pg8::StaticOrder S; S.init(NLAT, DIN, G, bx); S.dsh = (PROBE_REP_MASK >> 5) & 1;
        EpiInProj E{(u16*)(p.ws + WS_R2 + R2_Z), (u16*)(p.ws + WS_R2 + R2_Q), (u16*)(p.ws + WS_R2 + R2_K), (u16*)(p.ws + WS_R2 + R2_V), (const float*)(p.ws + WS_ROPE)};
        pg8::gemm_phase<EpiInProj, pg8::StaticOrder>(ldsl, g, S, E, nullptr);
        adaln_rows(p, p.out, HCTX, NLAT, MROWS, 1, 3, 4, U, nullptr, tid, G, bx); }
    SYNC(5);
    if (IN(6)) { hy_t1(p, ldsf, tid, G, bx); key_norm_pass(p, tid, G, bx);
        pg8::Gemm g{U, (const u16*)(p.ws + WS_WIN), MROWS, DIN, DM, DM}; CtxKvOrder S{G, bx};
        EpiInProj E{(u16*)(p.ws + WS_R2 + R2_Z), (u16*)(p.ws + WS_R2 + R2_Q), (u16*)(p.ws + WS_R2 + R2_K), (u16*)(p.ws + WS_R2 + R2_V), (const float*)(p.ws + WS_ROPE)};
        pg8::gemm_phase<EpiInProj, CtxKvOrder>(ldsl, g, S, E, nullptr); }
    SYNC(6);
    if (IN(7)) {
#ifndef NO_ATT
        REPS(7) attn_phase(p, (char*)lds, ldsl, tid, G, bx);
#endif
#ifndef NO_FFT
#if PROBE_FFT
        hy_fft(p, (float2*)lds, tid, G, bx, true);
#endif
        hy_fft(p, (float2*)lds, tid, G, bx, false);
#endif
#if PROBE_SYNC
        for (int i_ = 0; i_ < 10; ++i_) grid.sync();
#endif
    }
    SYNC(7);
    if (IN(8)) REPS(8) hy_t2(p, ldsf, tid, G, bx);
    SYNC(8);
    if (IN(9)) { pg8::Gemm g{U, (const u16*)(p.ws + WS_WOUT), NLAT, DM, DM, DM}; pg8::StaticOrder S; S.init(NLAT, DM, G, bx); EpiResid E{p.out, p.out, p.out, p.out, mod, 5, 1.0f};
        pg8::gemm_phase<EpiResid, pg8::StaticOrder>(ldsl, g, S, E, nullptr); }
    SYNC(9);
    if (IN(10)) adaln_rows(p, p.out, HCTX, 0, NLAT, 2, 6, 7, U, nullptr, tid, G, bx);
    SYNC(10);
    if (IN(11)) { pg8::Gemm g{U, (const u16*)(p.ws + WS_WB1), NLAT, 2 * FF, DM, DM}; pg8::StaticOrder S; S.init(NLAT, 2 * FF, G, bx); S.dsh = (PROBE_REP_MASK >> 11) & 1; EpiSwiGLU E{HID};
        pg8::gemm_phase<EpiSwiGLU, pg8::StaticOrder>(ldsl, g, S, E, nullptr); }
    SYNC(11);
    if (IN(12)) { pg8::Gemm g{HID, (const u16*)(p.ws + WS_WD1), NLAT, DM, FF, FF}; pg8::StaticOrder S; S.init(NLAT, DM, G, bx); EpiResid E{p.out, p.out, p.out, p.out, mod, 8, 0.5f};
        pg8::gemm_phase<EpiResid, pg8::StaticOrder>(ldsl, g, S, E, nullptr); }
    SYNC(12);
    if (IN(13)) final_norm(p, tid, G, bx);
#undef IN
#undef SYNC
#undef mod
#undef U
#undef HID
#undef HCTX
}

extern "C" void kernel_launch(void* const* d_in, const int* in_sizes, int n_in, void* d_out, int out_size, void* d_ws, size_t ws_size, hipStream_t stream) {
    static int grid = 0;
    if (grid == 0) {
        if (n_in != 24 || ws_size < WS_END) { fprintf(stderr, "kernel_launch: n_in %d ws %zu (need %zu)\n", n_in, ws_size, (size_t)WS_END); grid = -1; return; }
        int dev = 0, cus = 0, per_cu = 0;
        hipGetDevice(&dev); hipDeviceGetAttribute(&cus, hipDeviceAttributeMultiprocessorCount, dev);
        if (hipFuncSetAttribute((const void*)mega, hipFuncAttributeMaxDynamicSharedMemorySize, LDS_BYTES) != hipSuccess) { fprintf(stderr, "kernel_launch: hipFuncSetAttribute failed\n"); grid = -1; return; }
        if (hipOccupancyMaxActiveBlocksPerMultiprocessor(&per_cu, (const void*)mega, 512, LDS_BYTES) != hipSuccess || per_cu < 1) { fprintf(stderr, "kernel_launch: occupancy query gives %d\n", per_cu); per_cu = 1; }
        (void)hipGetLastError();
        grid = cus * per_cu; if (grid > 256) grid = 256;
    }
    if (grid < 0) return;
    Params p{};
    const float** pp = (const float**)&p;
    for (int i = 0; i < 24; ++i) pp[i] = (const float*)d_in[i];
    p.out = (float*)d_out; p.ws = (unsigned char*)d_ws;
#if MULTI_LAUNCH
    for (int ph = 0; ph < NPHASE; ++ph) { p.ph_lo = ph; p.ph_hi = ph + 1; hipLaunchKernelGGL(mega, dim3(grid), dim3(512), LDS_BYTES, stream, p); }
#else
    p.ph_lo = 0; p.ph_hi = NPHASE;
    if (hipMemsetAsync((char*)d_ws + WS_BAR, 0, (size_t)XCD_BAR_WORDS * 4, stream) != hipSuccess) { fprintf(stderr, "kernel_launch: memset failed\n"); return; }
    void* args[] = {&p};
    hipError_t e = hipLaunchCooperativeKernel((const void*)mega, dim3(grid), dim3(512), args, LDS_BYTES, stream);
    if (e != hipSuccess) fprintf(stderr, "cooperative launch failed: %s (grid %d)\n", hipGetErrorString(e), grid);
#endif
}
```

```cpp
#include <hip/hip_runtime.h>
#include <hip/hip_cooperative_groups.h>
#include <cstdio>
#include <cstdint>
namespace cg = cooperative_groups;
#define ATT_V4 1
namespace pg8 {
#define PG8_LAS __attribute__((address_space(3)))
typedef unsigned short bf16_t;
typedef short bf16x8 __attribute__((ext_vector_type(8)));
typedef float f32x4 __attribute__((ext_vector_type(4)));
typedef unsigned u32x4 __attribute__((ext_vector_type(4)));
constexpr int BM = 256, BK = 64, HALF = 128, HTB = HALF * BK * 2  , STAGE_BYTES = 8 * HTB, NXCD = 8, WGM = 8;

__host__ __device__ __forceinline__ int lds_byte(int r, int c) { const int st = (r >> 4) * 2 + (c >> 5), rr = r & 15, cc = c & 31, ob = rr * 64 + cc * 2; return st * 1024 + (ob ^ (((ob >> 9) & 1) << 5)); }
__host__ __device__ __forceinline__ void stage_rc(int b, int& R, int& C) { const int st = b / 1024, sb = b % 1024, swz = sb ^ (((sb >> 9) & 1) << 5); R = (st >> 1) * 16 + swz / 64; C = (st & 1) * 32 + (swz % 64) / 2; }
__host__ __device__ __forceinline__ int perm32(int rho) { const int n = rho >> 4, i = rho & 15; return 8 * (i >> 2) + 4 * n + (i & 3); }

struct Unit { int pm, pn, ko; };
struct Gemm { const bf16_t* A; const bf16_t* Bt; int M, N, K, ld; };

struct StaticOrder {
    int nM, nN, nwg, G, c, dsh;
    __host__ __device__ void init(int M, int N, int G_, int c_) { nM = M / BM; nN = N / BM; nwg = nM * nN; G = G_; c = c_; dsh = 0; }
    __host__ __device__ bool next(int i, Unit& u) const {
        const long L = (long)(i >> dsh) * G + c; if (L >= nwg) return false;
        int wgid = (int)L; { const int q = nwg / NXCD, r = nwg % NXCD, xcd = wgid % NXCD, off = wgid / NXCD; wgid = (xcd < r ? xcd * (q + 1) : r * (q + 1) + (xcd - r) * q) + off; }
        const int nig = WGM * nN, gid = wgid / nig, fm = gid * WGM, gsz = (nM - fm) < WGM ? (nM - fm) : WGM;
        u.pm = fm + ((wgid % nig) % gsz); u.pn = (wgid % nig) / gsz; u.ko = 0; return true;
    }
    __device__ __forceinline__ void a_ready(const Unit&) const {}
    __device__ __forceinline__ void done(const Unit&) const {}
};
__device__ __forceinline__ unsigned cvt_pk_bf16(float lo, float hi) { unsigned r; asm volatile("v_cvt_pk_bf16_f32 %0, %1, %2" : "=v"(r) : "v"(lo), "v"(hi)); return r; }
typedef float f32x2 __attribute__((ext_vector_type(2)));
template <class Epi, class Sched, bool STAMP = false>
__device__ __forceinline__ void gemm_phase(PG8_LAS unsigned char* lds, const Gemm g, const Sched& S, const Epi& E, unsigned long long* stamps) {
    const int tid = threadIdx.x, wid = __builtin_amdgcn_readfirstlane(tid >> 6), lane = tid & 63, wr = wid >> 2, wc = wid & 3, fr = lane & 15, fq = lane >> 4;
    const int K = g.K, nt = K / BK;
    int ts_lo = 0, ts_hi = 0, nts = 0; const unsigned long long rt_entry = STAMP ? (unsigned long long)wall_clock64() : 0ull;
#define PG8_STAMP() do { if (STAMP && wid == 0 && nts < 64) { const unsigned long long _c = (unsigned long long)clock64(); \
        ts_lo = (lane == nts) ? (int)(unsigned)_c : ts_lo; ts_hi = (lane == nts) ? (int)(unsigned)(_c >> 32) : ts_hi; ++nts; } } while (0)
    PG8_STAMP();
    unsigned voffA[2], voffB[2];
#pragma unroll
    for (int i = 0; i < 2; ++i) { int R, C; stage_rc(tid * 16 + i * 8192, R, C); const int Rb = Epi::PERM ? ((R & ~31) + perm32(R & 31)) : R;
        voffA[i] = (unsigned)(R * g.ld + C) * 2u; voffB[i] = (unsigned)(Rb * g.ld + C) * 2u; }
    const size_t kstep = (size_t)(BK * 2);
    const size_t hstep = (size_t)HALF * g.ld * 2;
    const size_t tstep = 2 * hstep;
    const unsigned ldsw = (unsigned)wid * 1024u;
    const int aoff = lds_byte(wr * 64 + fr, fq * 8), boff = lds_byte(wc * 32 + fr, fq * 8);
#define PG8_SA(b, h) (((b) * 2 + (h)) * HTB)
#define PG8_SB(b, h) ((4 + (b) * 2 + (h)) * HTB)
#define PG8_STAGE(bufoff, gbase, voff) do { _Pragma("unroll") for (int _i = 0; _i < 2; ++_i) \
        __builtin_amdgcn_global_load_lds((const unsigned*)((const char*)(gbase) + (voff)[_i]), (PG8_LAS unsigned*)(lds + (bufoff) + ldsw + _i * 8192), 16, 0, 0); } while (0)
#define PG8_LDA(dst, b, h) do { _Pragma("unroll") for (int m = 0; m < 4; ++m) _Pragma("unroll") for (int k = 0; k < 2; ++k) dst[m][k] = *(const PG8_LAS bf16x8*)(lds + PG8_SA(b, h) + aoff + m * 2048 + k * 1024); } while (0)
#define PG8_LDB(dst, b, h) do { _Pragma("unroll") for (int n = 0; n < 2; ++n) _Pragma("unroll") for (int k = 0; k < 2; ++k) dst[n][k] = *(const PG8_LAS bf16x8*)(lds + PG8_SB(b, h) + boff + n * 2048 + k * 1024); } while (0)
#define PG8_MMA(ai, bj, At, Bt) do { __builtin_amdgcn_s_setprio(1); _Pragma("unroll") for (int m = 0; m < 4; ++m) _Pragma("unroll") for (int n = 0; n < 2; ++n) _Pragma("unroll") for (int k = 0; k < 2; ++k) \
        acc[ai][bj][m][n] = __builtin_amdgcn_mfma_f32_16x16x32_bf16(Bt[n][k], At[m][k], acc[ai][bj][m][n], 0, 0, 0); __builtin_amdgcn_s_setprio(0); } while (0)
#define PG8_WAIT_V(n) asm volatile("s_waitcnt vmcnt(" #n ")" ::: "memory")
#define PG8_WAIT_L(n) asm volatile("s_waitcnt lgkmcnt(" #n ")" ::: "memory")
#define PG8_BAR __builtin_amdgcn_s_barrier()
#define PG8_SCHED __builtin_amdgcn_sched_barrier(0)
    Unit cur, nxt; int ui = 0;
    if (!S.next(0, cur)) return;
    f32x4 acc[2][2][4][2];
#pragma unroll
    for (int a = 0; a < 2; ++a)
#pragma unroll
        for (int b = 0; b < 2; ++b)
#pragma unroll
            for (int m = 0; m < 4; ++m)
#pragma unroll
                for (int n = 0; n < 2; ++n) acc[a][b][m][n] = (f32x4){0.f, 0.f, 0.f, 0.f};
    bf16x8 At[4][2], B0[2][2], B1[2][2];
    const char* cA = (const char*)g.A + (size_t)cur.pm * tstep + cur.ko; const char* cB = (const char*)g.Bt + (size_t)cur.pn * tstep + cur.ko;
    S.a_ready(cur);
    PG8_STAGE(PG8_SB(0, 0), cB, voffB); PG8_STAGE(PG8_SA(0, 0), cA, voffA); PG8_STAGE(PG8_SB(0, 1), cB + hstep, voffB); PG8_STAGE(PG8_SA(0, 1), cA + hstep, voffA);
    if (wr == 1) PG8_BAR;
    PG8_WAIT_V(4); PG8_BAR;
    PG8_STAGE(PG8_SB(1, 0), cB + kstep, voffB); PG8_STAGE(PG8_SA(1, 0), cA + kstep, voffA); PG8_STAGE(PG8_SB(1, 1), cB + hstep + kstep, voffB);
    PG8_WAIT_V(6); PG8_BAR;
    PG8_STAMP();
    for (;;) {
        const bool has_next = S.next(ui + 1, nxt);
        const char* nA = has_next ? (const char*)g.A + (size_t)nxt.pm * tstep + nxt.ko : cA; const char* nB = has_next ? (const char*)g.Bt + (size_t)nxt.pn * tstep + nxt.ko : cB;
        for (int t = 0; t < nt; t += 2) {
            const bool last = (t == nt - 2);
            const char* a1 = cA + (size_t)(t + 1) * kstep;
            const char* a2 = last ? nA : cA + (size_t)(t + 2) * kstep; const char* b2 = last ? nB : cB + (size_t)(t + 2) * kstep;
            const char* a3 = a2 + kstep; const char* b3 = b2 + kstep;
            if (last && has_next) S.a_ready(nxt);
            PG8_LDB(B0, 0, 0); PG8_SCHED; PG8_LDA(At, 0, 0); PG8_STAGE(PG8_SA(1, 1), a1 + hstep, voffA);
            PG8_WAIT_L(8); PG8_BAR; PG8_WAIT_L(0); PG8_MMA(0, 0, At, B0); PG8_BAR; PG8_SCHED;
            PG8_LDB(B1, 0, 1); PG8_STAGE(PG8_SB(0, 0), b2, voffB);
            PG8_BAR; PG8_WAIT_L(0); PG8_MMA(0, 1, At, B1); PG8_BAR;
            PG8_LDA(At, 0, 1); PG8_STAGE(PG8_SA(0, 0), a2, voffA);
            PG8_BAR; PG8_WAIT_L(0); PG8_MMA(1, 0, At, B0); PG8_BAR; PG8_SCHED;
            PG8_STAGE(PG8_SB(0, 1), b2 + hstep, voffB);
            PG8_WAIT_V(6); PG8_BAR; PG8_MMA(1, 1, At, B1); PG8_BAR;
            PG8_LDB(B0, 1, 0); PG8_SCHED; PG8_LDA(At, 1, 0); PG8_STAGE(PG8_SA(0, 1), a2 + hstep, voffA);
            PG8_WAIT_L(8); PG8_BAR; PG8_WAIT_L(0); PG8_MMA(0, 0, At, B0); PG8_BAR; PG8_SCHED;
            PG8_LDB(B1, 1, 1); PG8_STAGE(PG8_SB(1, 0), b3, voffB);
            PG8_BAR; PG8_WAIT_L(0); PG8_MMA(0, 1, At, B1); PG8_BAR;
            PG8_LDA(At, 1, 1); PG8_STAGE(PG8_SA(1, 0), a3, voffA);
            PG8_BAR; PG8_WAIT_L(0); PG8_MMA(1, 0, At, B0); PG8_BAR; PG8_SCHED;
            PG8_STAGE(PG8_SB(1, 1), b3 + hstep, voffB);
            PG8_WAIT_V(6); PG8_BAR; PG8_MMA(1, 1, At, B1); PG8_BAR;
        }
        PG8_STAMP();
        if constexpr (!Epi::AFTER_DRAIN) { E(acc, cur, wr, wc, fr, fq); S.done(cur); }
        PG8_STAMP();
        if (!has_next) break;
#pragma unroll
        for (int a = 0; a < 2; ++a)
#pragma unroll
            for (int b = 0; b < 2; ++b)
#pragma unroll
                for (int m = 0; m < 4; ++m)
#pragma unroll
                    for (int n = 0; n < 2; ++n) acc[a][b][m][n] = (f32x4){0.f, 0.f, 0.f, 0.f};
        cur = nxt; cA = nA; cB = nB; ++ui;
    }
    PG8_WAIT_V(0);
    if (wr == 0) PG8_BAR;
    PG8_BAR;
    if constexpr (Epi::AFTER_DRAIN) { E.fused(acc, cur, wr, wc, fr, fq, lds, wid, lane); S.done(cur); }
    PG8_STAMP();
    if (STAMP && wid == 0) { stamps[lane] = lane < nts ? (((unsigned long long)(unsigned)ts_hi << 32) | (unsigned)ts_lo) : 0ull;
        if (lane == 62) stamps[62] = rt_entry; if (lane == 63) stamps[63] = (unsigned long long)wall_clock64(); }
#undef PG8_STAMP
#undef PG8_SA
#undef PG8_SB
#undef PG8_STAGE
#undef PG8_LDA
#undef PG8_LDB
#undef PG8_MMA
#undef PG8_WAIT_V
#undef PG8_WAIT_L
#undef PG8_BAR
#undef PG8_SCHED
}
}
#define XB_LAS __attribute__((address_space(3)))

#define XB_TMO      128
#define XB_XCNT(j)  (256  + 64 * (j))
#define XB_XSUB(j)  (1280 + 64 * (j))
#define XB_XGEN(j)  (2304 + 64 * (j))
#define XB_TOP      3328
#define XB_TOPGEN   3392
#define XCD_BAR_WORDS 3456
#define XB_SPIN_CAP (1u << 18)

__device__ __forceinline__ unsigned xb_ld(unsigned* p)              { return __hip_atomic_load(p, __ATOMIC_RELAXED, __HIP_MEMORY_SCOPE_AGENT); }
__device__ __forceinline__ unsigned xb_add(unsigned* p, unsigned v) { return __hip_atomic_fetch_add(p, v, __ATOMIC_RELAXED, __HIP_MEMORY_SCOPE_AGENT); }
__device__ __forceinline__ unsigned xb_xcc_id() { return (unsigned)__builtin_amdgcn_s_getreg((3 << 11) | 20) & 0xFu; }
#define XB_SPIN(cond, bar) do { unsigned _sp = 0; while (cond) { __builtin_amdgcn_s_sleep(1); \
    if ((++_sp & 255u) == 0u) { if (xb_ld(&(bar)[XB_TMO])) break; if (_sp > XB_SPIN_CAP) { atomicAdd(&(bar)[XB_TMO], 1u); break; } } } } while (0)

struct XcdBarrier {
    unsigned* bar; unsigned x;
    volatile XB_LAS unsigned* st;
};

__device__ __forceinline__ XcdBarrier xcd_barrier_post(unsigned* bar, volatile XB_LAS unsigned* st) {
    XcdBarrier b; b.bar = bar; b.x = xb_xcc_id(); b.st = st;
    if (threadIdx.x == 0) (void)xb_add(&bar[XB_XCNT(b.x)], 1u);
    return b;
}
__device__ __forceinline__ void xcd_barrier_complete(unsigned* bar, unsigned x, unsigned& nloc, unsigned& nx) {
    const unsigned G = gridDim.x * gridDim.y * gridDim.z;
    unsigned sum, cnt, mine, sp = 0u;
    for (;;) {
        sum = 0u; cnt = 0u; mine = 0u;
#pragma unroll
        for (unsigned j = 0; j < 16; ++j) { const unsigned c = xb_ld(&bar[XB_XCNT(j)]); sum += c; cnt += (c > 0u) ? 1u : 0u; mine = (j == x) ? c : mine; }
        if (sum == G) break;
        __builtin_amdgcn_s_sleep(1);
        if ((++sp & 255u) == 0u) { if (xb_ld(&bar[XB_TMO])) break; if (sp > XB_SPIN_CAP) { atomicAdd(&bar[XB_TMO], 1u); break; } }
    }
    nloc = mine > 0u ? mine : 1u; nx = cnt > 0u ? cnt : 1u;
}

__device__ __forceinline__ void xcd_barrier(const XcdBarrier& b) {
    asm volatile("s_waitcnt vmcnt(0)" ::: "memory");
    __syncthreads();
    if (threadIdx.x == 0) {
        unsigned* bar = b.bar;
        __builtin_amdgcn_s_waitcnt(0);
        unsigned nloc = b.st[0], nx = b.st[1];
        if (nloc == 0u) { xcd_barrier_complete(bar, b.x, nloc, nx); b.st[0] = nloc; b.st[1] = nx; }
        const unsigned old = xb_add(&bar[XB_XSUB(b.x)], 1u);
        const unsigned gen = old / nloc;
        if (old + 1u == (gen + 1u) * nloc) {
            __builtin_amdgcn_fence(__ATOMIC_RELEASE, "agent");
            asm volatile("s_waitcnt vmcnt(0)" ::: "memory");
            const unsigned og = xb_add(&bar[XB_TOP], 1u);
            const unsigned tg = og / nx;
            if (og + 1u == (tg + 1u) * nx) xb_add(&bar[XB_TOPGEN], 1u);
            else XB_SPIN(xb_ld(&bar[XB_TOPGEN]) == tg, bar);
            __builtin_amdgcn_fence(__ATOMIC_ACQUIRE, "agent");
            xb_add(&bar[XB_XGEN(b.x)], 1u);
            asm volatile("s_waitcnt vmcnt(0)" ::: "memory");
        } else {
            XB_SPIN(xb_ld(&bar[XB_XGEN(b.x)]) == gen, bar);
            __builtin_amdgcn_fence(__ATOMIC_ACQUIRE, "agent");
            asm volatile("s_waitcnt vmcnt(0)" ::: "memory");
        }
    }
    __syncthreads();
}


using pg8::f32x4; using pg8::bf16x8; using pg8::u32x4; using pg8::Unit;
typedef unsigned short u16;
#define LAS PG8_LAS
constexpr int DM = 1024, SEQ = 16384, CTXL = 256, NLAT = 2 * SEQ, NCTX = 2 * CTXL, MROWS = NLAT + NCTX;
constexpr int FF = 2816, DIN = 3072, NKEY = SEQ + CTXL, NADA = 9 * DM;
constexpr int LDS_MAIN = 150528;
constexpr int LDS_BYTES = LDS_MAIN + 16;
#ifndef MULTI_LAUNCH
#define MULTI_LAUNCH 0
#endif
constexpr int NPHASE = 14;

constexpr size_t al256(size_t x) { return (x + 255) / 256 * 256; }
constexpr size_t WS_WB0 = 0;
constexpr size_t WS_WD0 = WS_WB0 + al256((size_t)2 * FF * DM * 2);
constexpr size_t WS_WB1 = WS_WD0 + al256((size_t)DM * FF * 2);
constexpr size_t WS_WD1 = WS_WB1 + al256((size_t)2 * FF * DM * 2);
constexpr size_t WS_WIN = WS_WD1 + al256((size_t)DM * FF * 2);
constexpr size_t WS_WOUT = WS_WIN + al256((size_t)DIN * DM * 2);
constexpr size_t WS_MOD = WS_WOUT + al256((size_t)DM * DM * 2);
constexpr size_t WS_ROPE = WS_MOD + al256((size_t)3 * NADA * 4);
constexpr size_t WS_TW = WS_ROPE + al256((size_t)256 * 16 * 8);
constexpr size_t WS_OM = WS_TW + al256((size_t)4096 * 8);
constexpr size_t WS_H3 = WS_OM + al256((size_t)SEQ * 8);
constexpr size_t WS_HFILT = WS_H3 + al256((size_t)SEQ * 64 * 4);
constexpr size_t WS_HCTX = WS_HFILT + al256((size_t)1024 * SEQ * 2);
constexpr size_t WS_U = WS_HCTX + al256((size_t)NCTX * DM * 4);
constexpr size_t WS_R2 = WS_U + al256((size_t)MROWS * DM * 2);
constexpr size_t R2_Z = 0, R2_Q = R2_Z + (size_t)NLAT * 1536 * 2, R2_K = R2_Q + (size_t)NLAT * 512 * 2, R2_V = R2_K + (size_t)2 * NKEY * 512 * 2, R2_END = R2_V + (size_t)2 * NKEY * 512 * 2;
constexpr size_t R2_SIZE = R2_END > (size_t)MROWS * FF * 2 ? R2_END : (size_t)MROWS * FF * 2;
constexpr size_t WS_W = WS_R2 + al256(R2_SIZE);
constexpr size_t WS_SCR = WS_W + al256((size_t)512 * 2 * SEQ * 4);
constexpr size_t WS_BAR = WS_SCR + (size_t)256 * 262144;
constexpr size_t WS_KN2 = WS_BAR + al256((size_t)XCD_BAR_WORDS * 4);
constexpr size_t WS_END = WS_KN2 + 256;

struct Params {
    const float *x, *c, *ctx, *c_ctx, *ada_w, *ada_b, *norm_g, *w_gate, *w_up, *w_down, *w_in, *w_out, *conv_w, *conv_b, *f_w1, *f_b1, *f_wi, *f_bi, *f_freq, *f_wout, *hy_bias, *lam, *subln_g, *final_g;
    float* out; unsigned char* ws; int ph_lo, ph_hi;
};

__device__ __forceinline__ float bf2f(u16 b) { return __uint_as_float(((unsigned)b) << 16); }
__device__ __forceinline__ u16 f2bf(float f) { unsigned u = __float_as_uint(f); u += 0x7FFFu + ((u >> 16) & 1u); return (u16)(u >> 16); }
__device__ __forceinline__ unsigned pk2(float lo, float hi) { return pg8::cvt_pk_bf16(lo, hi); }
__device__ __forceinline__ float2 cmul(float2 a, float2 b) { return make_float2(a.x * b.x - a.y * b.y, a.x * b.y + a.y * b.x); }
__device__ __forceinline__ float silu_f(float v) { return v * __builtin_amdgcn_rcpf(1.0f + __builtin_amdgcn_exp2f(-1.4426950408889634f * v)); }

__device__ __forceinline__ void transpose_tile(const float* __restrict__ src, u16* __restrict__ dst, int K, int N, int mode, int tile, float* ldsf, int tid) {
    const int ntn = N >> 6, tk = tile / ntn, tn = tile - tk * ntn, k0 = tk * 64, n0 = tn * 64;
#pragma unroll
    for (int i = 0; i < 8; ++i) { const int k = (tid >> 6) + 8 * i, n = tid & 63; ldsf[k * 65 + n] = src[(size_t)(k0 + k) * N + n0 + n]; }
    __syncthreads();
    const int nl = tid >> 3, ks = (tid & 7) * 8;
    float v[8];
#pragma unroll
    for (int j = 0; j < 8; ++j) v[j] = ldsf[(ks + j) * 65 + nl];
    const int nn = n0 + nl;
    const int row = mode == 0 ? nn : ((nn >> 7) * 256 + (nn & 127) + (mode == 2 ? 128 : 0));
    u32x4 w; w.x = pk2(v[0], v[1]); w.y = pk2(v[2], v[3]); w.z = pk2(v[4], v[5]); w.w = pk2(v[6], v[7]);
    *(u32x4*)(dst + (size_t)row * K + k0 + ks) = w;
    __syncthreads();
}

__device__ __forceinline__ void mod_item(const Params& p, int item, float* ldsf, int tid_) {
    int tid = tid_; asm volatile("" : "+v"(tid));
    const int wave = __builtin_amdgcn_readfirstlane(tid >> 6), lane = tid & 63, col = item * 64 + lane;
    float s0[2], s1[2], s2[2];
#pragma unroll
    for (int h = 0; h < 2; ++h) { const int kk = wave * 128 + h * 64 + lane; s0[h] = silu_f(p.c[kk]); s1[h] = silu_f(p.c[DM + kk]); s2[h] = silu_f(p.c_ctx[kk]); }
    float a0 = 0.f, a1 = 0.f, a2 = 0.f;
    const float* aw = p.ada_w + (size_t)(wave * 128) * NADA + col;
#pragma unroll
    for (int h = 0; h < 2; ++h)
#pragma unroll 16
        for (int k = 0; k < 64; ++k) {
            const float w = aw[(size_t)(h * 64 + k) * NADA];
            a0 += __builtin_bit_cast(float, __builtin_amdgcn_readlane(__builtin_bit_cast(int, s0[h]), k)) * w;
            a1 += __builtin_bit_cast(float, __builtin_amdgcn_readlane(__builtin_bit_cast(int, s1[h]), k)) * w;
            a2 += __builtin_bit_cast(float, __builtin_amdgcn_readlane(__builtin_bit_cast(int, s2[h]), k)) * w;
        }
    ldsf[(wave * 3 + 0) * 64 + lane] = a0; ldsf[(wave * 3 + 1) * 64 + lane] = a1; ldsf[(wave * 3 + 2) * 64 + lane] = a2;
    __syncthreads();
    if (tid < 192) { const int v = tid >> 6; float s = p.ada_b[col];
#pragma unroll
        for (int w = 0; w < 8; ++w) s += ldsf[(w * 3 + v) * 64 + lane];
        ((float*)(p.ws + WS_MOD))[v * NADA + col] = s; }
    __syncthreads();
}

__device__ __forceinline__ void filt_block(const Params& p, int blk, float* ldsf, int tid_) {
    int tid = tid_; asm volatile("" : "+v"(tid));
    const int wave = tid >> 6, lane = tid & 63, n0 = (blk * 8 + wave) * 8;
    float* hb = ldsf + wave * 512;
#pragma unroll 1
    for (int q = 0; q < 8; ++q) { const int n = n0 + q;
        const float t = (float)n / (float)(SEQ - 1);
        const float omega = (2.0f * 3.14159265358979323846f / (float)SEQ) * (float)n;
        if (lane == 0) hb[q * 64] = t;
        if (lane < 32) { const int k = lane & 15; const float band = 1e-4f + (15.0f - 1e-4f) * (float)k / 15.0f; const float ang = omega * band;
            hb[q * 64 + 1 + lane] = lane < 16 ? cosf(ang) : -sinf(ang); } }
    __syncthreads();
    const float fr = p.f_freq[lane];
    float acc[8], h[8];
#pragma unroll
    for (int q = 0; q < 8; ++q) acc[q] = p.f_b1[lane];
    for (int i = 0; i < 33; ++i) { const float w = p.f_w1[i * 64 + lane];
#pragma unroll
        for (int q = 0; q < 8; ++q) acc[q] += hb[q * 64 + i] * w; }
#pragma unroll
    for (int q = 0; q < 8; ++q) h[q] = __sinf(fr * acc[q]);
    __syncthreads();
    for (int l = 0; l < 2; ++l) {
#pragma unroll
        for (int q = 0; q < 8; ++q) hb[q * 64 + lane] = h[q];
        __syncthreads();
        const float* wi = p.f_wi + l * 4096;
#pragma unroll
        for (int q = 0; q < 8; ++q) acc[q] = p.f_bi[l * 64 + lane];
#pragma unroll 4
        for (int i = 0; i < 64; ++i) { const float w = wi[i * 64 + lane];
#pragma unroll
            for (int q = 0; q < 8; ++q) acc[q] += hb[q * 64 + i] * w; }
#pragma unroll
        for (int q = 0; q < 8; ++q) h[q] = __sinf(fr * acc[q]);
        __syncthreads();
    }
#pragma unroll
    for (int q = 0; q < 8; ++q) ((float*)(p.ws + WS_H3))[(n0 + q) * 64 + lane] = h[q];
}

__device__ __forceinline__ void tr_decode(const Params& p, int t, const float*& src, u16*& dst, int& K, int& N, int& mode, int& k0, int& n0) {
    if (t < 2816) { const int mm = t / 704; t -= mm * 704; const int layer = mm >> 1; K = DM; N = FF; mode = 1 + (mm & 1);
        src = ((mm & 1) ? p.w_up : p.w_gate) + (size_t)layer * DM * FF; dst = (u16*)(p.ws + (layer ? WS_WB1 : WS_WB0)); }
    else if (t < 4224) { t -= 2816; const int layer = t / 704; t -= layer * 704; K = FF; N = DM; mode = 0; src = p.w_down + (size_t)layer * FF * DM; dst = (u16*)(p.ws + (layer ? WS_WD1 : WS_WD0)); }
    else if (t < 4992) { t -= 4224; K = DM; N = DIN; mode = 0; src = p.w_in; dst = (u16*)(p.ws + WS_WIN); }
    else { t -= 4992; K = DM; N = DM; mode = 0; src = p.w_out; dst = (u16*)(p.ws + WS_WOUT); }
    const int ntn = N >> 6, tk = t / ntn, tn = t - tk * ntn; k0 = tk * 64; n0 = tn * 64;
}
__device__ __forceinline__ void transpose_all(const Params& p, float* ldsf, int tid_, int G, int bx) {
    int tid = tid_; asm volatile("" : "+v"(tid));
    constexpr int NTILE = 5248, BUF = 64 * 65;
    float va[8], vb[8];
#define TR_LOAD(v, t_) do { const float* s_; u16* d_; int K_, N_, m_, k0_, n0_; tr_decode(p, (t_), s_, d_, K_, N_, m_, k0_, n0_);               \
        _Pragma("unroll") for (int i = 0; i < 8; ++i) v[i] = s_[(size_t)(k0_ + (tid >> 6) + 8 * i) * N_ + n0_ + (tid & 63)]; } while (0)
#define TR_EMIT(v, t_, buf_) do { float* lb_ = ldsf + (buf_) * BUF;                                                                            \
        _Pragma("unroll") for (int i = 0; i < 8; ++i) lb_[((tid >> 6) + 8 * i) * 65 + (tid & 63)] = v[i];                                      \
        __syncthreads();                                                                                                                        \
        if ((t_) + 2 * G < NTILE) TR_LOAD(v, (t_) + 2 * G);                                                                                     \
        { const float* s_; u16* d_; int K_, N_, m_, k0_, n0_; tr_decode(p, (t_), s_, d_, K_, N_, m_, k0_, n0_);                                 \
          const int nl = tid >> 3, ks = (tid & 7) * 8; float w_[8];                                                                             \
          _Pragma("unroll") for (int j = 0; j < 8; ++j) w_[j] = lb_[(ks + j) * 65 + nl];                                                        \
          const int nn = n0_ + nl; const int row = m_ == 0 ? nn : ((nn >> 7) * 256 + (nn & 127) + (m_ == 2 ? 128 : 0));                         \
          u32x4 o_; o_.x = pk2(w_[0], w_[1]); o_.y = pk2(w_[2], w_[3]); o_.z = pk2(w_[4], w_[5]); o_.w = pk2(w_[6], w_[7]);                      \
          *(u32x4*)(d_ + (size_t)row * K_ + k0_ + ks) = o_; } } while (0)
    int t = bx;
    if (t < NTILE) TR_LOAD(va, t);
    if (t + G < NTILE) TR_LOAD(vb, t + G);
    for (; t < NTILE; t += 2 * G) {
        TR_EMIT(va, t, 0);
        if (t + G < NTILE) TR_EMIT(vb, t + G, 1);
    }
    __syncthreads();
#undef TR_LOAD
#undef TR_EMIT
}
__device__ __forceinline__ void phase_prep(const Params& p, float* ldsf, int tid, int G, int bx) {
    if (bx == 0 && tid < 16) ((float*)(p.ws + WS_KN2))[tid] = 0.f;
    for (int it = bx; it < 144; it += G) mod_item(p, it, ldsf, tid);
    for (int it = bx; it < 256; it += G) filt_block(p, (it + 144) % 256, ldsf, tid);
    for (int it = bx; it < 8; it += G) { const int idx = it * 512 + tid, pos = idx >> 4, f = idx & 15;
        const float invf = powf(10000.0f, -(float)(2 * f) / 32.0f); float s, c; sincosf((float)pos * invf, &s, &c);
        ((float2*)(p.ws + WS_ROPE))[idx] = make_float2(c, s); }
    for (int it = bx; it < 40; it += G) {
        if (it < 8) { const int n = it * 512 + tid; float s, c; sincospif((float)n / 8192.0f, &s, &c); ((float2*)(p.ws + WS_TW))[n] = make_float2(c, -s); }
        else { const int n = (it - 8) * 512 + tid; float s, c; sincospif((float)n * (1.0f / SEQ), &s, &c); ((float2*)(p.ws + WS_OM))[n] = make_float2(c, -s); } }
    __syncthreads();
    transpose_all(p, ldsf, tid, G, bx);
}

__device__ __forceinline__ void adaln_rows(const Params& p, const float* lat, const float* ctxp, int rbeg, int nrows, int gi, int kshift, int kscale, u16* U, float* copy_ctx, int tid, int G, int bx) {
    const int wave = tid >> 6, lane = tid & 63;
    const float* g = p.norm_g + gi * DM; const float* mod = (const float*)(p.ws + WS_MOD);
    const int stride = G * 8;
    for (int r0 = rbeg + bx * 8 + wave; r0 < nrows; r0 += 4 * stride) {
        f32x4 v[4][4]; float ss[4] = {0.f, 0.f, 0.f, 0.f};
#pragma unroll
        for (int q = 0; q < 4; ++q) { const int r = r0 + q * stride; const int rr = r < nrows ? r : r0;
            const float* src = rr < NLAT ? lat + (size_t)rr * DM : ctxp + (size_t)(rr - NLAT) * DM;
#pragma unroll
            for (int i = 0; i < 4; ++i) v[q][i] = *(const f32x4*)(src + i * 256 + lane * 4); }
#pragma unroll
        for (int q = 0; q < 4; ++q) {
#pragma unroll
            for (int i = 0; i < 4; ++i) ss[q] += v[q][i][0] * v[q][i][0] + v[q][i][1] * v[q][i][1] + v[q][i][2] * v[q][i][2] + v[q][i][3] * v[q][i][3];
#pragma unroll
            for (int o = 32; o >= 1; o >>= 1) ss[q] += __shfl_xor(ss[q], o); }
#pragma unroll
        for (int q = 0; q < 4; ++q) { const int r = r0 + q * stride; if (r >= nrows) break;
            const int sel = r < NLAT ? (r >> 14) : 2;
            const float rs = rsqrtf(ss[q] * (1.0f / DM) + 1e-6f);
            const float* sh = mod + sel * NADA + kshift * DM; const float* sc = mod + sel * NADA + kscale * DM;
#pragma unroll
            for (int i = 0; i < 4; ++i) { const int c = i * 256 + lane * 4;
                const f32x4 gg = *(const f32x4*)(g + c), s4 = *(const f32x4*)(sh + c), c4 = *(const f32x4*)(sc + c);
                f32x4 y = v[q][i] * rs * gg * (c4 + 1.0f) + s4;
                uint2 w; w.x = pk2(y[0], y[1]); w.y = pk2(y[2], y[3]);
                *(uint2*)(U + (size_t)r * DM + c) = w;
                if (copy_ctx && r >= NLAT) *(f32x4*)(copy_ctx + (size_t)(r - NLAT) * DM + c) = v[q][i]; } }
    }
}
__device__ __forceinline__ void final_norm(const Params& p, int tid, int G, int bx) {
    const int wave = tid >> 6, lane = tid & 63, stride = G * 8;
    for (int r0 = bx * 8 + wave; r0 < NLAT; r0 += 4 * stride) {
        f32x4 v[4][4]; float ss[4] = {0.f, 0.f, 0.f, 0.f};
#pragma unroll
        for (int q = 0; q < 4; ++q) { const int r = r0 + q * stride < NLAT ? r0 + q * stride : r0; const float* src = p.out + (size_t)r * DM;
#pragma unroll
            for (int i = 0; i < 4; ++i) v[q][i] = *(const f32x4*)(src + i * 256 + lane * 4); }
#pragma unroll
        for (int q = 0; q < 4; ++q) {
#pragma unroll
            for (int i = 0; i < 4; ++i) ss[q] += v[q][i][0] * v[q][i][0] + v[q][i][1] * v[q][i][1] + v[q][i][2] * v[q][i][2] + v[q][i][3] * v[q][i][3];
#pragma unroll
            for (int o = 32; o >= 1; o >>= 1) ss[q] += __shfl_xor(ss[q], o); }
#pragma unroll
        for (int q = 0; q < 4; ++q) { const int r = r0 + q * stride; if (r >= NLAT) break;
            const float rs = rsqrtf(ss[q] * (1.0f / DM) + 1e-6f); float* dst = p.out + (size_t)r * DM;
#pragma unroll
            for (int i = 0; i < 4; ++i) { const int c = i * 256 + lane * 4; const f32x4 gg = *(const f32x4*)(p.final_g + c); *(f32x4*)(dst + c) = v[q][i] * rs * gg; } }
    }
}

__device__ __forceinline__ void hfilt_items(const Params& p, float* ldsf, int tid, int G, int bx) {
    const float* h3 = (const float*)(p.ws + WS_H3); u16* HF = (u16*)(p.ws + WS_HFILT);
    for (int it = bx; it < 512; it += G) {
        const int nblk = it >> 4, cch = it & 15, n = nblk * 512 + tid;
#pragma unroll
        for (int e = 0; e < 8; ++e) { const int idx = tid + e * 512, i = idx >> 6, cc = idx & 63; ldsf[cc * 64 + i] = p.f_wout[i * 1024 + cch * 64 + cc]; }
        f32x4 h[16];
#pragma unroll
        for (int i = 0; i < 16; ++i) h[i] = *(const f32x4*)(h3 + (size_t)n * 64 + i * 4);
        __syncthreads();
        const float t = (float)n / (float)(SEQ - 1);
        for (int cc = 0; cc < 64; ++cc) {
            float acc = 0.f;
#pragma unroll
            for (int i = 0; i < 16; ++i) { const f32x4 w = *(const f32x4*)(ldsf + cc * 64 + i * 4); acc += h[i][0] * w[0] + h[i][1] * w[1] + h[i][2] * w[2] + h[i][3] * w[3]; }
            const int cp = cch * 64 + cc, c = cp & 511;
            const float mind = -3.0701134573253944f, maxd = -15.350567286626972f;
            const float delta = fabsf(mind + (maxd - mind) * ((float)c / 511.0f));
            HF[(size_t)cp * SEQ + n] = f2bf(acc * __expf(-t * delta));
        }
        __syncthreads();
    }
}

struct EpiSwiGLU {
    static constexpr bool PERM = true, AFTER_DRAIN = false;
    u16* O;
    __device__ __forceinline__ void operator()(const f32x4 (&acc)[2][2][4][2], const Unit& u, int wr, int wc, int fr, int fq) const {
        const int row0 = u.pm * 256 + wr * 64 + fr, j0 = u.pn * 128 + wc * 32 + 8 * fq;
#pragma unroll
        for (int ai = 0; ai < 2; ++ai)
#pragma unroll
            for (int m = 0; m < 4; ++m) {
                const f32x4 g0 = acc[ai][0][m][0], g1 = acc[ai][0][m][1], u0 = acc[ai][1][m][0], u1 = acc[ai][1][m][1];
                float h[8];
#pragma unroll
                for (int j = 0; j < 4; ++j) { h[j] = silu_f(g0[j]) * u0[j]; h[4 + j] = silu_f(g1[j]) * u1[j]; }
                u32x4 w; w.x = pk2(h[0], h[1]); w.y = pk2(h[2], h[3]); w.z = pk2(h[4], h[5]); w.w = pk2(h[6], h[7]);
                *(u32x4*)(O + (size_t)(row0 + ai * 128 + m * 16) * FF + j0) = w;
            }
    }
};
struct EpiResid {
    static constexpr bool PERM = false, AFTER_DRAIN = false;
    const float* src_lat; const float* src_ctx; float* dst_lat; float* dst_ctx; const float* mod; int modk; float coef;
    __device__ __forceinline__ void operator()(const f32x4 (&acc)[2][2][4][2], const Unit& u, int wr, int wc, int fr, int fq) const {
        const bool isctx = u.pm >= 128; const int sel = isctx ? 2 : (u.pm >> 6);
        const size_t rb = (size_t)(isctx ? (u.pm - 128) : u.pm) * 256 * DM;
        const float* src = (isctx ? src_ctx : src_lat) + rb; float* dst = (isctx ? dst_ctx : dst_lat) + rb;
        const float* gv = mod + sel * NADA + modk * DM;
        const int col0 = u.pn * 256 + wc * 32 + 4 * fq, r0 = wr * 64 + fr;
#pragma unroll
        for (int bj = 0; bj < 2; ++bj)
#pragma unroll
            for (int n = 0; n < 2; ++n) {
                const int c = col0 + bj * 128 + n * 16;
                const f32x4 g4 = *(const f32x4*)(gv + c) * coef;
                f32x4 sv[2][4];
#pragma unroll
                for (int ai = 0; ai < 2; ++ai)
#pragma unroll
                    for (int m = 0; m < 4; ++m) sv[ai][m] = *(const f32x4*)(src + (size_t)(r0 + ai * 128 + m * 16) * DM + c);
#pragma unroll
                for (int ai = 0; ai < 2; ++ai)
#pragma unroll
                    for (int m = 0; m < 4; ++m) *(f32x4*)(dst + (size_t)(r0 + ai * 128 + m * 16) * DM + c) = sv[ai][m] + g4 * acc[ai][bj][m][n];
            }
    }
};
struct EpiInProj {
    static constexpr bool PERM = false, AFTER_DRAIN = false;
    u16 *Z, *Q, *K, *V; const float* rope;
    __device__ __forceinline__ void operator()(const f32x4 (&acc)[2][2][4][2], const Unit& u, int wr, int wc, int fr, int fq) const {
        const bool isctx = u.pm >= 128; const int pn = u.pn;
        if (isctx && pn < 8) return;
        const int rl0 = wr * 64 + fr;
        const int cl0 = wc * 32 + 4 * fq;
        if (pn < 6) {
#pragma unroll
            for (int ai = 0; ai < 2; ++ai)
#pragma unroll
                for (int m = 0; m < 4; ++m) { u16* rp = Z + (size_t)(u.pm * 256 + rl0 + ai * 128 + m * 16) * 1536 + pn * 256 + cl0;
#pragma unroll
                    for (int bj = 0; bj < 2; ++bj)
#pragma unroll
                        for (int n = 0; n < 2; ++n) { const f32x4 a = acc[ai][bj][m][n]; uint2 w; w.x = pk2(a[0], a[1]); w.y = pk2(a[2], a[3]); *(uint2*)(rp + bj * 128 + n * 16) = w; } }
            return;
        }
        const bool do_rope = (pn < 10) && !isctx;
        u16* base; size_t rowbase;
        if (pn < 8) { base = Q; rowbase = (size_t)u.pm * 256; }
        else { base = pn < 10 ? K : V; rowbase = isctx ? ((size_t)(u.pm - 128) * NKEY + SEQ) : ((size_t)(u.pm >> 6) * NKEY + (size_t)(u.pm & 63) * 256); }
        const int cbase = (pn & 1) * 256 + cl0;
        const int axis = wc & 1;
#pragma unroll
        for (int ai = 0; ai < 2; ++ai)
#pragma unroll
            for (int m = 0; m < 4; ++m) {
                const int rl = rl0 + ai * 128 + m * 16;
                u16* rp = base + (rowbase + rl) * 512 + cbase;
                f32x4 cs0 = {1.f, 0.f, 1.f, 0.f}, cs1 = {1.f, 0.f, 1.f, 0.f};
                if (do_rope) { const int t = (u.pm & 63) * 256 + rl; const int pos = axis ? (t & 63) : (t >> 6);
                    const float* rp2 = rope + (size_t)(pos * 16 + 4 * fq) * 2; cs0 = *(const f32x4*)rp2; cs1 = *(const f32x4*)(rp2 + 4); }
#pragma unroll
                for (int bj = 0; bj < 2; ++bj) {
                    const f32x4 x1 = acc[ai][bj][m][0], x2 = acc[ai][bj][m][1];
                    f32x4 o1, o2;
                    o1[0] = x1[0] * cs0[0] - x2[0] * cs0[1]; o2[0] = x2[0] * cs0[0] + x1[0] * cs0[1];
                    o1[1] = x1[1] * cs0[2] - x2[1] * cs0[3]; o2[1] = x2[1] * cs0[2] + x1[1] * cs0[3];
                    o1[2] = x1[2] * cs1[0] - x2[2] * cs1[1]; o2[2] = x2[2] * cs1[0] + x1[2] * cs1[1];
                    o1[3] = x1[3] * cs1[2] - x2[3] * cs1[3]; o2[3] = x2[3] * cs1[2] + x1[3] * cs1[3];
                    uint2 w; w.x = pk2(o1[0], o1[1]); w.y = pk2(o1[2], o1[3]); *(uint2*)(rp + bj * 128) = w;
                    w.x = pk2(o2[0], o2[1]); w.y = pk2(o2[2], o2[3]); *(uint2*)(rp + bj * 128 + 16) = w;
                }
            }
    }
};

struct CtxSplitOrder {
    int G, c;
    __device__ __forceinline__ bool next(int i, Unit& u) const { const int L = i * G + c; if (L >= 88) return false; u.pm = 128 + (L & 1); u.pn = (L >> 1) & 3; u.ko = (L >> 3) * 512; return true; }
    __device__ __forceinline__ void a_ready(const Unit&) const {}
    __device__ __forceinline__ void done(const Unit&) const {}
};
struct CtxKvOrder {
    int G, c;
    __device__ __forceinline__ bool next(int i, Unit& u) const { const int L = i * G + c; if (L >= 8) return false; u.pm = 128 + (L & 1); u.pn = 8 + (L >> 1); u.ko = 0; return true; }
    __device__ __forceinline__ void a_ready(const Unit&) const {}
    __device__ __forceinline__ void done(const Unit&) const {}
};
struct EpiCtxAtomic {
    static constexpr bool PERM = false, AFTER_DRAIN = false;
    float* dst_ctx; const float* mod; int modk; float coef;
    __device__ __forceinline__ void operator()(const f32x4 (&acc)[2][2][4][2], const Unit& u, int wr, int wc, int fr, int fq) const {
        float* dst = dst_ctx + (size_t)(u.pm - 128) * 256 * DM; const float* gv = mod + 2 * NADA + modk * DM;
        const int col0 = u.pn * 256 + wc * 32 + 4 * fq, r0 = wr * 64 + fr;
        f32x4 g4[2][2];
#pragma unroll
        for (int bj = 0; bj < 2; ++bj)
#pragma unroll
            for (int n = 0; n < 2; ++n) g4[bj][n] = *(const f32x4*)(gv + col0 + bj * 128 + n * 16) * coef;
#pragma unroll
        for (int ai = 0; ai < 2; ++ai)
#pragma unroll
            for (int m = 0; m < 4; ++m) {
                unsigned ro = (unsigned)((r0 + ai * 128 + m * 16) * DM + col0); asm volatile("" : "+v"(ro));
                float* o = dst + ro;
#pragma unroll
                for (int bj = 0; bj < 2; ++bj)
#pragma unroll
                    for (int n = 0; n < 2; ++n) { const f32x4 v = g4[bj][n] * acc[ai][bj][m][n];
#pragma unroll
                        for (int j = 0; j < 4; ++j) __hip_atomic_fetch_add(o + bj * 128 + n * 16 + j, v[j], __ATOMIC_RELAXED, __HIP_MEMORY_SCOPE_AGENT); } }
    }
};

namespace att {
using bf16x8 = __attribute__((ext_vector_type(8))) short;
using s16x4  = __attribute__((ext_vector_type(4))) short;
using f32x16 = __attribute__((ext_vector_type(16))) float;
constexpr int KVBLK = 64, LDK = 512, LDQ = 512;
constexpr float SCALE = 0.125f, THR = 8.f;
constexpr int SHM_V = KVBLK * 128 * 2, SHM_K = KVBLK * 128 * 2;
#define KSWZ(row, colB) ((row) * 256 + ((colB) ^ (((row) & 7) << 4)))
#define SBAR() __builtin_amdgcn_sched_barrier(0)
template <int M> __device__ __forceinline__ float swz_xor(float v) { return __int_as_float(__builtin_amdgcn_ds_swizzle(__float_as_int(v), 0x1F | (M << 10))); }
__device__ __forceinline__ int crow(int r, int hi) { return (r & 3) + 8 * (r >> 2) + 4 * hi; }
__device__ __forceinline__ unsigned cvtpk(float lo, float hi) { unsigned r; asm volatile("v_cvt_pk_bf16_f32 %0, %1, %2" : "=v"(r) : "v"(lo), "v"(hi)); return r; }
__device__ __forceinline__ void partialSM(f32x16& p0, f32x16& p1, float& m_reg, float& mn, float& alpha) {
  constexpr float C = SCALE * 1.4426950408889634f;
  float pmax = p0[0];
#pragma unroll
  for (int r = 1; r < 16; ++r) pmax = fmaxf(pmax, p0[r]);
#pragma unroll
  for (int r = 0; r < 16; ++r) pmax = fmaxf(pmax, p1[r]);
  { auto rr = __builtin_amdgcn_permlane32_swap(__float_as_uint(pmax), __float_as_uint(pmax), false, false);
    pmax = fmaxf(__uint_as_float(rr[0]), __uint_as_float(rr[1])); }
  if (__builtin_expect(__all(pmax - m_reg <= THR / SCALE), 1)) { mn = m_reg; alpha = 1.f; }
  else { mn = fmaxf(m_reg, pmax); alpha = __builtin_amdgcn_exp2f((m_reg - mn) * C); m_reg = mn; }
  float mnC = -mn * C;
#pragma unroll
  for (int r = 0; r < 16; ++r) p0[r] = fmaf(p0[r], C, mnC);
#pragma unroll
  for (int r = 0; r < 16; ++r) p1[r] = fmaf(p1[r], C, mnC);
#pragma unroll
  for (int r = 0; r < 16; ++r) p0[r] = __builtin_amdgcn_exp2f(p0[r]);
}
__device__ __forceinline__ void finishSM(f32x16& p0, f32x16& p1, float alpha, float& l_reg, bf16x8& pa0, bf16x8& pa1, bf16x8& pa2, bf16x8& pa3) {
#pragma unroll
  for (int r = 0; r < 16; ++r) p1[r] = __builtin_amdgcn_exp2f(p1[r]);
  float ps = 0;
#pragma unroll
  for (int r = 0; r < 16; ++r) ps += p0[r];
#pragma unroll
  for (int r = 0; r < 16; ++r) ps += p1[r];
  { auto rr = __builtin_amdgcn_permlane32_swap(__float_as_uint(ps), __float_as_uint(ps), false, false);
    ps = __uint_as_float(rr[0]) + __uint_as_float(rr[1]); }
  l_reg = l_reg * alpha + ps;
#define PK4(P, BASE, OUT) do { unsigned a0 = cvtpk(P[BASE + 0], P[BASE + 1]), a1 = cvtpk(P[BASE + 2], P[BASE + 3]);   \
    unsigned b0 = cvtpk(P[BASE + 4], P[BASE + 5]), b1 = cvtpk(P[BASE + 6], P[BASE + 7]);                              \
    auto r0 = __builtin_amdgcn_permlane32_swap(a0, b0, false, false); auto r1 = __builtin_amdgcn_permlane32_swap(a1, b1, false, false); \
    u32x4 w = {r0[0], r1[0], r0[1], r1[1]}; OUT = *reinterpret_cast<bf16x8*>(&w); } while (0)
  PK4(p0, 0, pa0); PK4(p0, 8, pa1); PK4(p1, 0, pa2); PK4(p1, 8, pa3);
#undef PK4
}
__device__ __forceinline__ void qkt(f32x16& p0, f32x16& p1, const char* Ks, const bf16x8* qr, int r32, int hi, int s) {
  p0 = f32x16{}; p1 = f32x16{};
#pragma unroll
  for (int d0 = 0; d0 < 4; ++d0) { int cb = (s * 64 + d0 * 16 + hi * 8) * 2;
    bf16x8 b0 = *reinterpret_cast<const bf16x8*>(Ks + KSWZ(r32, cb));
    bf16x8 b1 = *reinterpret_cast<const bf16x8*>(Ks + KSWZ(32 + r32, cb));
    p0 = __builtin_amdgcn_mfma_f32_32x32x16_bf16(b0, qr[d0], p0, 0, 0, 0);
    p1 = __builtin_amdgcn_mfma_f32_32x32x16_bf16(b1, qr[d0], p1, 0, 0, 0); }
}
__device__ __forceinline__ int v_st(int k, int c) { const int kk = (k & ~0xC) | ((k & 4) << 1) | ((k & 8) >> 1); return ((kk >> 3) * 4 + (c >> 5)) * 512 + ((kk & 7) * 32 + (c & 31)) * 2; }
__device__ __forceinline__ int v_rd_base(int lane) { return ((lane & 3) << 3) | (((lane >> 2) & 3) << 6) | (((lane >> 4) & 1) << 5) | (((lane >> 5) & 1) << 8); }
constexpr int v_rd_off(int d0, int ks, int half) { return d0 * 512 + ks * 4096 + half * 2048; }
template <int OFF> __device__ __forceinline__ s16x4 tr_read(int vb) {
  s16x4 r; asm volatile("ds_read_b64_tr_b16 %0, %1 offset:%2" : "=&v"(r) : "v"(vb), "i"(OFF) : "memory"); return r;
}
template <int D0> __device__ __forceinline__ void pv_one(f32x16& od, int vb, bf16x8 pa0, bf16x8 pa1, bf16x8 pa2, bf16x8 pa3) {
  const s16x4 l0 = tr_read<v_rd_off(D0, 0, 0)>(vb), h0 = tr_read<v_rd_off(D0, 0, 1)>(vb), l1 = tr_read<v_rd_off(D0, 1, 0)>(vb), h1 = tr_read<v_rd_off(D0, 1, 1)>(vb);
  const s16x4 l2 = tr_read<v_rd_off(D0, 2, 0)>(vb), h2 = tr_read<v_rd_off(D0, 2, 1)>(vb), l3 = tr_read<v_rd_off(D0, 3, 0)>(vb), h3 = tr_read<v_rd_off(D0, 3, 1)>(vb);
  asm volatile("s_waitcnt lgkmcnt(0)" ::: "memory"); SBAR();
#define PK(L, H) (bf16x8){L[0], L[1], L[2], L[3], H[0], H[1], H[2], H[3]}
  od = __builtin_amdgcn_mfma_f32_32x32x16_bf16(pa0, PK(l0, h0), od, 0, 0, 0);
  od = __builtin_amdgcn_mfma_f32_32x32x16_bf16(pa1, PK(l1, h1), od, 0, 0, 0);
  od = __builtin_amdgcn_mfma_f32_32x32x16_bf16(pa2, PK(l2, h2), od, 0, 0, 0);
  od = __builtin_amdgcn_mfma_f32_32x32x16_bf16(pa3, PK(l3, h3), od, 0, 0, 0);
#undef PK
}
__device__ __forceinline__ void pv_d0(f32x16* o, int vb, bf16x8 pa0, bf16x8 pa1, bf16x8 pa2, bf16x8 pa3) {
  pv_one<0>(o[0], vb, pa0, pa1, pa2, pa3); pv_one<1>(o[1], vb, pa0, pa1, pa2, pa3); pv_one<2>(o[2], vb, pa0, pa1, pa2, pa3); pv_one<3>(o[3], vb, pa0, pa1, pa2, pa3);
}

__device__ __forceinline__ void diff_attn_unit(const u16* __restrict__ Qb, const u16* __restrict__ Kh, const u16* __restrict__ Vh, u16* __restrict__ Yb,
                                               float lam, const float* __restrict__ subg, char* lds) {
  const int tid = threadIdx.x, wid = tid >> 6, lane = tid & 63, r32 = lane & 31, hi = lane >> 5, qb = wid >> 1, s = wid & 1;
  char* V_lds = lds; char* K_lds = lds + 2 * SHM_V;
  float* wsl = (float*)(lds + 2 * SHM_V + 2 * SHM_K) + wid * 64; float* li_l = wsl; float* al_l = wsl + 32;
  float m_reg = -1e30f, l_reg = 0; f32x16 o[4] = {}; bf16x8 qr[4];
  const u16* Qw = Qb + (long)(qb * 32 + r32) * LDQ + s * 64 + hi * 8;
#pragma unroll
  for (int d0 = 0; d0 < 4; ++d0) qr[d0] = *reinterpret_cast<const bf16x8*>(Qw + d0 * 16);
  const int sr = tid >> 4, sc = (tid & 15) * 8, vst0 = v_st(sr, sc), vst1 = v_st(32 + sr, sc);
  const int vb0 = (int)(uintptr_t)V_lds + v_rd_base(lane);
  struct { bf16x8 vs0, vs1, ks0, ks1; } sr_[2];
#define LD8(ptr) (*reinterpret_cast<const bf16x8*>(ptr))
#define SLOAD(i, k0) do { sr_[i].vs0 = LD8(&Vh[(long)((k0) + sr) * LDK + sc]); sr_[i].vs1 = LD8(&Vh[(long)((k0) + 32 + sr) * LDK + sc]); \
    sr_[i].ks0 = LD8(&Kh[(long)((k0) + sr) * LDK + sc]); sr_[i].ks1 = LD8(&Kh[(long)((k0) + 32 + sr) * LDK + sc]); } while (0)
#define SWRITE(b, i) do { *(bf16x8*)(V_lds + (b) * SHM_V + vst0) = sr_[i].vs0;          \
    *(bf16x8*)(V_lds + (b) * SHM_V + vst1) = sr_[i].vs1; int kc = sc * 2;               \
    *(bf16x8*)(K_lds + (b) * SHM_K + KSWZ(sr, kc)) = sr_[i].ks0;                       \
    *(bf16x8*)(K_lds + (b) * SHM_K + KSWZ(32 + sr, kc)) = sr_[i].ks1; } while (0)
#define SWAIT() asm volatile("s_waitcnt vmcnt(4)" ::: "memory")
#define RESC(a) do { if (__any((a) < 1.f)) { if (hi == 0) al_l[r32] = (a); asm volatile("s_waitcnt lgkmcnt(0)" ::: "memory"); \
    _Pragma("unroll") for (int d = 0; d < 4; ++d) _Pragma("unroll") for (int r = 0; r < 16; ++r) o[d][r] *= al_l[crow(r, hi)]; } } while (0)
  f32x16 pA0, pA1, pB0, pB1; float mnA, mnB, alA, alB; bf16x8 pa0, pa1, pa2, pa3; constexpr int NT = NKEY / KVBLK;
  constexpr int SE = 0, SO = 1;
  SLOAD(SE, 0); asm volatile("s_waitcnt vmcnt(0)" ::: "memory"); SWRITE(0, SE); __syncthreads();
  qkt(pA0, pA1, K_lds, qr, r32, hi, s); partialSM(pA0, pA1, m_reg, mnA, alA);
  SLOAD(SO, KVBLK); SLOAD(SE, 2 * KVBLK);
  SWAIT(); SWRITE(1, SO); __syncthreads();
  for (int j = 1; j + 1 < NT; j += 2) {
    SBAR(); qkt(pB0, pB1, K_lds + SHM_K, qr, r32, hi, s);
    finishSM(pA0, pA1, alA, l_reg, pa0, pa1, pa2, pa3); SBAR();
    SLOAD(SO, (j + 2) * KVBLK); SBAR();
    pv_d0(o, vb0, pa0, pa1, pa2, pa3); partialSM(pB0, pB1, m_reg, mnB, alB);
    __syncthreads(); SWAIT(); SWRITE(0, SE);
    RESC(alB); __syncthreads();
    SBAR(); qkt(pA0, pA1, K_lds, qr, r32, hi, s);
    finishSM(pB0, pB1, alB, l_reg, pa0, pa1, pa2, pa3); SBAR();
    if (j + 3 < NT) SLOAD(SE, (j + 3) * KVBLK); SBAR();
    pv_d0(o, vb0 + SHM_V, pa0, pa1, pa2, pa3); partialSM(pA0, pA1, m_reg, mnA, alA);
    __syncthreads(); SWAIT(); SWRITE(1, SO);
    RESC(alA); __syncthreads();
  }
  SBAR(); qkt(pB0, pB1, K_lds + SHM_K, qr, r32, hi, s);
  finishSM(pA0, pA1, alA, l_reg, pa0, pa1, pa2, pa3); SBAR();
  pv_d0(o, vb0, pa0, pa1, pa2, pa3); partialSM(pB0, pB1, m_reg, mnB, alB);
  __syncthreads(); RESC(alB);
  finishSM(pB0, pB1, alB, l_reg, pa0, pa1, pa2, pa3); SBAR();
  pv_d0(o, vb0 + SHM_V, pa0, pa1, pa2, pa3);
  if (hi == 0) li_l[r32] = l_reg; asm volatile("s_waitcnt lgkmcnt(0)" ::: "memory");
  int hi2 = hi; asm volatile("" : "+v"(hi2));
  float rli[16];
#pragma unroll
  for (int r = 0; r < 16; ++r) rli[r] = 1.0f / li_l[crow(r, hi2)];
  __syncthreads();
  int xoff = qb * 4096 + r32, yoff = qb * 32 * 1024 + r32;
  asm volatile("" : "+v"(xoff), "+v"(yoff));
  float* X = (float*)lds + xoff;
  if (s == 1) {
#pragma unroll
    for (int r = 0; r < 16; ++r)
#pragma unroll
      for (int d0 = 0; d0 < 4; ++d0) X[crow(r, hi2) * 128 + d0 * 32] = lam * o[d0][r] * rli[r];
  }
  __syncthreads();
  if (s == 0) {
    float gv[4];
#pragma unroll
    for (int d0 = 0; d0 < 4; ++d0) gv[d0] = subg[d0 * 32 + r32] * 0.8f;
#pragma unroll
    for (int r = 0; r < 16; ++r) {
      const int row = crow(r, hi2); float v[4]; float ss = 0.f;
#pragma unroll
      for (int d0 = 0; d0 < 4; ++d0) { v[d0] = o[d0][r] * rli[r] - X[row * 128 + d0 * 32]; ss += v[d0] * v[d0]; }
      ss += swz_xor<16>(ss); ss += swz_xor<8>(ss); ss += swz_xor<4>(ss); ss += swz_xor<2>(ss); ss += swz_xor<1>(ss);
      const float rs = rsqrtf(ss * (1.0f / 128.0f) + 1e-5f);
      u16* yp = Yb + (yoff + row * 1024);
#pragma unroll
      for (int d0 = 0; d0 < 4; ++d0) yp[d0 * 32] = f2bf(v[d0] * rs * gv[d0]);
    }
  }
  __syncthreads();
#undef LD8
#undef SLOAD
#undef SWRITE
#undef SWAIT
#undef RESC
}

#ifndef PROBE_ATT_VALU
#define PROBE_ATT_VALU 0
#endif
#ifndef PROBE_ATT_MFMA
#define PROBE_ATT_MFMA 0
#endif
__device__ __forceinline__ void sm_half(f32x16& p, float& m_reg, float& l_reg, float& alpha, bf16x8& paA, bf16x8& paB) {
  constexpr float C = SCALE * 1.4426950408889634f * (PROBE_ATT_MFMA ? 0.5f : 1.0f);
  float pmax = p[0];
#pragma unroll
  for (int r = 1; r < 16; ++r) pmax = fmaxf(pmax, p[r]);
  { auto rr = __builtin_amdgcn_permlane32_swap(__float_as_uint(pmax), __float_as_uint(pmax), false, false);
    pmax = fmaxf(__uint_as_float(rr[0]), __uint_as_float(rr[1])); }
  float mn;
  if (__builtin_expect(__all(pmax - m_reg <= THR / SCALE * (PROBE_ATT_MFMA ? 2.0f : 1.0f)), 1)) { mn = m_reg; alpha = 1.f; }
  else { mn = fmaxf(m_reg, pmax); alpha = __builtin_amdgcn_exp2f((m_reg - mn) * C); m_reg = mn; }
  const float mnC = -mn * C;
#if PROBE_ATT_VALU
  { float junk = 0.f;
#pragma unroll
    for (int r = 0; r < 16; ++r) junk += __builtin_amdgcn_exp2f(fmaf(p[r], C, mnC - 1.0f));
    l_reg += junk * 0.0f; }
#endif
#pragma unroll
  for (int r = 0; r < 16; ++r) p[r] = __builtin_amdgcn_exp2f(fmaf(p[r], C, mnC));
  float ps = 0;
#pragma unroll
  for (int r = 0; r < 16; ++r) ps += p[r];
  { auto rr = __builtin_amdgcn_permlane32_swap(__float_as_uint(ps), __float_as_uint(ps), false, false);
    ps = __uint_as_float(rr[0]) + __uint_as_float(rr[1]); }
  l_reg = l_reg * alpha + ps;
#define PK4(P, BASE, OUT) do { unsigned a0 = cvtpk(P[BASE + 0], P[BASE + 1]), a1 = cvtpk(P[BASE + 2], P[BASE + 3]);   \
    unsigned b0 = cvtpk(P[BASE + 4], P[BASE + 5]), b1 = cvtpk(P[BASE + 6], P[BASE + 7]);                              \
    auto r0 = __builtin_amdgcn_permlane32_swap(a0, b0, false, false); auto r1 = __builtin_amdgcn_permlane32_swap(a1, b1, false, false); \
    u32x4 w = {r0[0], r1[0], r0[1], r1[1]}; OUT = *reinterpret_cast<bf16x8*>(&w); } while (0)
  PK4(p, 0, paA); PK4(p, 8, paB);
#undef PK4
}

__device__ __forceinline__ void sm_half_b(f32x16& p, float mnC, float& l_reg, bf16x8& paA, bf16x8& paB) {
  constexpr float C = SCALE * 1.4426950408889634f;
#pragma unroll
  for (int r = 0; r < 16; ++r) p[r] = __builtin_amdgcn_exp2f(fmaf(p[r], C, mnC));
  float ps0 = p[0] + p[1], ps1 = p[2] + p[3], ps2 = p[4] + p[5], ps3 = p[6] + p[7];
  ps0 += p[8] + p[9]; ps1 += p[10] + p[11]; ps2 += p[12] + p[13]; ps3 += p[14] + p[15];
  float ps = (ps0 + ps1) + (ps2 + ps3);
  { auto rr = __builtin_amdgcn_permlane32_swap(__float_as_uint(ps), __float_as_uint(ps), false, false);
    ps = __uint_as_float(rr[0]) + __uint_as_float(rr[1]); }
  l_reg += ps;
#define PK4(P, BASE, OUT) do { unsigned a0 = cvtpk(P[BASE + 0], P[BASE + 1]), a1 = cvtpk(P[BASE + 2], P[BASE + 3]);   \
    unsigned b0 = cvtpk(P[BASE + 4], P[BASE + 5]), b1 = cvtpk(P[BASE + 6], P[BASE + 7]);                              \
    auto r0 = __builtin_amdgcn_permlane32_swap(a0, b0, false, false); auto r1 = __builtin_amdgcn_permlane32_swap(a1, b1, false, false); \
    u32x4 w = {r0[0], r1[0], r0[1], r1[1]}; OUT = *reinterpret_cast<bf16x8*>(&w); } while (0)
  PK4(p, 0, paA); PK4(p, 8, paB);
#undef PK4
}
__device__ __forceinline__ float sumsq8(bf16x8 v) {
  const u32x4 w = *reinterpret_cast<const u32x4*>(&v); float s = 0.f;
#pragma unroll
  for (int i = 0; i < 4; ++i) { const float lo = __uint_as_float(w[i] << 16), hi = __uint_as_float(w[i] & 0xffff0000u); s += lo * lo + hi * hi; }
  return s;
}
typedef short s16x4w __attribute__((ext_vector_type(4)));
template <int HF> __device__ __forceinline__ void pv_half2(f32x16* o0, f32x16* o1, LAS unsigned char* vbp, bf16x8 p0a, bf16x8 p0b, bf16x8 p1a, bf16x8 p1b) {
#define TR(off) __builtin_amdgcn_ds_read_tr16_b64_v4i16((LAS s16x4w*)(vbp + (off)))
#define PK(L, H) (bf16x8){L[0], L[1], L[2], L[3], H[0], H[1], H[2], H[3]}
  s16x4w la[4], ha[4], lb[4], hb[4];
#pragma unroll
  for (int d0 = 0; d0 < 4; ++d0) { la[d0] = TR(v_rd_off(d0, 2 * HF, 0)); ha[d0] = TR(v_rd_off(d0, 2 * HF, 1)); lb[d0] = TR(v_rd_off(d0, 2 * HF + 1, 0)); hb[d0] = TR(v_rd_off(d0, 2 * HF + 1, 1)); }
#pragma unroll
  for (int d0 = 0; d0 < 4; ++d0) { const bf16x8 va = PK(la[d0], ha[d0]);
    o0[d0] = __builtin_amdgcn_mfma_f32_32x32x16_bf16(p0a, va, o0[d0], 0, 0, 0); o1[d0] = __builtin_amdgcn_mfma_f32_32x32x16_bf16(p1a, va, o1[d0], 0, 0, 0); }
#pragma unroll
  for (int d0 = 0; d0 < 4; ++d0) { const bf16x8 vb = PK(lb[d0], hb[d0]);
    o0[d0] = __builtin_amdgcn_mfma_f32_32x32x16_bf16(p0b, vb, o0[d0], 0, 0, 0); o1[d0] = __builtin_amdgcn_mfma_f32_32x32x16_bf16(p1b, vb, o1[d0], 0, 0, 0); }
#undef TR
#undef PK
}
__device__ __forceinline__ void diff_attn_unit2(const u16* __restrict__ Qb, const u16* __restrict__ Kh, const u16* __restrict__ Vh, u16* __restrict__ Yb,
                                                float lam, const float* __restrict__ subg, const float* __restrict__ kn2, char* lds, LAS unsigned char* ldsl) {
  const int tid = threadIdx.x, wid = __builtin_amdgcn_readfirstlane(tid >> 6), lane = tid & 63, r32 = lane & 31, hi = lane >> 5;
  char* V_lds = lds; char* K_lds = lds + 2 * SHM_V;
  float* wsl = (float*)(lds + 2 * SHM_V + 2 * SHM_K) + wid * 96; float* li0 = wsl; float* li1 = wsl + 32; float* al_l = wsl + 64;
  float l0 = 0.f, l1 = 0.f; f32x16 o0[4] = {}, o1[4] = {}; bf16x8 q0[4], q1[4];
  { unsigned qoff = (unsigned)((wid * 32 + r32) * LDQ + hi * 8) * 2u; asm volatile("" : "+v"(qoff));
    const char* Qw = (const char*)Qb + qoff;
#pragma unroll
    for (int d0 = 0; d0 < 4; ++d0) { q0[d0] = *reinterpret_cast<const bf16x8*>(Qw + d0 * 32); q1[d0] = *reinterpret_cast<const bf16x8*>(Qw + 128 + d0 * 32); } }
  float mnC0, mnC1;
  {
    float* cmax = (float*)(lds + 2 * SHM_V + 2 * SHM_K + 8 * 96 * 4);
    int t_ = tid; asm volatile("" : "+v"(t_));
    const int ck = t_ >> 1, cs = t_ & 1; const char* kp_ = (const char*)Kh + (unsigned)(((SEQ + ck) * LDK + cs * 64) * 2); const u16* kp = (const u16*)kp_; float ss = 0.f;
#pragma unroll
    for (int i = 0; i < 8; ++i) ss += sumsq8(*reinterpret_cast<const bf16x8*>(kp + i * 8));
    ss = fmaxf(ss, swz_xor<2>(ss)); ss = fmaxf(ss, swz_xor<4>(ss)); ss = fmaxf(ss, swz_xor<8>(ss)); ss = fmaxf(ss, swz_xor<16>(ss));
    { auto rr = __builtin_amdgcn_permlane32_swap(__float_as_uint(ss), __float_as_uint(ss), false, false); ss = fmaxf(__uint_as_float(rr[0]), __uint_as_float(rr[1])); }
    if (lane < 2) cmax[wid * 2 + lane] = ss;
    __syncthreads();
    float c0 = cmax[0], c1 = cmax[1];
#pragma unroll
    for (int w = 1; w < 8; ++w) { c0 = fmaxf(c0, cmax[2 * w]); c1 = fmaxf(c1, cmax[2 * w + 1]); }
    const float kb0 = fmaxf(kn2[0], c0), kb1 = fmaxf(kn2[1], c1);
    float qa = 0.f, qb = 0.f;
#pragma unroll
    for (int d0 = 0; d0 < 4; ++d0) { qa += sumsq8(q0[d0]); qb += sumsq8(q1[d0]); }
    { auto rr = __builtin_amdgcn_permlane32_swap(__float_as_uint(qa), __float_as_uint(qa), false, false); qa = __uint_as_float(rr[0]) + __uint_as_float(rr[1]); }
    { auto rr = __builtin_amdgcn_permlane32_swap(__float_as_uint(qb), __float_as_uint(qb), false, false); qb = __uint_as_float(rr[0]) + __uint_as_float(rr[1]); }
    constexpr float C = SCALE * 1.4426950408889634f;
    mnC0 = -sqrtf(qa * kb0) * C * 1.0001f - 1e-6f; mnC1 = -sqrtf(qb * kb1) * C * 1.0001f - 1e-6f;
  }
  LAS unsigned char* vbl = ldsl + v_rd_base(lane);
  int kb[4];
#pragma unroll
  for (int d0 = 0; d0 < 4; ++d0) kb[d0] = r32 * 256 + ((d0 * 32 + hi * 16) ^ ((r32 & 7) << 4));
  unsigned koff[2], voff[2];
#pragma unroll
  for (int i = 0; i < 2; ++i) { const int L = (wid + 8 * i) * 64 + lane;
    { const int row = L >> 4, pos = L & 15; koff[i] = (unsigned)(row * 1024 + ((pos ^ (row & 7)) << 4)); }
    { const int sub = L >> 5, within = L & 31, kk = (sub >> 2) * 8 + (within >> 2), k = (kk & ~0xC) | ((kk & 4) << 1) | ((kk & 8) >> 1), c = (sub & 3) * 32 + (within & 3) * 8;
      voff[i] = (unsigned)(k * 1024 + c * 2); } }
#define SDMA(b, k0) do { const char* vg = (const char*)Vh + (size_t)(k0) * (LDK * 2); const char* kg = (const char*)Kh + (size_t)(k0) * (LDK * 2); \
    _Pragma("unroll") for (int i = 0; i < 2; ++i) {                                                                                                  \
      __builtin_amdgcn_global_load_lds((const unsigned*)(kg + i * 32768 + koff[0]), (LAS unsigned*)(ldsl + 2 * SHM_V + (b) * SHM_K + (wid + 8 * i) * 1024), 16, 0, 0); \
      __builtin_amdgcn_global_load_lds((const unsigned*)(vg + i * 32768 + voff[0]), (LAS unsigned*)(ldsl + (b) * SHM_V + (wid + 8 * i) * 1024), 16, 0, 0); } } while (0)
#define VWAIT() asm volatile("s_waitcnt vmcnt(0)" ::: "memory")
#define RESC(o, a) do { if (__any((a) < 1.f)) { if (hi == 0) al_l[r32] = (a); asm volatile("s_waitcnt lgkmcnt(0)" ::: "memory"); \
    _Pragma("unroll") for (int d = 0; d < 4; ++d) _Pragma("unroll") for (int r = 0; r < 16; ++r) o[d][r] *= al_l[crow(r, hi)]; } } while (0)
#define HALF(b, HF) do { const char* Kt = K_lds + (b) * SHM_K; f32x16 s0 = {}, s1 = {}; bf16x8 kf0[4], kf1[4];                  \
    _Pragma("unroll") for (int d0 = 0; d0 < 4; ++d0) {                                                                     \
      kf0[d0] = *reinterpret_cast<const bf16x8*>(Kt + kb[d0] + (HF) * 8192);                                               \
      kf1[d0] = *reinterpret_cast<const bf16x8*>(Kt + kb[d0] + (HF) * 8192 + 128); }                                       \
    _Pragma("unroll") for (int d0 = 0; d0 < 4; ++d0) {                                                                     \
      s0 = __builtin_amdgcn_mfma_f32_32x32x16_bf16(kf0[d0], q0[d0], s0, 0, 0, 0);                                           \
      s1 = __builtin_amdgcn_mfma_f32_32x32x16_bf16(kf1[d0], q1[d0], s1, 0, 0, 0); }                                         \
    bf16x8 p0a, p0b, p1a, p1b;                                                                                              \
    sm_half_b(s0, mnC0, l0, p0a, p0b);                                                                                      \
    sm_half_b(s1, mnC1, l1, p1a, p1b);                                                                                      \
    pv_half2<HF>(o0, o1, vbl + (b) * SHM_V, p0a, p0b, p1a, p1b); } while (0)
  constexpr int NT = NKEY / KVBLK;
  SDMA(0, 0); VWAIT(); __syncthreads();
  for (int j = 0; j < NT; j += 2) {
    SDMA(1, (j + 1) * KVBLK);
    HALF(0, 0); HALF(0, 1);
    VWAIT(); __syncthreads();
    if (j + 2 < NT) SDMA(0, (j + 2) * KVBLK);
    HALF(1, 0); HALF(1, 1);
    VWAIT(); __syncthreads();
  }
  if (hi == 0) { li0[r32] = l0; li1[r32] = l1; } asm volatile("s_waitcnt lgkmcnt(0)" ::: "memory");
  int hi2 = hi, yoff = wid * 32 * 1024 + r32; asm volatile("" : "+v"(hi2), "+v"(yoff));
  float gv[4];
#pragma unroll
  for (int d0 = 0; d0 < 4; ++d0) gv[d0] = subg[d0 * 32 + (yoff & 31)] * 0.8f;
#pragma unroll
  for (int r = 0; r < 16; ++r) {
    const int row = crow(r, hi2); const float r0 = 1.0f / li0[row], r1 = lam / li1[row]; float v[4]; float ss = 0.f;
#pragma unroll
    for (int d0 = 0; d0 < 4; ++d0) { v[d0] = o0[d0][r] * r0 - o1[d0][r] * r1; ss += v[d0] * v[d0]; }
    ss += swz_xor<16>(ss); ss += swz_xor<8>(ss); ss += swz_xor<4>(ss); ss += swz_xor<2>(ss); ss += swz_xor<1>(ss);
    const float rs = rsqrtf(ss * (1.0f / 128.0f) + 1e-5f);
    u16* yp = Yb + (yoff + row * 1024);
#pragma unroll
    for (int d0 = 0; d0 < 4; ++d0) yp[d0 * 32] = f2bf(v[d0] * rs * gv[d0]);
  }
  __syncthreads();
#undef SDMA
#undef VWAIT
#undef RESC
#undef HALF
}

constexpr int L3_V = 0, L3_K = 3 * SHM_V, L3_Q = L3_K + 2 * SHM_K, L3_S = L3_Q + 65536, L3_END = L3_S + 8 * 96 * 4;
typedef short s16x4v __attribute__((ext_vector_type(4)));
__device__ __forceinline__ void sm3(f32x16& p, float& m_reg, float& l_reg, float& alpha, bf16x8& paA, bf16x8& paB) {
  constexpr float C = SCALE * 1.4426950408889634f;
  float pmax = fmaxf(fmaxf(p[0], p[1]), fmaxf(p[2], p[3]));
#pragma unroll
  for (int r = 4; r < 16; r += 2) pmax = fmaxf(pmax, fmaxf(p[r], p[r + 1]));
  { auto rr = __builtin_amdgcn_permlane32_swap(__float_as_uint(pmax), __float_as_uint(pmax), false, false);
    pmax = fmaxf(__uint_as_float(rr[0]), __uint_as_float(rr[1])); }
  const float mn = (pmax - m_reg <= THR / SCALE) ? m_reg : fmaxf(m_reg, pmax);
  alpha = __builtin_amdgcn_exp2f((m_reg - mn) * C); m_reg = mn;
  const float mnC = -mn * C;
#pragma unroll
  for (int r = 0; r < 16; ++r) p[r] = __builtin_amdgcn_exp2f(fmaf(p[r], C, mnC));
  float ps0 = p[0] + p[1], ps1 = p[2] + p[3], ps2 = p[4] + p[5], ps3 = p[6] + p[7];
  ps0 += p[8] + p[9]; ps1 += p[10] + p[11]; ps2 += p[12] + p[13]; ps3 += p[14] + p[15];
  float ps = (ps0 + ps1) + (ps2 + ps3);
  { auto rr = __builtin_amdgcn_permlane32_swap(__float_as_uint(ps), __float_as_uint(ps), false, false);
    ps = __uint_as_float(rr[0]) + __uint_as_float(rr[1]); }
  l_reg = l_reg * alpha + ps;
#define PK4(P, BASE, OUT) do { unsigned a0 = cvtpk(P[BASE + 0], P[BASE + 1]), a1 = cvtpk(P[BASE + 2], P[BASE + 3]);   \
    unsigned b0 = cvtpk(P[BASE + 4], P[BASE + 5]), b1 = cvtpk(P[BASE + 6], P[BASE + 7]);                              \
    auto r0 = __builtin_amdgcn_permlane32_swap(a0, b0, false, false); auto r1 = __builtin_amdgcn_permlane32_swap(a1, b1, false, false); \
    u32x4 w = {r0[0], r1[0], r0[1], r1[1]}; OUT = *reinterpret_cast<bf16x8*>(&w); } while (0)
  PK4(p, 0, paA); PK4(p, 8, paB);
#undef PK4
}
template <int HF> __device__ __forceinline__ void pv_all(f32x16* o0, f32x16* o1, LAS unsigned char* vbp, bf16x8 p0a, bf16x8 p0b, bf16x8 p1a, bf16x8 p1b) {
#define TR(off) __builtin_amdgcn_ds_read_tr16_b64_v4i16((LAS s16x4v*)(vbp + (off)))
#define PK(L, H) (bf16x8){L[0], L[1], L[2], L[3], H[0], H[1], H[2], H[3]}
#pragma unroll
  for (int d0 = 0; d0 < 4; ++d0) {
    const s16x4v la = TR(v_rd_off(d0, 2 * HF, 0)), ha = TR(v_rd_off(d0, 2 * HF, 1)), lb = TR(v_rd_off(d0, 2 * HF + 1, 0)), hb = TR(v_rd_off(d0, 2 * HF + 1, 1));
    const bf16x8 va = PK(la, ha), vb = PK(lb, hb);
    o0[d0] = __builtin_amdgcn_mfma_f32_32x32x16_bf16(p0a, va, o0[d0], 0, 0, 0);
    o1[d0] = __builtin_amdgcn_mfma_f32_32x32x16_bf16(p1a, va, o1[d0], 0, 0, 0);
    o0[d0] = __builtin_amdgcn_mfma_f32_32x32x16_bf16(p0b, vb, o0[d0], 0, 0, 0);
    o1[d0] = __builtin_amdgcn_mfma_f32_32x32x16_bf16(p1b, vb, o1[d0], 0, 0, 0);
  }
#undef TR
#undef PK
}
__device__ __forceinline__ void diff_attn_unit3(const u16* __restrict__ Qb, const u16* __restrict__ Kh, const u16* __restrict__ Vh, u16* __restrict__ Yb,
                                                float lam, const float* __restrict__ subg, LAS unsigned char* ldsl) {
  const int tid = threadIdx.x, wid = __builtin_amdgcn_readfirstlane(tid >> 6), lane = tid & 63, r32 = lane & 31, hi = lane >> 5;
  LAS float* wsl = (LAS float*)(ldsl + L3_S) + wid * 96; LAS float* li0 = wsl; LAS float* li1 = wsl + 32; LAS float* al_l = wsl + 64;
  float m0 = -1e30f, l0 = 0.f, m1 = -1e30f, l1 = 0.f; f32x16 o0[4] = {}, o1[4] = {};
  int kb[4];
#pragma unroll
  for (int d0 = 0; d0 < 4; ++d0) kb[d0] = r32 * 256 + ((d0 * 32 + hi * 16) ^ ((r32 & 7) << 4));
  LAS unsigned char* Qw_l = ldsl + L3_Q + wid * 8192;
  { unsigned qoff = (unsigned)((wid * 32 + r32) * LDQ + hi * 8) * 2u; asm volatile("" : "+v"(qoff));
    const char* Qw = (const char*)Qb + qoff;
#pragma unroll
    for (int d0 = 0; d0 < 4; ++d0) { const bf16x8 a = *reinterpret_cast<const bf16x8*>(Qw + d0 * 32), b = *reinterpret_cast<const bf16x8*>(Qw + 128 + d0 * 32);
      *(LAS bf16x8*)(Qw_l + kb[d0]) = a; *(LAS bf16x8*)(Qw_l + kb[d0] + 128) = b; } }
  LAS unsigned char* vb0 = ldsl + L3_V + v_rd_base(lane);
  unsigned koff[2], voff[2];
#pragma unroll
  for (int i = 0; i < 2; ++i) { const int L = (wid + 8 * i) * 64 + lane;
    { const int row = L >> 4, pos = L & 15; koff[i] = (unsigned)(row * 1024 + ((pos ^ (row & 7)) << 4)); }
    { const int sub = L >> 5, within = L & 31, kk = (sub >> 2) * 8 + (within >> 2), k = (kk & ~0xC) | ((kk & 4) << 1) | ((kk & 8) >> 1), c = (sub & 3) * 32 + (within & 3) * 8;
      voff[i] = (unsigned)(k * 1024 + c * 2); } }
#define SDMA(ko, vo, k0) do { const char* vg = (const char*)Vh + (size_t)(k0) * (LDK * 2); const char* kg = (const char*)Kh + (size_t)(k0) * (LDK * 2); \
    _Pragma("unroll") for (int i = 0; i < 2; ++i) {                                                                                                  \
      __builtin_amdgcn_global_load_lds((const unsigned*)(kg + i * 32768 + koff[0]), (LAS unsigned*)(ldsl + L3_K + (ko) + (wid + 8 * i) * 1024), 16, 0, 0);      \
      __builtin_amdgcn_global_load_lds((const unsigned*)(vg + i * 32768 + voff[0]), (LAS unsigned*)(ldsl + L3_V + (vo) + (wid + 8 * i) * 1024), 16, 0, 0); } } while (0)
#define VWAIT() asm volatile("s_waitcnt vmcnt(0)" ::: "memory")
#define RESC(o, a) do { if (__any((a) < 1.f)) { if (hi == 0) al_l[r32] = (a); asm volatile("s_waitcnt lgkmcnt(0)" ::: "memory"); \
    _Pragma("unroll") for (int d = 0; d < 4; ++d) _Pragma("unroll") for (int r = 0; r < 16; ++r) o[d][r] *= al_l[crow(r, hi)]; } } while (0)
#define QKH(ko, HF) do { s0 = f32x16{}; s1 = f32x16{};                                                                      \
    _Pragma("unroll") for (int d0 = 0; d0 < 4; ++d0) {                                                                     \
      const bf16x8 k0 = *(const LAS bf16x8*)(ldsl + L3_K + (ko) + kb[d0] + (HF) * 8192);                                   \
      const bf16x8 k1 = *(const LAS bf16x8*)(ldsl + L3_K + (ko) + kb[d0] + (HF) * 8192 + 128);                             \
      const bf16x8 qa = *(const LAS bf16x8*)(Qw_l + kb[d0]); const bf16x8 qb = *(const LAS bf16x8*)(Qw_l + kb[d0] + 128);   \
      s0 = __builtin_amdgcn_mfma_f32_32x32x16_bf16(k0, qa, s0, 0, 0, 0);                                                    \
      s1 = __builtin_amdgcn_mfma_f32_32x32x16_bf16(k1, qb, s1, 0, 0, 0); } } while (0)
#define SMBOTH() do { float a0, a1; bf16x8 n0a, n0b, n1a, n1b;                                                              \
    sm3(s0, m0, l0, a0, n0a, n0b); sm3(s1, m1, l1, a1, n1a, n1b);                                                           \
    p0a = n0a; p0b = n0b; p1a = n1a; p1b = n1b; RESC(o0, a0); RESC(o1, a1); } while (0)
#define TR(off) __builtin_amdgcn_ds_read_tr16_b64_v4i16((LAS s16x4v*)(vp_ + (off)))
#define PKV(L, H) (bf16x8){L[0], L[1], L[2], L[3], H[0], H[1], H[2], H[3]}
#define TRD(S, d0, HF) do { S##0 = TR(v_rd_off(d0, 2 * (HF), 0)); S##1 = TR(v_rd_off(d0, 2 * (HF), 1)); S##2 = TR(v_rd_off(d0, 2 * (HF) + 1, 0)); S##3 = TR(v_rd_off(d0, 2 * (HF) + 1, 1)); } while (0)
#define PVD(S, d0) do { const bf16x8 va_ = PKV(S##0, S##1), vb_ = PKV(S##2, S##3);                                          \
    o0[d0] = __builtin_amdgcn_mfma_f32_32x32x16_bf16(p0a, va_, o0[d0], 0, 0, 0); o1[d0] = __builtin_amdgcn_mfma_f32_32x32x16_bf16(p1a, va_, o1[d0], 0, 0, 0); \
    o0[d0] = __builtin_amdgcn_mfma_f32_32x32x16_bf16(p0b, vb_, o0[d0], 0, 0, 0); o1[d0] = __builtin_amdgcn_mfma_f32_32x32x16_bf16(p1b, vb_, o1[d0], 0, 0, 0); } while (0)
#define ROWMAX(p, out) do { float t_ = fmaxf(fmaxf(p[0], p[1]), fmaxf(p[2], p[3]));                                        \
    _Pragma("unroll") for (int r = 4; r < 16; r += 2) t_ = fmaxf(t_, fmaxf(p[r], p[r + 1]));                               \
    auto rr_ = __builtin_amdgcn_permlane32_swap(__float_as_uint(t_), __float_as_uint(t_), false, false);                    \
    out = fmaxf(__uint_as_float(rr_[0]), __uint_as_float(rr_[1])); } while (0)
#define ROWSUM(p, out) do { float q0_ = p[0] + p[1], q1_ = p[2] + p[3], q2_ = p[4] + p[5], q3_ = p[6] + p[7];               \
    q0_ += p[8] + p[9]; q1_ += p[10] + p[11]; q2_ += p[12] + p[13]; q3_ += p[14] + p[15]; float t_ = (q0_ + q1_) + (q2_ + q3_); \
    auto rr_ = __builtin_amdgcn_permlane32_swap(__float_as_uint(t_), __float_as_uint(t_), false, false);                    \
    out = __uint_as_float(rr_[0]) + __uint_as_float(rr_[1]); } while (0)
#define PK4(P, BASE, OUT) do { unsigned a0_ = cvtpk(P[BASE + 0], P[BASE + 1]), a1_ = cvtpk(P[BASE + 2], P[BASE + 3]);       \
    unsigned b0_ = cvtpk(P[BASE + 4], P[BASE + 5]), b1_ = cvtpk(P[BASE + 6], P[BASE + 7]);                                  \
    auto r0_ = __builtin_amdgcn_permlane32_swap(a0_, b0_, false, false); auto r1_ = __builtin_amdgcn_permlane32_swap(a1_, b1_, false, false); \
    u32x4 w_ = {r0_[0], r1_[0], r0_[1], r1_[1]}; OUT = *reinterpret_cast<bf16x8*>(&w_); } while (0)
#define STEP(ko, QHF, vp, PVHF) do { LAS unsigned char* vp_ = (vp); constexpr float C_ = SCALE * 1.4426950408889634f;       \
    s16x4v A0, A1, A2, A3, B0, B1, B2, B3; float a0, a1, c0_, c1_; bf16x8 n0a, n0b, n1a, n1b;                                \
    TRD(A, 0, PVHF);                                                                                                        \
    QKH(ko, QHF);                                                                                                           \
    SBAR();                                                                                                                 \
    PVD(A, 0); TRD(B, 1, PVHF);                                                                                             \
    { float pm0, pm1; ROWMAX(s0, pm0); ROWMAX(s1, pm1);                                                                     \
      const float mn0 = (pm0 - m0 <= THR / SCALE) ? m0 : fmaxf(m0, pm0), mn1 = (pm1 - m1 <= THR / SCALE) ? m1 : fmaxf(m1, pm1); \
      a0 = __builtin_amdgcn_exp2f((m0 - mn0) * C_); a1 = __builtin_amdgcn_exp2f((m1 - mn1) * C_); m0 = mn0; m1 = mn1; c0_ = -mn0 * C_; c1_ = -mn1 * C_; } \
    SBAR();                                                                                                                 \
    PVD(B, 1); TRD(A, 2, PVHF);                                                                                             \
    _Pragma("unroll") for (int r = 0; r < 16; ++r) s0[r] = __builtin_amdgcn_exp2f(fmaf(s0[r], C_, c0_));                    \
    SBAR();                                                                                                                 \
    PVD(A, 2); TRD(B, 3, PVHF);                                                                                             \
    _Pragma("unroll") for (int r = 0; r < 16; ++r) s1[r] = __builtin_amdgcn_exp2f(fmaf(s1[r], C_, c1_));                    \
    SBAR();                                                                                                                 \
    PVD(B, 3);                                                                                                              \
    { float ps0, ps1; ROWSUM(s0, ps0); ROWSUM(s1, ps1); l0 = l0 * a0 + ps0; l1 = l1 * a1 + ps1;                             \
      PK4(s0, 0, n0a); PK4(s0, 8, n0b); PK4(s1, 0, n1a); PK4(s1, 8, n1b); }                                                  \
    SBAR();                                                                                                                 \
    p0a = n0a; p0b = n0b; p1a = n1a; p1b = n1b; RESC(o0, a0); RESC(o1, a1); } while (0)
  constexpr int NT = NKEY / KVBLK;
  f32x16 s0, s1; bf16x8 p0a, p0b, p1a, p1b;
  SDMA(0, 0, 0); VWAIT(); __syncthreads();
  SDMA(SHM_K, SHM_V, KVBLK);
  QKH(0, 0); SMBOTH();
  int vcur = 0;
  for (int j = 0; j < NT; ++j) {
    const int kcur = (j & 1) * SHM_K, knext = SHM_K - kcur;
    const int vnext = vcur == 2 * SHM_V ? 0 : vcur + SHM_V, vnn = vnext == 2 * SHM_V ? 0 : vnext + SHM_V;
    STEP(kcur, 1, vb0 + vcur, 0);
    VWAIT(); __syncthreads();
    if (j + 2 < NT) SDMA(kcur, vnn, (j + 2) * KVBLK);
    if (j + 1 < NT) { STEP(knext, 0, vb0 + vcur, 1); }
    else pv_all<1>(o0, o1, vb0 + vcur, p0a, p0b, p1a, p1b);
    vcur = vnext;
  }
  if (hi == 0) { li0[r32] = l0; li1[r32] = l1; } asm volatile("s_waitcnt lgkmcnt(0)" ::: "memory");
  int hi2 = hi, yoff = wid * 32 * 1024 + r32; asm volatile("" : "+v"(hi2), "+v"(yoff));
  float gv[4];
#pragma unroll
  for (int d0 = 0; d0 < 4; ++d0) gv[d0] = subg[d0 * 32 + (yoff & 31)] * 0.8f;
#pragma unroll
  for (int r = 0; r < 16; ++r) {
    const int row = crow(r, hi2); const float r0 = 1.0f / li0[row], r1 = lam / li1[row]; float v[4]; float ss = 0.f;
#pragma unroll
    for (int d0 = 0; d0 < 4; ++d0) { v[d0] = o0[d0][r] * r0 - o1[d0][r] * r1; ss += v[d0] * v[d0]; }
    ss += swz_xor<16>(ss); ss += swz_xor<8>(ss); ss += swz_xor<4>(ss); ss += swz_xor<2>(ss); ss += swz_xor<1>(ss);
    const float rs = rsqrtf(ss * (1.0f / 128.0f) + 1e-5f);
    u16* yp = Yb + (yoff + row * 1024);
#pragma unroll
    for (int d0 = 0; d0 < 4; ++d0) yp[d0 * 32] = f2bf(v[d0] * rs * gv[d0]);
  }
  __syncthreads();
#undef SDMA
#undef VWAIT
#undef RESC
#undef QKH
#undef SMBOTH
#undef STEP
#undef TR
#undef PKV
#undef TRD
#undef PVD
#undef ROWMAX
#undef ROWSUM
#undef PK4
}

__device__ __forceinline__ void diff_attn_unit4(const u16* __restrict__ Qb, const u16* __restrict__ Kh, const u16* __restrict__ Vh, u16* __restrict__ Yb,
                                                float lam, const float* __restrict__ subg, const float* __restrict__ kn2, LAS unsigned char* ldsl) {
  const int tid = threadIdx.x, wid = __builtin_amdgcn_readfirstlane(tid >> 6), lane = tid & 63, r32 = lane & 31, hi = lane >> 5;
  LAS float* wsl = (LAS float*)(ldsl + L3_S) + wid * 96; LAS float* li0 = wsl; LAS float* li1 = wsl + 32; LAS float* al_l = wsl + 64;
  float l0 = 0.f, l1 = 0.f; f32x16 o0[4] = {}, o1[4] = {}; bf16x8 q0[4], q1[4];
  int kb[4];
#pragma unroll
  for (int d0 = 0; d0 < 4; ++d0) kb[d0] = r32 * 256 + ((d0 * 32 + hi * 16) ^ ((r32 & 7) << 4));
  { unsigned qoff = (unsigned)((wid * 32 + r32) * LDQ + hi * 8) * 2u; asm volatile("" : "+v"(qoff));
    const char* Qw = (const char*)Qb + qoff;
#pragma unroll
    for (int d0 = 0; d0 < 4; ++d0) { q0[d0] = *reinterpret_cast<const bf16x8*>(Qw + d0 * 32); q1[d0] = *reinterpret_cast<const bf16x8*>(Qw + 128 + d0 * 32); } }
  float mnC0, mnC1;
  { LAS float* cmax = (LAS float*)(ldsl + L3_S) + 8 * 96 - 16;
    int t_ = tid; asm volatile("" : "+v"(t_));
    const int ck = t_ >> 1, cs = t_ & 1; const char* kp_ = (const char*)Kh + (unsigned)(((SEQ + ck) * LDK + cs * 64) * 2); const u16* kp = (const u16*)kp_; float ss = 0.f;
#pragma unroll
    for (int i = 0; i < 8; ++i) ss += sumsq8(*reinterpret_cast<const bf16x8*>(kp + i * 8));
    ss = fmaxf(ss, swz_xor<2>(ss)); ss = fmaxf(ss, swz_xor<4>(ss)); ss = fmaxf(ss, swz_xor<8>(ss)); ss = fmaxf(ss, swz_xor<16>(ss));
    { auto rr = __builtin_amdgcn_permlane32_swap(__float_as_uint(ss), __float_as_uint(ss), false, false); ss = fmaxf(__uint_as_float(rr[0]), __uint_as_float(rr[1])); }
    if (lane < 2) cmax[wid * 2 + lane] = ss;
    __syncthreads();
    float c0 = cmax[0], c1 = cmax[1];
#pragma unroll
    for (int w = 1; w < 8; ++w) { c0 = fmaxf(c0, cmax[2 * w]); c1 = fmaxf(c1, cmax[2 * w + 1]); }
    const float kb0 = fmaxf(kn2[0], c0), kb1 = fmaxf(kn2[1], c1);
    float qa = 0.f, qb = 0.f;
#pragma unroll
    for (int d0 = 0; d0 < 4; ++d0) { qa += sumsq8(q0[d0]); qb += sumsq8(q1[d0]); }
    { auto rr = __builtin_amdgcn_permlane32_swap(__float_as_uint(qa), __float_as_uint(qa), false, false); qa = __uint_as_float(rr[0]) + __uint_as_float(rr[1]); }
    { auto rr = __builtin_amdgcn_permlane32_swap(__float_as_uint(qb), __float_as_uint(qb), false, false); qb = __uint_as_float(rr[0]) + __uint_as_float(rr[1]); }
    constexpr float C = SCALE * 1.4426950408889634f;
    mnC0 = -sqrtf(qa * kb0) * C * 1.0001f - 1e-6f; mnC1 = -sqrtf(qb * kb1) * C * 1.0001f - 1e-6f;
    __syncthreads(); }
  LAS unsigned char* Qw_l = ldsl + L3_Q + wid * 8192;
#pragma unroll
  for (int d0 = 0; d0 < 4; ++d0) { *(LAS bf16x8*)(Qw_l + kb[d0]) = q0[d0]; *(LAS bf16x8*)(Qw_l + kb[d0] + 128) = q1[d0]; }
  LAS unsigned char* vb0 = ldsl + L3_V + v_rd_base(lane);
  unsigned koff[2], voff[2];
#pragma unroll
  for (int i = 0; i < 2; ++i) { const int L = (wid + 8 * i) * 64 + lane;
    { const int row = L >> 4, pos = L & 15; koff[i] = (unsigned)(row * 1024 + ((pos ^ (row & 7)) << 4)); }
    { const int sub = L >> 5, within = L & 31, kk = (sub >> 2) * 8 + (within >> 2), k = (kk & ~0xC) | ((kk & 4) << 1) | ((kk & 8) >> 1), c = (sub & 3) * 32 + (within & 3) * 8;
      voff[i] = (unsigned)(k * 1024 + c * 2); } }
#define SDMA(ko, vo, k0) do { const char* vg = (const char*)Vh + (size_t)(k0) * (LDK * 2); const char* kg = (const char*)Kh + (size_t)(k0) * (LDK * 2); \
    _Pragma("unroll") for (int i = 0; i < 2; ++i) {                                                                                                  \
      __builtin_amdgcn_global_load_lds((const unsigned*)(kg + i * 32768 + koff[0]), (LAS unsigned*)(ldsl + L3_K + (ko) + (wid + 8 * i) * 1024), 16, 0, 0);      \
      __builtin_amdgcn_global_load_lds((const unsigned*)(vg + i * 32768 + voff[0]), (LAS unsigned*)(ldsl + L3_V + (vo) + (wid + 8 * i) * 1024), 16, 0, 0); } } while (0)
#define VWAIT() asm volatile("s_waitcnt vmcnt(0)" ::: "memory")
#define RESC(o, a) do { if (__any((a) < 1.f)) { if (hi == 0) al_l[r32] = (a); asm volatile("s_waitcnt lgkmcnt(0)" ::: "memory"); \
    _Pragma("unroll") for (int d = 0; d < 4; ++d) _Pragma("unroll") for (int r = 0; r < 16; ++r) o[d][r] *= al_l[crow(r, hi)]; } } while (0)
#define QKH(ko, HF) do { s0 = f32x16{}; s1 = f32x16{}; int kx_ = kb[0]; asm volatile("" : "+v"(kx_));                            \
    _Pragma("unroll") for (int d0 = 0; d0 < 4; ++d0) { const int ka_ = kx_ ^ (d0 << 5);                                     \
      const bf16x8 k0 = *(const LAS bf16x8*)(ldsl + L3_K + (ko) + ka_ + (HF) * 8192);                                      \
      const bf16x8 k1 = *(const LAS bf16x8*)(ldsl + L3_K + (ko) + ka_ + (HF) * 8192 + 128);                                \
      const bf16x8 qa_ = *(const LAS bf16x8*)(Qw_l + ka_); const bf16x8 qb_ = *(const LAS bf16x8*)(Qw_l + ka_ + 128);       \
      s0 = __builtin_amdgcn_mfma_f32_32x32x16_bf16(k0, qa_, s0, 0, 0, 0);                                                  \
      s1 = __builtin_amdgcn_mfma_f32_32x32x16_bf16(k1, qb_, s1, 0, 0, 0); } } while (0)
#define SMBOTH() do { bf16x8 n0a, n0b, n1a, n1b; sm_half_b(s0, mnC0, l0, n0a, n0b); sm_half_b(s1, mnC1, l1, n1a, n1b);               \
    p0a = n0a; p0b = n0b; p1a = n1a; p1b = n1b; } while (0)
#define TR(off) __builtin_amdgcn_ds_read_tr16_b64_v4i16((LAS s16x4v*)(vp_ + (off)))
#define PKV(L, H) (bf16x8){L[0], L[1], L[2], L[3], H[0], H[1], H[2], H[3]}
#define TRD(S, d0, HF) do { S##0 = TR(v_rd_off(d0, 2 * (HF), 0)); S##1 = TR(v_rd_off(d0, 2 * (HF), 1)); S##2 = TR(v_rd_off(d0, 2 * (HF) + 1, 0)); S##3 = TR(v_rd_off(d0, 2 * (HF) + 1, 1)); } while (0)
#define PVD(S, d0) do { const bf16x8 va_ = PKV(S##0, S##1), vb_ = PKV(S##2, S##3);                                          \
    o0[d0] = __builtin_amdgcn_mfma_f32_32x32x16_bf16(p0a, va_, o0[d0], 0, 0, 0); o1[d0] = __builtin_amdgcn_mfma_f32_32x32x16_bf16(p1a, va_, o1[d0], 0, 0, 0); \
    o0[d0] = __builtin_amdgcn_mfma_f32_32x32x16_bf16(p0b, vb_, o0[d0], 0, 0, 0); o1[d0] = __builtin_amdgcn_mfma_f32_32x32x16_bf16(p1b, vb_, o1[d0], 0, 0, 0); } while (0)
#define ROWMAX(p, out) do { float t_ = fmaxf(fmaxf(p[0], p[1]), fmaxf(p[2], p[3]));                                        \
    _Pragma("unroll") for (int r = 4; r < 16; r += 2) t_ = fmaxf(t_, fmaxf(p[r], p[r + 1]));                               \
    auto rr_ = __builtin_amdgcn_permlane32_swap(__float_as_uint(t_), __float_as_uint(t_), false, false);                    \
    out = fmaxf(__uint_as_float(rr_[0]), __uint_as_float(rr_[1])); } while (0)
#define ROWSUM(p, out) do { float q0_ = p[0] + p[1], q1_ = p[2] + p[3], q2_ = p[4] + p[5], q3_ = p[6] + p[7];               \
    q0_ += p[8] + p[9]; q1_ += p[10] + p[11]; q2_ += p[12] + p[13]; q3_ += p[14] + p[15]; float t_ = (q0_ + q1_) + (q2_ + q3_); \
    auto rr_ = __builtin_amdgcn_permlane32_swap(__float_as_uint(t_), __float_as_uint(t_), false, false);                    \
    out = __uint_as_float(rr_[0]) + __uint_as_float(rr_[1]); } while (0)
#define PK4(P, BASE, OUT) do { unsigned a0_ = cvtpk(P[BASE + 0], P[BASE + 1]), a1_ = cvtpk(P[BASE + 2], P[BASE + 3]);       \
    unsigned b0_ = cvtpk(P[BASE + 4], P[BASE + 5]), b1_ = cvtpk(P[BASE + 6], P[BASE + 7]);                                  \
    auto r0_ = __builtin_amdgcn_permlane32_swap(a0_, b0_, false, false); auto r1_ = __builtin_amdgcn_permlane32_swap(a1_, b1_, false, false); \
    u32x4 w_ = {r0_[0], r1_[0], r0_[1], r1_[1]}; OUT = *reinterpret_cast<bf16x8*>(&w_); } while (0)
#define STEP(ko, QHF, vp, PVHF) do { LAS unsigned char* vp_ = (vp); constexpr float C_ = SCALE * 1.4426950408889634f;       \
    s16x4v A0, A1, A2, A3, B0, B1, B2, B3; bf16x8 n0a, n0b, n1a, n1b;                                                       \
    TRD(A, 0, PVHF);                                                                                                        \
    QKH(ko, QHF);                                                                                                           \
    SBAR();                                                                                                                 \
    PVD(A, 0); TRD(B, 1, PVHF);                                                                                             \
    _Pragma("unroll") for (int r = 0; r < 16; ++r) s0[r] = __builtin_amdgcn_exp2f(fmaf(s0[r], C_, mnC0));                   \
    SBAR();                                                                                                                 \
    PVD(B, 1); TRD(A, 2, PVHF);                                                                                             \
    _Pragma("unroll") for (int r = 0; r < 16; ++r) s1[r] = __builtin_amdgcn_exp2f(fmaf(s1[r], C_, mnC1));                   \
    SBAR();                                                                                                                 \
    PVD(A, 2); TRD(B, 3, PVHF);                                                                                             \
    { float ps0, ps1; ROWSUM(s0, ps0); ROWSUM(s1, ps1); l0 += ps0; l1 += ps1; PK4(s0, 0, n0a); PK4(s0, 8, n0b); }            \
    SBAR();                                                                                                                 \
    PVD(B, 3);                                                                                                              \
    { PK4(s1, 0, n1a); PK4(s1, 8, n1b); }                                                                                    \
    SBAR();                                                                                                                 \
    p0a = n0a; p0b = n0b; p1a = n1a; p1b = n1b; } while (0)
  constexpr int NT = NKEY / KVBLK;
  f32x16 s0, s1; bf16x8 p0a, p0b, p1a, p1b;
  SDMA(0, 0, 0); VWAIT(); __syncthreads();
  SDMA(SHM_K, SHM_V, KVBLK);
  QKH(0, 0); SMBOTH();
  int vcur = 0;
  for (int j = 0; j < NT; ++j) {
    const int kcur = (j & 1) * SHM_K, knext = SHM_K - kcur;
    const int vnext = vcur == 2 * SHM_V ? 0 : vcur + SHM_V, vnn = vnext == 2 * SHM_V ? 0 : vnext + SHM_V;
    STEP(kcur, 1, vb0 + vcur, 0);
    VWAIT(); __syncthreads();
    if (j + 2 < NT) SDMA(kcur, vnn, (j + 2) * KVBLK);
    if (j + 1 < NT) { STEP(knext, 0, vb0 + vcur, 1); }
    else pv_all<1>(o0, o1, vb0 + vcur, p0a, p0b, p1a, p1b);
    vcur = vnext;
  }
  int te = tid; asm volatile("" : "+v"(te));
  const int r32e = te & 31; int hi2 = (te >> 5) & 1, yoff = wid * 32 * 1024 + r32e;
  if (hi2 == 0) { li0[r32e] = l0; li1[r32e] = l1; } asm volatile("s_waitcnt lgkmcnt(0)" ::: "memory");
  float gv[4];
#pragma unroll
  for (int d0 = 0; d0 < 4; ++d0) gv[d0] = subg[d0 * 32 + (yoff & 31)] * 0.8f;
#pragma unroll
  for (int r = 0; r < 16; ++r) {
    const int row = crow(r, hi2); const float r0 = 1.0f / li0[row], r1 = lam / li1[row]; float v[4]; float ss = 0.f;
#pragma unroll
    for (int d0 = 0; d0 < 4; ++d0) { v[d0] = o0[d0][r] * r0 - o1[d0][r] * r1; ss += v[d0] * v[d0]; }
    ss += swz_xor<16>(ss); ss += swz_xor<8>(ss); ss += swz_xor<4>(ss); ss += swz_xor<2>(ss); ss += swz_xor<1>(ss);
    const float rs = rsqrtf(ss * (1.0f / 128.0f) + 1e-5f);
    u16* yp = Yb + (yoff + row * 1024);
#pragma unroll
    for (int d0 = 0; d0 < 4; ++d0) yp[d0 * 32] = f2bf(v[d0] * rs * gv[d0]);
  }
  __syncthreads();
#undef SDMA
#undef VWAIT
#undef RESC
#undef QKH
#undef SMBOTH
#undef STEP
#undef TR
#undef PKV
#undef TRD
#undef PVD
#undef ROWMAX
#undef ROWSUM
#undef PK4
}
}


__device__ __forceinline__ void key_norm_pass(const Params& p, int tid, int G, int bx) {
    const u16* K = (const u16*)(p.ws + WS_R2 + R2_K); int* KN = (int*)(p.ws + WS_KN2);
    const int lane = tid & 63, gw = bx * 8 + (tid >> 6), nw = G * 8;
    float mx0 = 0.f, mx1 = 0.f;
    for (int rb = gw; rb < 2 * SEQ; rb += 8 * nw) {
        att::bf16x8 v[8];
#pragma unroll
        for (int k = 0; k < 8; ++k) { const int r = rb + k * nw < 2 * SEQ ? rb + k * nw : rb; v[k] = *reinterpret_cast<const att::bf16x8*>(K + ((size_t)(r >> 14) * NKEY + (r & (SEQ - 1))) * 512 + lane * 8); }
#pragma unroll
        for (int k = 0; k < 8; ++k) { const int r = rb + k * nw < 2 * SEQ ? rb + k * nw : rb;
            float s = att::sumsq8(v[k]); s += att::swz_xor<1>(s); s += att::swz_xor<2>(s); s += att::swz_xor<4>(s);
            if (r >> 14) mx1 = fmaxf(mx1, s); else mx0 = fmaxf(mx0, s); }
    }
    if ((lane & 7) == 0) { if (mx0 > 0.f) atomicMax(KN + (lane >> 3), __float_as_int(mx0)); if (mx1 > 0.f) atomicMax(KN + 8 + (lane >> 3), __float_as_int(mx1)); }
}

__device__ __forceinline__ void attn_phase(const Params& p, char* lds, LAS unsigned char* ldsl, int tid, int G, int bx) {
    const int lane = tid & 63;
    float sa = p.lam[lane] * p.lam[64 + lane], sb = p.lam[128 + lane] * p.lam[192 + lane];
    sa += att::swz_xor<1>(sa); sa += att::swz_xor<2>(sa); sa += att::swz_xor<4>(sa); sa += att::swz_xor<8>(sa); sa += att::swz_xor<16>(sa);
    sb += att::swz_xor<1>(sb); sb += att::swz_xor<2>(sb); sb += att::swz_xor<4>(sb); sb += att::swz_xor<8>(sb); sb += att::swz_xor<16>(sb);
    { auto rr = __builtin_amdgcn_permlane32_swap(__float_as_uint(sa), __float_as_uint(sa), false, false); sa = __uint_as_float(rr[0]) + __uint_as_float(rr[1]); }
    { auto rr = __builtin_amdgcn_permlane32_swap(__float_as_uint(sb), __float_as_uint(sb), false, false); sb = __uint_as_float(rr[0]) + __uint_as_float(rr[1]); }
    const float lam = expf(sa) - expf(sb) + 0.2f;
    const u16* Q = (const u16*)(p.ws + WS_R2 + R2_Q); const u16* K = (const u16*)(p.ws + WS_R2 + R2_K); const u16* V = (const u16*)(p.ws + WS_R2 + R2_V);
    u16* Y = (u16*)(p.ws + WS_U);
#if ATT_V1
    for (int i = bx; i < 1024; i += G) {
        const int bh = i & 7, qblk = i >> 3, b = bh >> 2, h = bh & 3;
        att::diff_attn_unit(Q + ((size_t)b * SEQ + (size_t)qblk * 128) * 512 + h * 128, K + (size_t)b * NKEY * 512 + h * 128, V + (size_t)b * NKEY * 512 + h * 128,
                            Y + ((size_t)b * SEQ + (size_t)qblk * 128) * 1024 + 512 + h * 128, lam, p.subln_g, lds);
    }
#elif ATT_V2
    for (int i = bx; i < 512; i += G) {
        const int bh = i & 7, qblk = i >> 3, b = bh >> 2, h = bh & 3;
        att::diff_attn_unit2(Q + ((size_t)b * SEQ + (size_t)qblk * 256) * 512 + h * 128, K + (size_t)b * NKEY * 512 + h * 128, V + (size_t)b * NKEY * 512 + h * 128,
                             Y + ((size_t)b * SEQ + (size_t)qblk * 256) * 1024 + 512 + h * 128, lam, p.subln_g, (const float*)(p.ws + WS_KN2) + bh * 2, lds, ldsl);
    }
#elif ATT_V4
    for (int i = bx; i < 512; i += G) {
        const int bh = i & 7, qblk = i >> 3, b = bh >> 2, h = bh & 3;
        att::diff_attn_unit4(Q + ((size_t)b * SEQ + (size_t)qblk * 256) * 512 + h * 128, K + (size_t)b * NKEY * 512 + h * 128, V + (size_t)b * NKEY * 512 + h * 128,
                             Y + ((size_t)b * SEQ + (size_t)qblk * 256) * 1024 + 512 + h * 128, lam, p.subln_g, (const float*)(p.ws + WS_KN2) + bh * 2, ldsl);
    }
#else
    for (int i = bx; i < 512; i += G) {
        const int bh = i & 7, qblk = i >> 3, b = bh >> 2, h = bh & 3;
        att::diff_attn_unit3(Q + ((size_t)b * SEQ + (size_t)qblk * 256) * 512 + h * 128, K + (size_t)b * NKEY * 512 + h * 128, V + (size_t)b * NKEY * 512 + h * 128,
                             Y + ((size_t)b * SEQ + (size_t)qblk * 256) * 1024 + 512 + h * 128, lam, p.subln_g, ldsl);
    }
#endif
}

#define UNPK8(d, V_) do { const u32x4 q_ = (V_); d[0] = __uint_as_float(q_.x << 16); d[1] = __uint_as_float(q_.x & 0xffff0000u); d[2] = __uint_as_float(q_.y << 16); d[3] = __uint_as_float(q_.y & 0xffff0000u); \
    d[4] = __uint_as_float(q_.z << 16); d[5] = __uint_as_float(q_.z & 0xffff0000u); d[6] = __uint_as_float(q_.w << 16); d[7] = __uint_as_float(q_.w & 0xffff0000u); } while (0)
__device__ __forceinline__ void hy_t1(const Params& p, float* ldsf, int tid, int G, int bx) {
    const u16* Z = (const u16*)(p.ws + WS_R2 + R2_Z); float* W = (float*)(p.ws + WS_W);
    constexpr int BUF = 8704 + 512;
    u32x4 w[3]; float cwv;
#define T1_LOAD(it_) do { const int cb_ = (it_) & 7, tb_ = ((it_) >> 3) & 255, b_ = (it_) >> 11, t0_ = tb_ * 64, c0_ = cb_ * 64;                  \
        _Pragma("unroll") for (int k = 0; k < 3; ++k) { const int e = tid + 512 * k, piece = e & 7, seg = e >> 3, tensor = seg & 1, row = seg >> 1, t = t0_ - 1 + row; \
            w[k] = (e < 1056 && t >= 0 && t < SEQ) ? *(const u32x4*)(Z + ((size_t)b_ * SEQ + t) * 1536 + 512 + tensor * 512 + c0_ + piece * 8) : (u32x4){0u, 0u, 0u, 0u}; } \
        { const int tn_ = tid >> 8, kd_ = (tid >> 6) & 3, ch_ = 512 + tn_ * 512 + c0_ + (tid & 63); cwv = kd_ < 3 ? p.conv_w[kd_ * 1536 + ch_] : p.conv_b[ch_]; } } while (0)
#define T1_STORE(buf_) do { _Pragma("unroll") for (int k = 0; k < 3; ++k) { const int e = tid + 512 * k, piece = e & 7, seg = e >> 3, tensor = seg & 1, row = seg >> 1; \
            if (e < 1056) { float* d = (buf_) + tensor * (66 * 65) + row * 65 + piece * 8; UNPK8(d, w[k]); } } (buf_)[8704 + tid] = cwv; } while (0)
    int it = bx, cur = 0;
    if (it < 4096) { T1_LOAD(it); T1_STORE(ldsf); }
    __syncthreads();
    for (; it < 4096; it += G) {
        const int nxt = it + G;
        if (nxt < 4096) T1_LOAD(nxt);
        const int cb = it & 7, tb = (it >> 3) & 255, b = it >> 11, t0 = tb * 64, c0 = cb * 64;
        const float* lb = ldsf + cur * BUF;
        const int t = tid & 63, cg8 = tid >> 6;
#pragma unroll
        for (int i = 0; i < 8; ++i) { const int c = cg8 * 8 + i; const float* cw = lb + 8704 + c;
            const float* a = lb + t * 65 + c; const float* v = a + 66 * 65;
            const float x1 = a[0] * cw[0] + a[65] * cw[64] + a[130] * cw[128] + cw[192];
            const float xv = v[0] * cw[256] + v[65] * cw[320] + v[130] * cw[384] + cw[448];
            W[((size_t)(c0 + c) * 2 + b) * SEQ + t0 + t] = x1 * xv; }
        if (nxt < 4096) T1_STORE(ldsf + (cur ^ 1) * BUF);
        __syncthreads();
        cur ^= 1;
    }
#undef T1_LOAD
#undef T1_STORE
}
__device__ __forceinline__ void hy_t2(const Params& p, float* ldsf, int tid, int G, int bx) {
    const u16* Z = (const u16*)(p.ws + WS_R2 + R2_Z); const float* W = (const float*)(p.ws + WS_W); u16* Y = (u16*)(p.ws + WS_U);
    constexpr int BUF = 8704;
    u32x4 w[2]; float yv[8];
#define T2_LOAD(it_) do { const int cb_ = (it_) & 7, tb_ = ((it_) >> 3) & 255, b_ = (it_) >> 11, t0_ = tb_ * 64, c0_ = cb_ * 64;                  \
        _Pragma("unroll") for (int k = 0; k < 2; ++k) { const int e = tid + 512 * k, piece = e & 7, row = e >> 3, t = t0_ - 1 + row;             \
            w[k] = (e < 528 && t >= 0 && t < SEQ) ? *(const u32x4*)(Z + ((size_t)b_ * SEQ + t) * 1536 + c0_ + piece * 8) : (u32x4){0u, 0u, 0u, 0u}; } \
        _Pragma("unroll") for (int i = 0; i < 8; ++i) yv[i] = W[((size_t)(c0_ + (tid >> 6) * 8 + i) * 2 + b_) * SEQ + t0_ + (tid & 63)]; } while (0)
#define T2_STORE(buf_) do { _Pragma("unroll") for (int k = 0; k < 2; ++k) { const int e = tid + 512 * k, piece = e & 7, row = e >> 3;           \
            if (e < 528) { float* d = (buf_) + row * 65 + piece * 8; UNPK8(d, w[k]); } }                                                       \
        _Pragma("unroll") for (int i = 0; i < 8; ++i) (buf_)[66 * 65 + ((tid >> 6) * 8 + i) * 65 + (tid & 63)] = yv[i]; } while (0)
    int it = bx, cur = 0;
    if (it < 4096) { T2_LOAD(it); T2_STORE(ldsf); }
    __syncthreads();
    for (; it < 4096; it += G) {
        const int nxt = it + G;
        if (nxt < 4096) T2_LOAD(nxt);
        const int cb = it & 7, tb = (it >> 3) & 255, b = it >> 11, t0 = tb * 64, c0 = cb * 64;
        const float* lb = ldsf + cur * BUF; const float* ly = lb + 66 * 65;
        const int c = tid & 63, tg = tid >> 6, ch0 = c0 + c;
        const float w0 = p.conv_w[ch0], w1 = p.conv_w[1536 + ch0], w2 = p.conv_w[3072 + ch0], bb = p.conv_b[ch0];
#pragma unroll
        for (int i = 0; i < 8; ++i) { const int t = tg * 8 + i; const float* a = lb + t * 65 + c;
            const float x0 = a[0] * w0 + a[65] * w1 + a[130] * w2 + bb;
            Y[((size_t)b * SEQ + t0 + t) * 1024 + ch0] = f2bf(x0 * ly[c * 65 + t]); }
        if (nxt < 4096) T2_STORE(ldsf + (cur ^ 1) * BUF);
        __syncthreads();
        cur ^= 1;
    }
#undef T2_LOAD
#undef T2_STORE
}

__device__ __forceinline__ int fsw(int i) { return i ^ ((i >> 5) & 3) ^ (((i >> 6) & 7) << 2); }
struct FftTw { float2 a1[8], b1[2], a2[4], b2, a3[4], b3; };
__device__ __forceinline__ void fft_load_tw(FftTw& T, const float2* __restrict__ tw, int tid) {
#pragma unroll
    for (int b = 0; b < 4; ++b) { T.a1[2 * b] = tw[b * 1024 + tid]; T.a1[2 * b + 1] = tw[b * 1024 + tid + 512];
        T.a2[b] = tw[b * 1024 + (tid & 63) * 16]; T.a3[b] = tw[b * 1024 + (tid & 3) * 256]; }
    T.b1[0] = tw[tid * 4]; T.b1[1] = tw[(tid + 512) * 4]; T.b2 = tw[(tid & 63) * 64]; T.b3 = tw[(tid & 3) * 1024];
}
__device__ __forceinline__ void bf4_fwd(float2& a0, float2& a1, float2& a2, float2& a3, float2 w1) {
    const float2 w2 = cmul(w1, w1), w3 = cmul(w2, w1);
    const float2 s02 = make_float2(a0.x + a2.x, a0.y + a2.y), d02 = make_float2(a0.x - a2.x, a0.y - a2.y);
    const float2 s13 = make_float2(a1.x + a3.x, a1.y + a3.y), d13 = make_float2(a1.x - a3.x, a1.y - a3.y);
    a0 = make_float2(s02.x + s13.x, s02.y + s13.y);
    a1 = cmul(make_float2(d02.x + d13.y, d02.y - d13.x), w1);
    a2 = cmul(make_float2(s02.x - s13.x, s02.y - s13.y), w2);
    a3 = cmul(make_float2(d02.x - d13.y, d02.y + d13.x), w3);
}
__device__ __forceinline__ void bf4_inv(float2& a0, float2& a1, float2& a2, float2& a3, float2 w1  ) {
    const float2 w2 = cmul(w1, w1), w3 = cmul(w2, w1);
    const float2 b1 = cmul(a1, w1), b2 = cmul(a2, w2), b3 = cmul(a3, w3);
    const float2 s02 = make_float2(a0.x + b2.x, a0.y + b2.y), d02 = make_float2(a0.x - b2.x, a0.y - b2.y);
    const float2 s13 = make_float2(b1.x + b3.x, b1.y + b3.y), d13 = make_float2(b1.x - b3.x, b1.y - b3.y);
    a0 = make_float2(s02.x + s13.x, s02.y + s13.y);
    a1 = make_float2(d02.x - d13.y, d02.y + d13.x);
    a2 = make_float2(s02.x - s13.x, s02.y - s13.y);
    a3 = make_float2(d02.x + d13.y, d02.y - d13.x);
}
template <int QB, int SHB, bool INV, int PAIR> __device__ __forceinline__ void fft_pair(float2* d, const FftTw& T, int tid_) {
    int tid = tid_; asm volatile("" : "+v"(tid));
    float2 wa[2][4], wb[2];
#pragma unroll
    for (int i = 0; i < 2; ++i) {
#pragma unroll
        for (int b = 0; b < 4; ++b) wa[i][b] = PAIR == 1 ? T.a1[2 * b + i] : (PAIR == 2 ? T.a2[b] : T.a3[b]);
        wb[i] = PAIR == 1 ? T.b1[i] : (PAIR == 2 ? T.b2 : T.b3); }
    asm volatile("" : "+v"(wa[0][0].x), "+v"(wa[0][0].y), "+v"(wa[0][1].x), "+v"(wa[0][1].y), "+v"(wa[0][2].x), "+v"(wa[0][2].y), "+v"(wa[0][3].x), "+v"(wa[0][3].y), "+v"(wb[0].x), "+v"(wb[0].y));
    if (PAIR == 1) asm volatile("" : "+v"(wa[1][0].x), "+v"(wa[1][0].y), "+v"(wa[1][1].x), "+v"(wa[1][1].y), "+v"(wa[1][2].x), "+v"(wa[1][2].y), "+v"(wa[1][3].x), "+v"(wa[1][3].y), "+v"(wb[1].x), "+v"(wb[1].y));
#pragma unroll
    for (int i = 0; i < 2; ++i) {
        const int ii = PAIR == 1 ? i : 0;
        const int G = tid + 512 * i, j = G & (QB - 1), g = G >> SHB, base = g * 16 * QB + j;
        float2 x[4][4];
#pragma unroll
        for (int a = 0; a < 4; ++a)
#pragma unroll
            for (int b = 0; b < 4; ++b) x[a][b] = d[fsw(base + (4 * a + b) * QB)];
        if (!INV) {
#pragma unroll
            for (int b = 0; b < 4; ++b) bf4_fwd(x[0][b], x[1][b], x[2][b], x[3][b], wa[ii][b]);
#pragma unroll
            for (int a = 0; a < 4; ++a) bf4_fwd(x[a][0], x[a][1], x[a][2], x[a][3], wb[ii]);
        } else {
#pragma unroll
            for (int a = 0; a < 4; ++a) bf4_inv(x[a][0], x[a][1], x[a][2], x[a][3], make_float2(wb[ii].x, -wb[ii].y));
#pragma unroll
            for (int b = 0; b < 4; ++b) bf4_inv(x[0][b], x[1][b], x[2][b], x[3][b], make_float2(wa[ii][b].x, -wa[ii][b].y));
        }
#pragma unroll
        for (int a = 0; a < 4; ++a)
#pragma unroll
            for (int b = 0; b < 4; ++b) d[fsw(base + (4 * a + b) * QB)] = x[a][b];
    }
    __syncthreads();
}
template <bool INV, int MODE> __device__ __forceinline__ void fft_q1(float2* d, int tid_, float2* __restrict__ KS) {
    int tid = tid_; asm volatile("" : "+v"(tid));
#pragma unroll
    for (int h = 0; h < 2; ++h) {
        float2 ks[4][4];
        if (MODE == 2) {
#pragma unroll
            for (int i = 0; i < 4; ++i) { const float4* kp = (const float4*)(KS + (tid + 512 * (4 * h + i)) * 4); const float4 k01 = kp[0], k23 = kp[1];
                ks[i][0] = make_float2(k01.x, k01.y); ks[i][1] = make_float2(k01.z, k01.w); ks[i][2] = make_float2(k23.x, k23.y); ks[i][3] = make_float2(k23.z, k23.w); } }
#pragma unroll
        for (int i = 0; i < 4; ++i) {
            const int i0 = (tid + 512 * (4 * h + i)) * 4, p0 = fsw(i0), p1 = fsw(i0 + 1), p2 = fsw(i0 + 2), p3 = fsw(i0 + 3);
            const float2 a0 = d[p0], a1 = d[p1], a2 = d[p2], a3 = d[p3];
            const float2 s02 = make_float2(a0.x + a2.x, a0.y + a2.y), d02 = make_float2(a0.x - a2.x, a0.y - a2.y);
            const float2 s13 = make_float2(a1.x + a3.x, a1.y + a3.y), d13 = make_float2(a1.x - a3.x, a1.y - a3.y);
            float2 u0 = make_float2(s02.x + s13.x, s02.y + s13.y), u2 = make_float2(s02.x - s13.x, s02.y - s13.y), u1, u3;
            if (!INV) { u1 = make_float2(d02.x + d13.y, d02.y - d13.x); u3 = make_float2(d02.x - d13.y, d02.y + d13.x); }
            else      { u1 = make_float2(d02.x - d13.y, d02.y + d13.x); u3 = make_float2(d02.x + d13.y, d02.y - d13.x); }
            if (MODE == 1) { float4* kp = (float4*)(KS + i0); kp[0] = make_float4(u0.x, u0.y, u1.x, u1.y); kp[1] = make_float4(u2.x, u2.y, u3.x, u3.y); }
            else {
                if (MODE == 2) { u0 = cmul(u0, ks[i][0]); u1 = cmul(u1, ks[i][1]); u2 = cmul(u2, ks[i][2]); u3 = cmul(u3, ks[i][3]); }
                d[p0] = u0; d[p1] = u1; d[p2] = u2; d[p3] = u3; }
        }
    }
    __syncthreads();
}
template <bool INV, int MODE> __device__ __forceinline__ void fft16k(float2* d, const FftTw& T, int tid, float2* KS) {
    if (!INV) { fft_pair<1024, 10, false, 1>(d, T, tid); fft_pair<64, 6, false, 2>(d, T, tid); fft_pair<4, 2, false, 3>(d, T, tid); fft_q1<false, MODE>(d, tid, KS); }
    else      { fft_q1<true, 0>(d, tid, KS); fft_pair<4, 2, true, 3>(d, T, tid); fft_pair<64, 6, true, 2>(d, T, tid); fft_pair<1024, 10, true, 1>(d, T, tid); }
}

__device__ __forceinline__ void hy_fft(const Params& p, float2* d, int tid, int G, int bx, bool dummy) {
    const u16* HF = (const u16*)(p.ws + WS_HFILT); float* W = (float*)(p.ws + WS_W); const float2* tw = (const float2*)(p.ws + WS_TW); const float2* OM = (const float2*)(p.ws + WS_OM);
    float2* KS = (float2*)(p.ws + WS_SCR + (size_t)bx * 262144); float2* P1 = KS + SEQ;
    FftTw T; fft_load_tw(T, tw, tid);
    for (int c = bx; c < 512; c += G) {
        const float bias = p.hy_bias[c];
        float* W0 = W + (size_t)(c * 2) * SEQ; float* W1 = W0 + SEQ;
        const u16* HFf = HF + (size_t)c * SEQ; const u16* HFb = HF + (size_t)(512 + c) * SEQ;
        for (int pass = 0; pass < 2; ++pass) {
            { int t_ = tid; asm volatile("" : "+v"(t_));
              for (int k0 = 0; k0 < 32; k0 += 8) {
                u16 hf[8], hb[8]; float2 om[8];
#pragma unroll
                for (int k = 0; k < 8; ++k) { const int n = t_ + 512 * (k0 + k); hf[k] = HFf[n]; hb[k] = HFb[(SEQ - n) & (SEQ - 1)]; om[k] = pass ? OM[n] : make_float2(1.f, 0.f); }
#pragma unroll
                for (int k = 0; k < 8; ++k) { const int n = t_ + 512 * (k0 + k); const float f = bf2f(hf[k]), g = n ? bf2f(hb[k]) : 0.f;
                    const float kv = pass ? (f - g) : (f + g); d[fsw(n)] = make_float2(kv * om[k].x, kv * om[k].y); }
              } }
            __syncthreads();
            fft16k<false, 1>(d, T, tid, KS);
            { int t_ = tid; asm volatile("" : "+v"(t_));
              for (int k0 = 0; k0 < 32; k0 += 8) {
                float w0[8], w1[8]; float2 om[8];
#pragma unroll
                for (int k = 0; k < 8; ++k) { const int n = t_ + 512 * (k0 + k); w0[k] = W0[n]; w1[k] = W1[n]; om[k] = pass ? OM[n] : make_float2(1.f, 0.f); }
#pragma unroll
                for (int k = 0; k < 8; ++k) { const int n = t_ + 512 * (k0 + k); d[fsw(n)] = cmul(make_float2(w0[k], w1[k]), om[k]); }
              } }
            __syncthreads();
            fft16k<false, 2>(d, T, tid, KS);
            fft16k<true, 0>(d, T, tid, KS);
            { int t_ = tid; asm volatile("" : "+v"(t_));
              if (pass == 0 || dummy) {
#pragma unroll 8
                for (int k = 0; k < 32; ++k) { const int n = t_ + 512 * k; float2 r = d[fsw(n)]; r.x *= (1.0f / SEQ); r.y *= (1.0f / SEQ); P1[n] = r; }
              } else {
                for (int k0 = 0; k0 < 32; k0 += 8) {
                    float w0[8], w1[8]; float2 om[8], p1[8];
#pragma unroll
                    for (int k = 0; k < 8; ++k) { const int n = t_ + 512 * (k0 + k); w0[k] = W0[n]; w1[k] = W1[n]; om[k] = OM[n]; p1[k] = P1[n]; }
#pragma unroll
                    for (int k = 0; k < 8; ++k) { const int n = t_ + 512 * (k0 + k); float2 r = d[fsw(n)]; r.x *= (1.0f / SEQ); r.y *= (1.0f / SEQ);
                        r = cmul(r, make_float2(om[k].x, -om[k].y));
                        W0[n] = 0.5f * (p1[k].x + r.x) + bias * w0[k]; W1[n] = 0.5f * (p1[k].y + r.y) + bias * w1[k]; }
                } } }
            __syncthreads();
        }
    }
}

__global__ void __launch_bounds__(512, 2) mega(Params p) {
    extern __shared__ __attribute__((aligned(16))) unsigned char lds[];
    cg::grid_group grid = cg::this_grid();
    const int tid = threadIdx.x, G = gridDim.x, bx = blockIdx.x;
    float* ldsf = (float*)lds;
    LAS unsigned char* ldsl = (LAS unsigned char*)lds;
    const int lo = p.ph_lo, hi = p.ph_hi;
    if (p.ph_hi > 1000) grid.sync();
    if (tid < 4) ((unsigned*)(lds + LDS_MAIN))[tid] = 0u;
    __syncthreads();
    XcdBarrier xbar = xcd_barrier_post((unsigned*)(p.ws + WS_BAR), (volatile XB_LAS unsigned*)(ldsl + LDS_MAIN));
#define mod ((const float*)(p.ws + WS_MOD))
#define U ((u16*)(p.ws + WS_U))
#define HID ((u16*)(p.ws + WS_R2))
#define HCTX ((float*)(p.ws + WS_HCTX))
#ifndef PHMASK
#define PHMASK 0xFFFF
#endif
#define IN(k) (((PHMASK >> (k)) & 1) && lo <= (k) && (k) < hi)
#ifndef PROBE_REP_MASK
#define PROBE_REP_MASK 0
#endif
#ifndef ATT_V1
#define ATT_V1 0
#endif
#ifndef PROBE_FFT
#define PROBE_FFT 0
#endif
#ifndef PROBE_SYNC
#define PROBE_SYNC 0
#endif
#define REPS(k) _Pragma("nounroll") for (int rep_ = 0; rep_ < 1 + ((PROBE_REP_MASK >> (k)) & 1); ++rep_)
#define SYNC(k) do { if (lo <= (k) && (k) + 1 < hi) { xcd_barrier(xbar); } } while (0)
    if (IN(0)) REPS(0) phase_prep(p, ldsf, tid, G, bx);
    SYNC(0);
    if (IN(1)) REPS(1) { adaln_rows(p, p.x, p.ctx, 0, MROWS, 0, 0, 1, U, HCTX, tid, G, bx); hfilt_items(p, ldsf, tid, G, bx); }
    SYNC(1);
    if (IN(2)) { pg8::Gemm g{U, (const u16*)(p.ws + WS_WB0), MROWS, 2 * FF, DM, DM}; pg8::StaticOrder S; S.init(MROWS, 2 * FF, G, bx); S.dsh = (PROBE_REP_MASK >> 2) & 1; EpiSwiGLU E{HID};
        pg8::gemm_phase<EpiSwiGLU, pg8::StaticOrder>(ldsl, g, S, E, nullptr); }
    SYNC(2);
    if (IN(3)) { pg8::Gemm g{HID, (const u16*)(p.ws + WS_WD0), NLAT, DM, FF, FF}; pg8::StaticOrder S; S.init(NLAT, DM, G, bx); S.dsh = (PROBE_REP_MASK >> 3) & 1; EpiResid E{p.x, p.ctx, p.out, HCTX, mod, 2, 0.5f};
        pg8::gemm_phase<EpiResid, pg8::StaticOrder>(ldsl, g, S, E, nullptr); }
    SYNC(3);
    if (IN(4)) { adaln_rows(p, p.out, HCTX, 0, NLAT, 1, 3, 4, U, nullptr, tid, G, bx);
        pg8::Gemm g{HID, (const u16*)(p.ws + WS_WD0), MROWS, DM, 256, FF}; CtxSplitOrder S{G, bx}; EpiCtxAtomic E{HCTX, mod, 2, 0.5f};
        pg8::gemm_phase<EpiCtxAtomic, CtxSplitOrder>(ldsl, g, S, E, nullptr); }
    SYNC(4);
    if (IN(5)) { pg8::Gemm g{U, (const u16*)(p.ws + WS_WIN), NLAT, DIN, DM, DM}; pg8::StaticOrder S; S.init(NLAT, DIN, G, bx); S.dsh = (PROBE_REP_MASK >> 5) & 1;
        EpiInProj E{(u16*)(p.ws + WS_R2 + R2_Z), (u16*)(p.ws + WS_R2 + R2_Q), (u16*)(p.ws + WS_R2 + R2_K), (u16*)(p.ws + WS_R2 + R2_V), (const float*)(p.ws + WS_ROPE)};
        pg8::gemm_phase<EpiInProj, pg8::StaticOrder>(ldsl, g, S, E, nullptr);
        adaln_rows(p, p.out, HCTX, NLAT, MROWS, 1, 3, 4, U, nullptr, tid, G, bx); }
    SYNC(5);
    if (IN(6)) { hy_t1(p, ldsf, tid, G, bx); key_norm_pass(p, tid, G, bx);
        pg8::Gemm g{U, (const u16*)(p.ws + WS_WIN), MROWS, DIN, DM, DM}; CtxKvOrder S{G, bx};
        EpiInProj E{(u16*)(p.ws + WS_R2 + R2_Z), (u16*)(p.ws + WS_R2 + R2_Q), (u16*)(p.ws + WS_R2 + R2_K), (u16*)(p.ws + WS_R2 + R2_V), (const float*)(p.ws + WS_ROPE)};
        pg8::gemm_phase<EpiInProj, CtxKvOrder>(ldsl, g, S, E, nullptr); }
    SYNC(6);
    if (IN(7)) {
#ifndef NO_ATT
        REPS(7) attn_phase(p, (char*)lds, ldsl, tid, G, bx);
#endif
#ifndef NO_FFT
#if PROBE_FFT
        hy_fft(p, (float2*)lds, tid, G, bx, true);
#endif
        hy_fft(p, (float2*)lds, tid, G, bx, false);
#endif
#if PROBE_SYNC
        for (int i_ = 0; i_ < 10; ++i_) grid.sync();
#endif
    }
    SYNC(7);
    if (IN(8)) REPS(8) hy_t2(p, ldsf, tid, G, bx);
    SYNC(8);
    if (IN(9)) { pg8::Gemm g{U, (const u16*)(p.ws + WS_WOUT), NLAT, DM, DM, DM}; pg8::StaticOrder S; S.init(NLAT, DM, G, bx); EpiResid E{p.out, p.out, p.out, p.out, mod, 5, 1.0f};
        pg8::gemm_phase<EpiResid, pg8::StaticOrder>(ldsl, g, S, E, nullptr); }
    SYNC(9);
    if (IN(10)) adaln_rows(p, p.out, HCTX, 0, NLAT, 2, 6, 7, U, nullptr, tid, G, bx);
    SYNC(10);
    if (IN(11)) { pg8::Gemm g{U, (const u16*)(p.ws + WS_WB1), NLAT, 2 * FF, DM, DM}; pg8::StaticOrder S; S.init(NLAT, 2 * FF, G, bx); S.dsh = (PROBE_REP_MASK >> 11) & 1; EpiSwiGLU E{HID};
        pg8::gemm_phase<EpiSwiGLU, pg8::StaticOrder>(ldsl, g, S, E, nullptr); }
    SYNC(11);
    if (IN(12)) { pg8::Gemm g{HID, (const u16*)(p.ws + WS_WD1), NLAT, DM, FF, FF}; pg8::StaticOrder S; S.init(NLAT, DM, G, bx); EpiResid E{p.out, p.out, p.out, p.out, mod, 8, 0.5f};
        pg8::gemm_phase<EpiResid, pg8::StaticOrder>(ldsl, g, S, E, nullptr); }
    SYNC(12);
    if (IN(13)) final_norm(p, tid, G, bx);
#undef IN
#undef SYNC
#undef mod
#undef U
#undef HID
#undef HCTX
}

extern "C" void kernel_launch(void* const* d_in, const int* in_sizes, int n_in, void* d_out, int out_size, void* d_ws, size_t ws_size, hipStream_t stream) {
    static int grid = 0;
    if (grid == 0) {
        if (n_in != 24 || ws_size < WS_END) { fprintf(stderr, "kernel_launch: n_in %d ws %zu (need %zu)\n", n_in, ws_size, (size_t)WS_END); grid = -1; return; }
        int dev = 0, cus = 0, per_cu = 0;
        hipGetDevice(&dev); hipDeviceGetAttribute(&cus, hipDeviceAttributeMultiprocessorCount, dev);
        if (hipFuncSetAttribute((const void*)mega, hipFuncAttributeMaxDynamicSharedMemorySize, LDS_BYTES) != hipSuccess) { fprintf(stderr, "kernel_launch: hipFuncSetAttribute failed\n"); grid = -1; return; }
        if (hipOccupancyMaxActiveBlocksPerMultiprocessor(&per_cu, (const void*)mega, 512, LDS_BYTES) != hipSuccess || per_cu < 1) { fprintf(stderr, "kernel_launch: occupancy query gives %d\n", per_cu); per_cu = 1; }
        (void)hipGetLastError();
        grid = cus * per_cu; if (grid > 256) grid = 256;
    }
    if (grid < 0) return;
    Params p{};
    const float** pp = (const float**)&p;
    for (int i = 0; i < 24; ++i) pp[i] = (const float*)d_in[i];
    p.out = (float*)d_out; p.ws = (unsigned char*)d_ws;
#if MULTI_LAUNCH
    for (int ph = 0; ph < NPHASE; ++ph) { p.ph_lo = ph; p.ph_hi = ph + 1; hipLaunchKernelGGL(mega, dim3(grid), dim3(512), LDS_BYTES, stream, p); }
#else
    p.ph_lo = 0; p.ph_hi = NPHASE;
    if (hipMemsetAsync((char*)d_ws + WS_BAR, 0, (size_t)XCD_BAR_WORDS * 4, stream) != hipSuccess) { fprintf(stderr, "kernel_launch: memset failed\n"); return; }
    void* args[] = {&p};
    hipError_t e = hipLaunchCooperativeKernel((const void*)mega, dim3(grid), dim3(512), args, LDS_BYTES, stream);
    if (e != hipSuccess) fprintf(stderr, "cooperative launch failed: %s (grid %d)\n", hipGetErrorString(e), grid);
#endif
}
```

```cpp
#include <hip/hip_runtime.h>
#include <hip/hip_cooperative_groups.h>
#include <cstdio>
#include <cstdint>
namespace cg = cooperative_groups;
#define ATT_V4 1
namespace pg8 {
#define PG8_LAS __attribute__((address_space(3)))
typedef unsigned short bf16_t;
typedef short bf16x8 __attribute__((ext_vector_type(8)));
typedef float f32x4 __attribute__((ext_vector_type(4)));
typedef unsigned u32x4 __attribute__((ext_vector_type(4)));
constexpr int BM = 256, BK = 64, HALF = 128, HTB = HALF * BK * 2  , STAGE_BYTES = 8 * HTB, NXCD = 8, WGM = 8;

__host__ __device__ __forceinline__ int lds_byte(int r, int c) { const int st = (r >> 4) * 2 + (c >> 5), rr = r & 15, cc = c & 31, ob = rr * 64 + cc * 2; return st * 1024 + (ob ^ (((ob >> 9) & 1) << 5)); }
__host__ __device__ __forceinline__ void stage_rc(int b, int& R, int& C) { const int st = b / 1024, sb = b % 1024, swz = sb ^ (((sb >> 9) & 1) << 5); R = (st >> 1) * 16 + swz / 64; C = (st & 1) * 32 + (swz % 64) / 2; }
__host__ __device__ __forceinline__ int perm32(int rho) { const int n = rho >> 4, i = rho & 15; return 8 * (i >> 2) + 4 * n + (i & 3); }

struct Unit { int pm, pn, ko; };
struct Gemm { const bf16_t* A; const bf16_t* Bt; int M, N, K, ld; };

struct StaticOrder {
    int nM, nN, nwg, G, c, dsh;
    __host__ __device__ void init(int M, int N, int G_, int c_) { nM = M / BM; nN = N / BM; nwg = nM * nN; G = G_; c = c_; dsh = 0; }
    __host__ __device__ bool next(int i, Unit& u) const {
        const long L = (long)(i >> dsh) * G + c; if (L >= nwg) return false;
        int wgid = (int)L; { const int q = nwg / NXCD, r = nwg % NXCD, xcd = wgid % NXCD, off = wgid / NXCD; wgid = (xcd < r ? xcd * (q + 1) : r * (q + 1) + (xcd - r) * q) + off; }
        const int nig = WGM * nN, gid = wgid / nig, fm = gid * WGM, gsz = (nM - fm) < WGM ? (nM - fm) : WGM;
        u.pm = fm + ((wgid % nig) % gsz); u.pn = (wgid % nig) / gsz; u.ko = 0; return true;
    }
    __device__ __forceinline__ void a_ready(const Unit&) const {}
    __device__ __forceinline__ void done(const Unit&) const {}
};
__device__ __forceinline__ unsigned cvt_pk_bf16(float lo, float hi) { unsigned r; asm volatile("v_cvt_pk_bf16_f32 %0, %1, %2" : "=v"(r) : "v"(lo), "v"(hi)); return r; }
typedef float f32x2 __attribute__((ext_vector_type(2)));
template <class Epi, class Sched, bool STAMP = false>
__device__ __forceinline__ void gemm_phase(PG8_LAS unsigned char* lds, const Gemm g, const Sched& S, const Epi& E, unsigned long long* stamps) {
    const int tid = threadIdx.x, wid = __builtin_amdgcn_readfirstlane(tid >> 6), lane = tid & 63, wr = wid >> 2, wc = wid & 3, fr = lane & 15, fq = lane >> 4;
    const int K = g.K, nt = K / BK;
    int ts_lo = 0, ts_hi = 0, nts = 0; const unsigned long long rt_entry = STAMP ? (unsigned long long)wall_clock64() : 0ull;
#define PG8_STAMP() do { if (STAMP && wid == 0 && nts < 64) { const unsigned long long _c = (unsigned long long)clock64(); \
        ts_lo = (lane == nts) ? (int)(unsigned)_c : ts_lo; ts_hi = (lane == nts) ? (int)(unsigned)(_c >> 32) : ts_hi; ++nts; } } while (0)
    PG8_STAMP();
    unsigned voffA[2], voffB[2];
#pragma unroll
    for (int i = 0; i < 2; ++i) { int R, C; stage_rc(tid * 16 + i * 8192, R, C); const int Rb = Epi::PERM ? ((R & ~31) + perm32(R & 31)) : R;
        voffA[i] = (unsigned)(R * g.ld + C) * 2u; voffB[i] = (unsigned)(Rb * g.ld + C) * 2u; }
    const size_t kstep = (size_t)(BK * 2);
    const size_t hstep = (size_t)HALF * g.ld * 2;
    const size_t tstep = 2 * hstep;
    const unsigned ldsw = (unsigned)wid * 1024u;
    const int aoff = lds_byte(wr * 64 + fr, fq * 8), boff = lds_byte(wc * 32 + fr, fq * 8);
#define PG8_SA(b, h) (((b) * 2 + (h)) * HTB)
#define PG8_SB(b, h) ((4 + (b) * 2 + (h)) * HTB)
#define PG8_STAGE(bufoff, gbase, voff) do { _Pragma("unroll") for (int _i = 0; _i < 2; ++_i) \
        __builtin_amdgcn_global_load_lds((const unsigned*)((const char*)(gbase) + (voff)[_i]), (PG8_LAS unsigned*)(lds + (bufoff) + ldsw + _i * 8192), 16, 0, 0); } while (0)
#define PG8_LDA(dst, b, h) do { _Pragma("unroll") for (int m = 0; m < 4; ++m) _Pragma("unroll") for (int k = 0; k < 2; ++k) dst[m][k] = *(const PG8_LAS bf16x8*)(lds + PG8_SA(b, h) + aoff + m * 2048 + k * 1024); } while (0)
#define PG8_LDB(dst, b, h) do { _Pragma("unroll") for (int n = 0; n < 2; ++n) _Pragma("unroll") for (int k = 0; k < 2; ++k) dst[n][k] = *(const PG8_LAS bf16x8*)(lds + PG8_SB(b, h) + boff + n * 2048 + k * 1024); } while (0)
#define PG8_MMA(ai, bj, At, Bt) do { __builtin_amdgcn_s_setprio(1); _Pragma("unroll") for (int m = 0; m < 4; ++m) _Pragma("unroll") for (int n = 0; n < 2; ++n) _Pragma("unroll") for (int k = 0; k < 2; ++k) \
        acc[ai][bj][m][n] = __builtin_amdgcn_mfma_f32_16x16x32_bf16(Bt[n][k], At[m][k], acc[ai][bj][m][n], 0, 0, 0); __builtin_amdgcn_s_setprio(0); } while (0)
#define PG8_WAIT_V(n) asm volatile("s_waitcnt vmcnt(" #n ")" ::: "memory")
#define PG8_WAIT_L(n) asm volatile("s_waitcnt lgkmcnt(" #n ")" ::: "memory")
#define PG8_BAR __builtin_amdgcn_s_barrier()
#define PG8_SCHED __builtin_amdgcn_sched_barrier(0)
    Unit cur, nxt; int ui = 0;
    if (!S.next(0, cur)) return;
    f32x4 acc[2][2][4][2];
#pragma unroll
    for (int a = 0; a < 2; ++a)
#pragma unroll
        for (int b = 0; b < 2; ++b)
#pragma unroll
            for (int m = 0; m < 4; ++m)
#pragma unroll
                for (int n = 0; n < 2; ++n) acc[a][b][m][n] = (f32x4){0.f, 0.f, 0.f, 0.f};
    bf16x8 At[4][2], B0[2][2], B1[2][2];
    const char* cA = (const char*)g.A + (size_t)cur.pm * tstep + cur.ko; const char* cB = (const char*)g.Bt + (size_t)cur.pn * tstep + cur.ko;
    S.a_ready(cur);
    PG8_STAGE(PG8_SB(0, 0), cB, voffB); PG8_STAGE(PG8_SA(0, 0), cA, voffA); PG8_STAGE(PG8_SB(0, 1), cB + hstep, voffB); PG8_STAGE(PG8_SA(0, 1), cA + hstep, voffA);
    if (wr == 1) PG8_BAR;
    PG8_WAIT_V(4); PG8_BAR;
    PG8_STAGE(PG8_SB(1, 0), cB + kstep, voffB); PG8_STAGE(PG8_SA(1, 0), cA + kstep, voffA); PG8_STAGE(PG8_SB(1, 1), cB + hstep + kstep, voffB);
    PG8_WAIT_V(6); PG8_BAR;
    PG8_STAMP();
    for (;;) {
        const bool has_next = S.next(ui + 1, nxt);
        const char* nA = has_next ? (const char*)g.A + (size_t)nxt.pm * tstep + nxt.ko : cA; const char* nB = has_next ? (const char*)g.Bt + (size_t)nxt.pn * tstep + nxt.ko : cB;
        for (int t = 0; t < nt; t += 2) {
            const bool last = (t == nt - 2);
            const char* a1 = cA + (size_t)(t + 1) * kstep;
            const char* a2 = last ? nA : cA + (size_t)(t + 2) * kstep; const char* b2 = last ? nB : cB + (size_t)(t + 2) * kstep;
            const char* a3 = a2 + kstep; const char* b3 = b2 + kstep;
            if (last && has_next) S.a_ready(nxt);
            PG8_LDB(B0, 0, 0); PG8_SCHED; PG8_LDA(At, 0, 0); PG8_STAGE(PG8_SA(1, 1), a1 + hstep, voffA);
            PG8_WAIT_L(8); PG8_BAR; PG8_WAIT_L(0); PG8_MMA(0, 0, At, B0); PG8_BAR; PG8_SCHED;
            PG8_LDB(B1, 0, 1); PG8_STAGE(PG8_SB(0, 0), b2, voffB);
            PG8_BAR; PG8_WAIT_L(0); PG8_MMA(0, 1, At, B1); PG8_BAR;
            PG8_LDA(At, 0, 1); PG8_STAGE(PG8_SA(0, 0), a2, voffA);
            PG8_BAR; PG8_WAIT_L(0); PG8_MMA(1, 0, At, B0); PG8_BAR; PG8_SCHED;
            PG8_STAGE(PG8_SB(0, 1), b2 + hstep, voffB);
            PG8_WAIT_V(6); PG8_BAR; PG8_MMA(1, 1, At, B1); PG8_BAR;
            PG8_LDB(B0, 1, 0); PG8_SCHED; PG8_LDA(At, 1, 0); PG8_STAGE(PG8_SA(0, 1), a2 + hstep, voffA);
            PG8_WAIT_L(8); PG8_BAR; PG8_WAIT_L(0); PG8_MMA(0, 0, At, B0); PG8_BAR; PG8_SCHED;
            PG8_LDB(B1, 1, 1); PG8_STAGE(PG8_SB(1, 0), b3, voffB);
            PG8_BAR; PG8_WAIT_L(0); PG8_MMA(0, 1, At, B1); PG8_BAR;
            PG8_LDA(At, 1, 1); PG8_STAGE(PG8_SA(1, 0), a3, voffA);
            PG8_BAR; PG8_WAIT_L(0); PG8_MMA(1, 0, At, B0); PG8_BAR; PG8_SCHED;
            PG8_STAGE(PG8_SB(1, 1), b3 + hstep, voffB);
            PG8_WAIT_V(6); PG8_BAR; PG8_MMA(1, 1, At, B1); PG8_BAR;
        }
        PG8_STAMP();
        if constexpr (!Epi::AFTER_DRAIN) { E(acc, cur, wr, wc, fr, fq); S.done(cur); }
        PG8_STAMP();
        if (!has_next) break;
#pragma unroll
        for (int a = 0; a < 2; ++a)
#pragma unroll
            for (int b = 0; b < 2; ++b)
#pragma unroll
                for (int m = 0; m < 4; ++m)
#pragma unroll
                    for (int n = 0; n < 2; ++n) acc[a][b][m][n] = (f32x4){0.f, 0.f, 0.f, 0.f};
        cur = nxt; cA = nA; cB = nB; ++ui;
    }
    PG8_WAIT_V(0);
    if (wr == 0) PG8_BAR;
    PG8_BAR;
    if constexpr (Epi::AFTER_DRAIN) { E.fused(acc, cur, wr, wc, fr, fq, lds, wid, lane); S.done(cur); }
    PG8_STAMP();
    if (STAMP && wid == 0) { stamps[lane] = lane < nts ? (((unsigned long long)(unsigned)ts_hi << 32) | (unsigned)ts_lo) : 0ull;
        if (lane == 62) stamps[62] = rt_entry; if (lane == 63) stamps[63] = (unsigned long long)wall_clock64(); }
#undef PG8_STAMP
#undef PG8_SA
#undef PG8_SB
#undef PG8_STAGE
#undef PG8_LDA
#undef PG8_LDB
#undef PG8_MMA
#undef PG8_WAIT_V
#undef PG8_WAIT_L
#undef PG8_BAR
#undef PG8_SCHED
}
}
#define XB_LAS __attribute__((address_space(3)))

#define XB_TMO      128
#define XB_XCNT(j)  (256  + 64 * (j))
#define XB_XSUB(j)  (1280 + 64 * (j))
#define XB_XGEN(j)  (2304 + 64 * (j))
#define XB_TOP      3328
#define XB_TOPGEN   3392
#define XCD_BAR_WORDS 3456
#define XB_SPIN_CAP (1u << 18)

__device__ __forceinline__ unsigned xb_ld(unsigned* p)              { return __hip_atomic_load(p, __ATOMIC_RELAXED, __HIP_MEMORY_SCOPE_AGENT); }
__device__ __forceinline__ unsigned xb_add(unsigned* p, unsigned v) { return __hip_atomic_fetch_add(p, v, __ATOMIC_RELAXED, __HIP_MEMORY_SCOPE_AGENT); }
__device__ __forceinline__ unsigned xb_xcc_id() { return (unsigned)__builtin_amdgcn_s_getreg((3 << 11) | 20) & 0xFu; }
#define XB_SPIN(cond, bar) do { unsigned _sp = 0; while (cond) { __builtin_amdgcn_s_sleep(1); \
    if ((++_sp & 255u) == 0u) { if (xb_ld(&(bar)[XB_TMO])) break; if (_sp > XB_SPIN_CAP) { atomicAdd(&(bar)[XB_TMO], 1u); break; } } } } while (0)

struct XcdBarrier {
    unsigned* bar; unsigned x;
    volatile XB_LAS unsigned* st;
};

__device__ __forceinline__ XcdBarrier xcd_barrier_post(unsigned* bar, volatile XB_LAS unsigned* st) {
    XcdBarrier b; b.bar = bar; b.x = xb_xcc_id(); b.st = st;
    if (threadIdx.x == 0) (void)xb_add(&bar[XB_XCNT(b.x)], 1u);
    return b;
}
__device__ __forceinline__ void xcd_barrier_complete(unsigned* bar, unsigned x, unsigned& nloc, unsigned& nx) {
    const unsigned G = gridDim.x * gridDim.y * gridDim.z;
    unsigned sum, cnt, mine, sp = 0u;
    for (;;) {
        sum = 0u; cnt = 0u; mine = 0u;
#pragma unroll
        for (unsigned j = 0; j < 16; ++j) { const unsigned c = xb_ld(&bar[XB_XCNT(j)]); sum += c; cnt += (c > 0u) ? 1u : 0u; mine = (j == x) ? c : mine; }
        if (sum == G) break;
        __builtin_amdgcn_s_sleep(1);
        if ((++sp & 255u) == 0u) { if (xb_ld(&bar[XB_TMO])) break; if (sp > XB_SPIN_CAP) { atomicAdd(&bar[XB_TMO], 1u); break; } }
    }
    nloc = mine > 0u ? mine : 1u; nx = cnt > 0u ? cnt : 1u;
}

__device__ __forceinline__ void xcd_barrier(const XcdBarrier& b) {
    asm volatile("s_waitcnt vmcnt(0)" ::: "memory");
    __syncthreads();
    if (threadIdx.x == 0) {
        unsigned* bar = b.bar;
        __builtin_amdgcn_s_waitcnt(0);
        unsigned nloc = b.st[0], nx = b.st[1];
        if (nloc == 0u) { xcd_barrier_complete(bar, b.x, nloc, nx); b.st[0] = nloc; b.st[1] = nx; }
        const unsigned old = xb_add(&bar[XB_XSUB(b.x)], 1u);
        const unsigned gen = old / nloc;
        if (old + 1u == (gen + 1u) * nloc) {
            __builtin_amdgcn_fence(__ATOMIC_RELEASE, "agent");
            asm volatile("s_waitcnt vmcnt(0)" ::: "memory");
            const unsigned og = xb_add(&bar[XB_TOP], 1u);
            const unsigned tg = og / nx;
            if (og + 1u == (tg + 1u) * nx) xb_add(&bar[XB_TOPGEN], 1u);
            else XB_SPIN(xb_ld(&bar[XB_TOPGEN]) == tg, bar);
            __builtin_amdgcn_fence(__ATOMIC_ACQUIRE, "agent");
            xb_add(&bar[XB_XGEN(b.x)], 1u);
            asm volatile("s_waitcnt vmcnt(0)" ::: "memory");
        } else {
            XB_SPIN(xb_ld(&bar[XB_XGEN(b.x)]) == gen, bar);
            __builtin_amdgcn_fence(__ATOMIC_ACQUIRE, "agent");
            asm volatile("s_waitcnt vmcnt(0)" ::: "memory");
        }
    }
    __syncthreads();
}


using pg8::f32x4; using pg8::bf16x8; using pg8::u32x4; using pg8::Unit;
typedef unsigned short u16;
#define LAS PG8_LAS
constexpr int DM = 1024, SEQ = 16384, CTXL = 256, NLAT = 2 * SEQ, NCTX = 2 * CTXL, MROWS = NLAT + NCTX;
constexpr int FF = 2816, DIN = 3072, NKEY = SEQ + CTXL, NADA = 9 * DM;
constexpr int LDS_MAIN = 150528;
constexpr int LDS_BYTES = LDS_MAIN + 16;
#ifndef MULTI_LAUNCH
#define MULTI_LAUNCH 0
#endif
constexpr int NPHASE = 14;

constexpr size_t al256(size_t x) { return (x + 255) / 256 * 256; }
constexpr size_t WS_WB0 = 0;
constexpr size_t WS_WD0 = WS_WB0 + al256((size_t)2 * FF * DM * 2);
constexpr size_t WS_WB1 = WS_WD0 + al256((size_t)DM * FF * 2);
constexpr size_t WS_WD1 = WS_WB1 + al256((size_t)2 * FF * DM * 2);
constexpr size_t WS_WIN = WS_WD1 + al256((size_t)DM * FF * 2);
constexpr size_t WS_WOUT = WS_WIN + al256((size_t)DIN * DM * 2);
constexpr size_t WS_MOD = WS_WOUT + al256((size_t)DM * DM * 2);
constexpr size_t WS_ROPE = WS_MOD + al256((size_t)3 * NADA * 4);
constexpr size_t WS_TW = WS_ROPE + al256((size_t)256 * 16 * 8);
constexpr size_t WS_OM = WS_TW + al256((size_t)4096 * 8);
constexpr size_t WS_H3 = WS_OM + al256((size_t)SEQ * 8);
constexpr size_t WS_HFILT = WS_H3 + al256((size_t)SEQ * 64 * 4);
constexpr size_t WS_HCTX = WS_HFILT + al256((size_t)1024 * SEQ * 2);
constexpr size_t WS_U = WS_HCTX + al256((size_t)NCTX * DM * 4);
constexpr size_t WS_R2 = WS_U + al256((size_t)MROWS * DM * 2);
constexpr size_t R2_Z = 0, R2_Q = R2_Z + (size_t)NLAT * 1536 * 2, R2_K = R2_Q + (size_t)NLAT * 512 * 2, R2_V = R2_K + (size_t)2 * NKEY * 512 * 2, R2_END = R2_V + (size_t)2 * NKEY * 512 * 2;
constexpr size_t R2_SIZE = R2_END > (size_t)MROWS * FF * 2 ? R2_END : (size_t)MROWS * FF * 2;
constexpr size_t WS_W = WS_R2 + al256(R2_SIZE);
constexpr size_t WS_SCR = WS_W + al256((size_t)512 * 2 * SEQ * 4);
constexpr size_t WS_BAR = WS_SCR + (size_t)256 * 262144;
constexpr size_t WS_KN2 = WS_BAR + al256((size_t)XCD_BAR_WORDS * 4);
constexpr size_t WS_END = WS_KN2 + 256;

struct Params {
    const float *x, *c, *ctx, *c_ctx, *ada_w, *ada_b, *norm_g, *w_gate, *w_up, *w_down, *w_in, *w_out, *conv_w, *conv_b, *f_w1, *f_b1, *f_wi, *f_bi, *f_freq, *f_wout, *hy_bias, *lam, *subln_g, *final_g;
    float* out; unsigned char* ws; int ph_lo, ph_hi;
};

__device__ __forceinline__ float bf2f(u16 b) { return __uint_as_float(((unsigned)b) << 16); }
__device__ __forceinline__ u16 f2bf(float f) { unsigned u = __float_as_uint(f); u += 0x7FFFu + ((u >> 16) & 1u); return (u16)(u >> 16); }
__device__ __forceinline__ unsigned pk2(float lo, float hi) { return pg8::cvt_pk_bf16(lo, hi); }
__device__ __forceinline__ float2 cmul(float2 a, float2 b) { return make_float2(a.x * b.x - a.y * b.y, a.x * b.y + a.y * b.x); }
__device__ __forceinline__ float silu_f(float v) { return v * __builtin_amdgcn_rcpf(1.0f + __builtin_amdgcn_exp2f(-1.4426950408889634f * v)); }

__device__ __forceinline__ void transpose_tile(const float* __restrict__ src, u16* __restrict__ dst, int K, int N, int mode, int tile, float* ldsf, int tid) {
    const int ntn = N >> 6, tk = tile / ntn, tn = tile - tk * ntn, k0 = tk * 64, n0 = tn * 64;
#pragma unroll
    for (int i = 0; i < 8; ++i) { const int k = (tid >> 6) + 8 * i, n = tid & 63; ldsf[k * 65 + n] = src[(size_t)(k0 + k) * N + n0 + n]; }
    __syncthreads();
    const int nl = tid >> 3, ks = (tid & 7) * 8;
    float v[8];
#pragma unroll
    for (int j = 0; j < 8; ++j) v[j] = ldsf[(ks + j) * 65 + nl];
    const int nn = n0 + nl;
    const int row = mode == 0 ? nn : ((nn >> 7) * 256 + (nn & 127) + (mode == 2 ? 128 : 0));
    u32x4 w; w.x = pk2(v[0], v[1]); w.y = pk2(v[2], v[3]); w.z = pk2(v[4], v[5]); w.w = pk2(v[6], v[7]);
    *(u32x4*)(dst + (size_t)row * K + k0 + ks) = w;
    __syncthreads();
}

__device__ __forceinline__ void mod_item(const Params& p, int item, float* ldsf, int tid_) {
    int tid = tid_; asm volatile("" : "+v"(tid));
    const int wave = tid >> 6, lane = tid & 63, col = item * 64 + lane;
    float a0 = 0.f, a1 = 0.f, a2 = 0.f;
    const float* aw = p.ada_w + (size_t)(wave * 128) * NADA + col;
#pragma unroll 16
    for (int k = 0; k < 128; ++k) {
        const int kk = wave * 128 + k;
        const float w = aw[(size_t)k * NADA];
        a0 += silu_f(p.c[kk]) * w; a1 += silu_f(p.c[DM + kk]) * w; a2 += silu_f(p.c_ctx[kk]) * w;
    }
    ldsf[(wave * 3 + 0) * 64 + lane] = a0; ldsf[(wave * 3 + 1) * 64 + lane] = a1; ldsf[(wave * 3 + 2) * 64 + lane] = a2;
    __syncthreads();
    if (tid < 192) { const int v = tid >> 6; float s = p.ada_b[col];
#pragma unroll
        for (int w = 0; w < 8; ++w) s += ldsf[(w * 3 + v) * 64 + lane];
        ((float*)(p.ws + WS_MOD))[v * NADA + col] = s; }
    __syncthreads();
}

__device__ __forceinline__ void filt_block(const Params& p, int blk, float* ldsf, int tid_) {
    int tid = tid_; asm volatile("" : "+v"(tid));
    const int wave = tid >> 6, lane = tid & 63, n0 = (blk * 8 + wave) * 8;
    float* hb = ldsf + wave * 512;
#pragma unroll 1
    for (int q = 0; q < 8; ++q) { const int n = n0 + q;
        const float t = (float)n / (float)(SEQ - 1);
        const float omega = (2.0f * 3.14159265358979323846f / (float)SEQ) * (float)n;
        if (lane == 0) hb[q * 64] = t;
        if (lane < 32) { const int k = lane & 15; const float band = 1e-4f + (15.0f - 1e-4f) * (float)k / 15.0f; const float ang = omega * band;
            hb[q * 64 + 1 + lane] = lane < 16 ? cosf(ang) : -sinf(ang); } }
    __syncthreads();
    const float fr = p.f_freq[lane];
    float acc[8], h[8];
#pragma unroll
    for (int q = 0; q < 8; ++q) acc[q] = p.f_b1[lane];
    for (int i = 0; i < 33; ++i) { const float w = p.f_w1[i * 64 + lane];
#pragma unroll
        for (int q = 0; q < 8; ++q) acc[q] += hb[q * 64 + i] * w; }
#pragma unroll
    for (int q = 0; q < 8; ++q) h[q] = __sinf(fr * acc[q]);
    __syncthreads();
    for (int l = 0; l < 2; ++l) {
#pragma unroll
        for (int q = 0; q < 8; ++q) hb[q * 64 + lane] = h[q];
        __syncthreads();
        const float* wi = p.f_wi + l * 4096;
#pragma unroll
        for (int q = 0; q < 8; ++q) acc[q] = p.f_bi[l * 64 + lane];
#pragma unroll 4
        for (int i = 0; i < 64; ++i) { const float w = wi[i * 64 + lane];
#pragma unroll
            for (int q = 0; q < 8; ++q) acc[q] += hb[q * 64 + i] * w; }
#pragma unroll
        for (int q = 0; q < 8; ++q) h[q] = __sinf(fr * acc[q]);
        __syncthreads();
    }
#pragma unroll
    for (int q = 0; q < 8; ++q) ((float*)(p.ws + WS_H3))[(n0 + q) * 64 + lane] = h[q];
}

__device__ __forceinline__ void tr_decode(const Params& p, int t, const float*& src, u16*& dst, int& K, int& N, int& mode, int& k0, int& n0) {
    if (t < 2816) { const int mm = t / 704; t -= mm * 704; const int layer = mm >> 1; K = DM; N = FF; mode = 1 + (mm & 1);
        src = ((mm & 1) ? p.w_up : p.w_gate) + (size_t)layer * DM * FF; dst = (u16*)(p.ws + (layer ? WS_WB1 : WS_WB0)); }
    else if (t < 4224) { t -= 2816; const int layer = t / 704; t -= layer * 704; K = FF; N = DM; mode = 0; src = p.w_down + (size_t)layer * FF * DM; dst = (u16*)(p.ws + (layer ? WS_WD1 : WS_WD0)); }
    else if (t < 4992) { t -= 4224; K = DM; N = DIN; mode = 0; src = p.w_in; dst = (u16*)(p.ws + WS_WIN); }
    else { t -= 4992; K = DM; N = DM; mode = 0; src = p.w_out; dst = (u16*)(p.ws + WS_WOUT); }
    const int ntn = N >> 6, tk = t / ntn, tn = t - tk * ntn; k0 = tk * 64; n0 = tn * 64;
}
__device__ __forceinline__ void transpose_all(const Params& p, float* ldsf, int tid_, int G, int bx) {
    int tid = tid_; asm volatile("" : "+v"(tid));
    constexpr int NTILE = 5248, BUF = 64 * 65;
    float va[8], vb[8];
#define TR_LOAD(v, t_) do { const float* s_; u16* d_; int K_, N_, m_, k0_, n0_; tr_decode(p, (t_), s_, d_, K_, N_, m_, k0_, n0_);               \
        _Pragma("unroll") for (int i = 0; i < 8; ++i) v[i] = s_[(size_t)(k0_ + (tid >> 6) + 8 * i) * N_ + n0_ + (tid & 63)]; } while (0)
#define TR_EMIT(v, t_, buf_) do { float* lb_ = ldsf + (buf_) * BUF;                                                                            \
        _Pragma("unroll") for (int i = 0; i < 8; ++i) lb_[((tid >> 6) + 8 * i) * 65 + (tid & 63)] = v[i];                                      \
        __syncthreads();                                                                                                                        \
        if ((t_) + 2 * G < NTILE) TR_LOAD(v, (t_) + 2 * G);                                                                                     \
        { const float* s_; u16* d_; int K_, N_, m_, k0_, n0_; tr_decode(p, (t_), s_, d_, K_, N_, m_, k0_, n0_);                                 \
          const int nl = tid >> 3, ks = (tid & 7) * 8; float w_[8];                                                                             \
          _Pragma("unroll") for (int j = 0; j < 8; ++j) w_[j] = lb_[(ks + j) * 65 + nl];                                                        \
          const int nn = n0_ + nl; const int row = m_ == 0 ? nn : ((nn >> 7) * 256 + (nn & 127) + (m_ == 2 ? 128 : 0));                         \
          u32x4 o_; o_.x = pk2(w_[0], w_[1]); o_.y = pk2(w_[2], w_[3]); o_.z = pk2(w_[4], w_[5]); o_.w = pk2(w_[6], w_[7]);                      \
          *(u32x4*)(d_ + (size_t)row * K_ + k0_ + ks) = o_; } } while (0)
    int t = bx;
    if (t < NTILE) TR_LOAD(va, t);
    if (t + G < NTILE) TR_LOAD(vb, t + G);
    for (; t < NTILE; t += 2 * G) {
        TR_EMIT(va, t, 0);
        if (t + G < NTILE) TR_EMIT(vb, t + G, 1);
    }
    __syncthreads();
#undef TR_LOAD
#undef TR_EMIT
}
__device__ __forceinline__ void phase_prep(const Params& p, float* ldsf, int tid, int G, int bx) {
    if (bx == 0 && tid < 16) ((float*)(p.ws + WS_KN2))[tid] = 0.f;
    for (int it = bx; it < 144; it += G) mod_item(p, it, ldsf, tid);
    for (int it = bx; it < 256; it += G) filt_block(p, (it + 144) % 256, ldsf, tid);
    for (int it = bx; it < 8; it += G) { const int idx = it * 512 + tid, pos = idx >> 4, f = idx & 15;
        const float invf = powf(10000.0f, -(float)(2 * f) / 32.0f); float s, c; sincosf((float)pos * invf, &s, &c);
        ((float2*)(p.ws + WS_ROPE))[idx] = make_float2(c, s); }
    for (int it = bx; it < 40; it += G) {
        if (it < 8) { const int n = it * 512 + tid; float s, c; sincospif((float)n / 8192.0f, &s, &c); ((float2*)(p.ws + WS_TW))[n] = make_float2(c, -s); }
        else { const int n = (it - 8) * 512 + tid; float s, c; sincospif((float)n * (1.0f / SEQ), &s, &c); ((float2*)(p.ws + WS_OM))[n] = make_float2(c, -s); } }
    __syncthreads();
    transpose_all(p, ldsf, tid, G, bx);
}

__device__ __forceinline__ void adaln_rows(const Params& p, const float* lat, const float* ctxp, int rbeg, int nrows, int gi, int kshift, int kscale, u16* U, float* copy_ctx, int tid, int G, int bx) {
    const int wave = tid >> 6, lane = tid & 63;
    const float* g = p.norm_g + gi * DM; const float* mod = (const float*)(p.ws + WS_MOD);
    const int stride = G * 8;
    for (int r0 = rbeg + bx * 8 + wave; r0 < nrows; r0 += 4 * stride) {
        f32x4 v[4][4]; float ss[4] = {0.f, 0.f, 0.f, 0.f};
#pragma unroll
        for (int q = 0; q < 4; ++q) { const int r = r0 + q * stride; const int rr = r < nrows ? r : r0;
            const float* src = rr < NLAT ? lat + (size_t)rr * DM : ctxp + (size_t)(rr - NLAT) * DM;
#pragma unroll
            for (int i = 0; i < 4; ++i) v[q][i] = *(const f32x4*)(src + i * 256 + lane * 4); }
#pragma unroll
        for (int q = 0; q < 4; ++q) {
#pragma unroll
            for (int i = 0; i < 4; ++i) ss[q] += v[q][i][0] * v[q][i][0] + v[q][i][1] * v[q][i][1] + v[q][i][2] * v[q][i][2] + v[q][i][3] * v[q][i][3];
#pragma unroll
            for (int o = 32; o >= 1; o >>= 1) ss[q] += __shfl_xor(ss[q], o); }
#pragma unroll
        for (int q = 0; q < 4; ++q) { const int r = r0 + q * stride; if (r >= nrows) break;
            const int sel = r < NLAT ? (r >> 14) : 2;
            const float rs = rsqrtf(ss[q] * (1.0f / DM) + 1e-6f);
            const float* sh = mod + sel * NADA + kshift * DM; const float* sc = mod + sel * NADA + kscale * DM;
#pragma unroll
            for (int i = 0; i < 4; ++i) { const int c = i * 256 + lane * 4;
                const f32x4 gg = *(const f32x4*)(g + c), s4 = *(const f32x4*)(sh + c), c4 = *(const f32x4*)(sc + c);
                f32x4 y = v[q][i] * rs * gg * (c4 + 1.0f) + s4;
                uint2 w; w.x = pk2(y[0], y[1]); w.y = pk2(y[2], y[3]);
                *(uint2*)(U + (size_t)r * DM + c) = w;
                if (copy_ctx && r >= NLAT) *(f32x4*)(copy_ctx + (size_t)(r - NLAT) * DM + c) = v[q][i]; } }
    }
}
__device__ __forceinline__ void final_norm(const Params& p, int tid, int G, int bx) {
    const int wave = tid >> 6, lane = tid & 63, stride = G * 8;
    for (int r0 = bx * 8 + wave; r0 < NLAT; r0 += 4 * stride) {
        f32x4 v[4][4]; float ss[4] = {0.f, 0.f, 0.f, 0.f};
#pragma unroll
        for (int q = 0; q < 4; ++q) { const int r = r0 + q * stride < NLAT ? r0 + q * stride : r0; const float* src = p.out + (size_t)r * DM;
#pragma unroll
            for (int i = 0; i < 4; ++i) v[q][i] = *(const f32x4*)(src + i * 256 + lane * 4); }
#pragma unroll
        for (int q = 0; q < 4; ++q) {
#pragma unroll
            for (int i = 0; i < 4; ++i) ss[q] += v[q][i][0] * v[q][i][0] + v[q][i][1] * v[q][i][1] + v[q][i][2] * v[q][i][2] + v[q][i][3] * v[q][i][3];
#pragma unroll
            for (int o = 32; o >= 1; o >>= 1) ss[q] += __shfl_xor(ss[q], o); }
#pragma unroll
        for (int q = 0; q < 4; ++q) { const int r = r0 + q * stride; if (r >= NLAT) break;
            const float rs = rsqrtf(ss[q] * (1.0f / DM) + 1e-6f); float* dst = p.out + (size_t)r * DM;
#pragma unroll
            for (int i = 0; i < 4; ++i) { const int c = i * 256 + lane * 4; const f32x4 gg = *(const f32x4*)(p.final_g + c); *(f32x4*)(dst + c) = v[q][i] * rs * gg; } }
    }
}

__device__ __forceinline__ void hfilt_items(const Params& p, float* ldsf, int tid, int G, int bx) {
    const float* h3 = (const float*)(p.ws + WS_H3); u16* HF = (u16*)(p.ws + WS_HFILT);
    for (int it = bx; it < 512; it += G) {
        const int nblk = it >> 4, cch = it & 15, n = nblk * 512 + tid;
#pragma unroll
        for (int e = 0; e < 8; ++e) { const int idx = tid + e * 512, i = idx >> 6, cc = idx & 63; ldsf[cc * 64 + i] = p.f_wout[i * 1024 + cch * 64 + cc]; }
        f32x4 h[16];
#pragma unroll
        for (int i = 0; i < 16; ++i) h[i] = *(const f32x4*)(h3 + (size_t)n * 64 + i * 4);
        __syncthreads();
        const float t = (float)n / (float)(SEQ - 1);
        for (int cc = 0; cc < 64; ++cc) {
            float acc = 0.f;
#pragma unroll
            for (int i = 0; i < 16; ++i) { const f32x4 w = *(const f32x4*)(ldsf + cc * 64 + i * 4); acc += h[i][0] * w[0] + h[i][1] * w[1] + h[i][2] * w[2] + h[i][3] * w[3]; }
            const int cp = cch * 64 + cc, c = cp & 511;
            const float mind = -3.0701134573253944f, maxd = -15.350567286626972f;
            const float delta = fabsf(mind + (maxd - mind) * ((float)c / 511.0f));
            HF[(size_t)cp * SEQ + n] = f2bf(acc * __expf(-t * delta));
        }
        __syncthreads();
    }
}

struct EpiSwiGLU {
    static constexpr bool PERM = true, AFTER_DRAIN = false;
    u16* O;
    __device__ __forceinline__ void operator()(const f32x4 (&acc)[2][2][4][2], const Unit& u, int wr, int wc, int fr, int fq) const {
        const int row0 = u.pm * 256 + wr * 64 + fr, j0 = u.pn * 128 + wc * 32 + 8 * fq;
#pragma unroll
        for (int ai = 0; ai < 2; ++ai)
#pragma unroll
            for (int m = 0; m < 4; ++m) {
                const f32x4 g0 = acc[ai][0][m][0], g1 = acc[ai][0][m][1], u0 = acc[ai][1][m][0], u1 = acc[ai][1][m][1];
                float h[8];
#pragma unroll
                for (int j = 0; j < 4; ++j) { h[j] = silu_f(g0[j]) * u0[j]; h[4 + j] = silu_f(g1[j]) * u1[j]; }
                u32x4 w; w.x = pk2(h[0], h[1]); w.y = pk2(h[2], h[3]); w.z = pk2(h[4], h[5]); w.w = pk2(h[6], h[7]);
                *(u32x4*)(O + (size_t)(row0 + ai * 128 + m * 16) * FF + j0) = w;
            }
    }
};
struct EpiResid {
    static constexpr bool PERM = false, AFTER_DRAIN = false;
    const float* src_lat; const float* src_ctx; float* dst_lat; float* dst_ctx; const float* mod; int modk; float coef;
    __device__ __forceinline__ void operator()(const f32x4 (&acc)[2][2][4][2], const Unit& u, int wr, int wc, int fr, int fq) const {
        const bool isctx = u.pm >= 128; const int sel = isctx ? 2 : (u.pm >> 6);
        const size_t rb = (size_t)(isctx ? (u.pm - 128) : u.pm) * 256 * DM;
        const float* src = (isctx ? src_ctx : src_lat) + rb; float* dst = (isctx ? dst_ctx : dst_lat) + rb;
        const float* gv = mod + sel * NADA + modk * DM;
        const int col0 = u.pn * 256 + wc * 32 + 4 * fq, r0 = wr * 64 + fr;
#pragma unroll
        for (int bj = 0; bj < 2; ++bj)
#pragma unroll
            for (int n = 0; n < 2; ++n) {
                const int c = col0 + bj * 128 + n * 16;
                const f32x4 g4 = *(const f32x4*)(gv + c) * coef;
                f32x4 sv[2][4];
#pragma unroll
                for (int ai = 0; ai < 2; ++ai)
#pragma unroll
                    for (int m = 0; m < 4; ++m) sv[ai][m] = *(const f32x4*)(src + (size_t)(r0 + ai * 128 + m * 16) * DM + c);
#pragma unroll
                for (int ai = 0; ai < 2; ++ai)
#pragma unroll
                    for (int m = 0; m < 4; ++m) *(f32x4*)(dst + (size_t)(r0 + ai * 128 + m * 16) * DM + c) = sv[ai][m] + g4 * acc[ai][bj][m][n];
            }
    }
};
struct EpiInProj {
    static constexpr bool PERM = false, AFTER_DRAIN = false;
    u16 *Z, *Q, *K, *V; const float* rope;
    __device__ __forceinline__ void operator()(const f32x4 (&acc)[2][2][4][2], const Unit& u, int wr, int wc, int fr, int fq) const {
        const bool isctx = u.pm >= 128; const int pn = u.pn;
        if (isctx && pn < 8) return;
        const int rl0 = wr * 64 + fr;
        const int cl0 = wc * 32 + 4 * fq;
        if (pn < 6) {
#pragma unroll
            for (int ai = 0; ai < 2; ++ai)
#pragma unroll
                for (int m = 0; m < 4; ++m) { u16* rp = Z + (size_t)(u.pm * 256 + rl0 + ai * 128 + m * 16) * 1536 + pn * 256 + cl0;
#pragma unroll
                    for (int bj = 0; bj < 2; ++bj)
#pragma unroll
                        for (int n = 0; n < 2; ++n) { const f32x4 a = acc[ai][bj][m][n]; uint2 w; w.x = pk2(a[0], a[1]); w.y = pk2(a[2], a[3]); *(uint2*)(rp + bj * 128 + n * 16) = w; } }
            return;
        }
        const bool do_rope = (pn < 10) && !isctx;
        u16* base; size_t rowbase;
        if (pn < 8) { base = Q; rowbase = (size_t)u.pm * 256; }
        else { base = pn < 10 ? K : V; rowbase = isctx ? ((size_t)(u.pm - 128) * NKEY + SEQ) : ((size_t)(u.pm >> 6) * NKEY + (size_t)(u.pm & 63) * 256); }
        const int cbase = (pn & 1) * 256 + cl0;
        const int axis = wc & 1;
#pragma unroll
        for (int ai = 0; ai < 2; ++ai)
#pragma unroll
            for (int m = 0; m < 4; ++m) {
                const int rl = rl0 + ai * 128 + m * 16;
                u16* rp = base + (rowbase + rl) * 512 + cbase;
                f32x4 cs0 = {1.f, 0.f, 1.f, 0.f}, cs1 = {1.f, 0.f, 1.f, 0.f};
                if (do_rope) { const int t = (u.pm & 63) * 256 + rl; const int pos = axis ? (t & 63) : (t >> 6);
                    const float* rp2 = rope + (size_t)(pos * 16 + 4 * fq) * 2; cs0 = *(const f32x4*)rp2; cs1 = *(const f32x4*)(rp2 + 4); }
#pragma unroll
                for (int bj = 0; bj < 2; ++bj) {
                    const f32x4 x1 = acc[ai][bj][m][0], x2 = acc[ai][bj][m][1];
                    f32x4 o1, o2;
                    o1[0] = x1[0] * cs0[0] - x2[0] * cs0[1]; o2[0] = x2[0] * cs0[0] + x1[0] * cs0[1];
                    o1[1] = x1[1] * cs0[2] - x2[1] * cs0[3]; o2[1] = x2[1] * cs0[2] + x1[1] * cs0[3];
                    o1[2] = x1[2] * cs1[0] - x2[2] * cs1[1]; o2[2] = x2[2] * cs1[0] + x1[2] * cs1[1];
                    o1[3] = x1[3] * cs1[2] - x2[3] * cs1[3]; o2[3] = x2[3] * cs1[2] + x1[3] * cs1[3];
                    uint2 w; w.x = pk2(o1[0], o1[1]); w.y = pk2(o1[2], o1[3]); *(uint2*)(rp + bj * 128) = w;
                    w.x = pk2(o2[0], o2[1]); w.y = pk2(o2[2], o2[3]); *(uint2*)(rp + bj * 128 + 16) = w;
                }
            }
    }
};

struct CtxSplitOrder {
    int G, c;
    __device__ __forceinline__ bool next(int i, Unit& u) const { const int L = i * G + c; if (L >= 88) return false; u.pm = 128 + (L & 1); u.pn = (L >> 1) & 3; u.ko = (L >> 3) * 512; return true; }
    __device__ __forceinline__ void a_ready(const Unit&) const {}
    __device__ __forceinline__ void done(const Unit&) const {}
};
struct CtxKvOrder {
    int G, c;
    __device__ __forceinline__ bool next(int i, Unit& u) const { const int L = i * G + c; if (L >= 8) return false; u.pm = 128 + (L & 1); u.pn = 8 + (L >> 1); u.ko = 0; return true; }
    __device__ __forceinline__ void a_ready(const Unit&) const {}
    __device__ __forceinline__ void done(const Unit&) const {}
};
struct EpiCtxAtomic {
    static constexpr bool PERM = false, AFTER_DRAIN = false;
    float* dst_ctx; const float* mod; int modk; float coef;
    __device__ __forceinline__ void operator()(const f32x4 (&acc)[2][2][4][2], const Unit& u, int wr, int wc, int fr, int fq) const {
        float* dst = dst_ctx + (size_t)(u.pm - 128) * 256 * DM; const float* gv = mod + 2 * NADA + modk * DM;
        const int col0 = u.pn * 256 + wc * 32 + 4 * fq, r0 = wr * 64 + fr;
        f32x4 g4[2][2];
#pragma unroll
        for (int bj = 0; bj < 2; ++bj)
#pragma unroll
            for (int n = 0; n < 2; ++n) g4[bj][n] = *(const f32x4*)(gv + col0 + bj * 128 + n * 16) * coef;
#pragma unroll
        for (int ai = 0; ai < 2; ++ai)
#pragma unroll
            for (int m = 0; m < 4; ++m) {
                unsigned ro = (unsigned)((r0 + ai * 128 + m * 16) * DM + col0); asm volatile("" : "+v"(ro));
                float* o = dst + ro;
#pragma unroll
                for (int bj = 0; bj < 2; ++bj)
#pragma unroll
                    for (int n = 0; n < 2; ++n) { const f32x4 v = g4[bj][n] * acc[ai][bj][m][n];
#pragma unroll
                        for (int j = 0; j < 4; ++j) __hip_atomic_fetch_add(o + bj * 128 + n * 16 + j, v[j], __ATOMIC_RELAXED, __HIP_MEMORY_SCOPE_AGENT); } }
    }
};

namespace att {
using bf16x8 = __attribute__((ext_vector_type(8))) short;
using s16x4  = __attribute__((ext_vector_type(4))) short;
using f32x16 = __attribute__((ext_vector_type(16))) float;
constexpr int KVBLK = 64, LDK = 512, LDQ = 512;
constexpr float SCALE = 0.125f, THR = 8.f;
constexpr int SHM_V = KVBLK * 128 * 2, SHM_K = KVBLK * 128 * 2;
#define KSWZ(row, colB) ((row) * 256 + ((colB) ^ (((row) & 7) << 4)))
#define SBAR() __builtin_amdgcn_sched_barrier(0)
template <int M> __device__ __forceinline__ float swz_xor(float v) { return __int_as_float(__builtin_amdgcn_ds_swizzle(__float_as_int(v), 0x1F | (M << 10))); }
__device__ __forceinline__ int crow(int r, int hi) { return (r & 3) + 8 * (r >> 2) + 4 * hi; }
__device__ __forceinline__ unsigned cvtpk(float lo, float hi) { unsigned r; asm volatile("v_cvt_pk_bf16_f32 %0, %1, %2" : "=v"(r) : "v"(lo), "v"(hi)); return r; }
__device__ __forceinline__ void partialSM(f32x16& p0, f32x16& p1, float& m_reg, float& mn, float& alpha) {
  constexpr float C = SCALE * 1.4426950408889634f;
  float pmax = p0[0];
#pragma unroll
  for (int r = 1; r < 16; ++r) pmax = fmaxf(pmax, p0[r]);
#pragma unroll
  for (int r = 0; r < 16; ++r) pmax = fmaxf(pmax, p1[r]);
  { auto rr = __builtin_amdgcn_permlane32_swap(__float_as_uint(pmax), __float_as_uint(pmax), false, false);
    pmax = fmaxf(__uint_as_float(rr[0]), __uint_as_float(rr[1])); }
  if (__builtin_expect(__all(pmax - m_reg <= THR / SCALE), 1)) { mn = m_reg; alpha = 1.f; }
  else { mn = fmaxf(m_reg, pmax); alpha = __builtin_amdgcn_exp2f((m_reg - mn) * C); m_reg = mn; }
  float mnC = -mn * C;
#pragma unroll
  for (int r = 0; r < 16; ++r) p0[r] = fmaf(p0[r], C, mnC);
#pragma unroll
  for (int r = 0; r < 16; ++r) p1[r] = fmaf(p1[r], C, mnC);
#pragma unroll
  for (int r = 0; r < 16; ++r) p0[r] = __builtin_amdgcn_exp2f(p0[r]);
}
__device__ __forceinline__ void finishSM(f32x16& p0, f32x16& p1, float alpha, float& l_reg, bf16x8& pa0, bf16x8& pa1, bf16x8& pa2, bf16x8& pa3) {
#pragma unroll
  for (int r = 0; r < 16; ++r) p1[r] = __builtin_amdgcn_exp2f(p1[r]);
  float ps = 0;
#pragma unroll
  for (int r = 0; r < 16; ++r) ps += p0[r];
#pragma unroll
  for (int r = 0; r < 16; ++r) ps += p1[r];
  { auto rr = __builtin_amdgcn_permlane32_swap(__float_as_uint(ps), __float_as_uint(ps), false, false);
    ps = __uint_as_float(rr[0]) + __uint_as_float(rr[1]); }
  l_reg = l_reg * alpha + ps;
#define PK4(P, BASE, OUT) do { unsigned a0 = cvtpk(P[BASE + 0], P[BASE + 1]), a1 = cvtpk(P[BASE + 2], P[BASE + 3]);   \
    unsigned b0 = cvtpk(P[BASE + 4], P[BASE + 5]), b1 = cvtpk(P[BASE + 6], P[BASE + 7]);                              \
    auto r0 = __builtin_amdgcn_permlane32_swap(a0, b0, false, false); auto r1 = __builtin_amdgcn_permlane32_swap(a1, b1, false, false); \
    u32x4 w = {r0[0], r1[0], r0[1], r1[1]}; OUT = *reinterpret_cast<bf16x8*>(&w); } while (0)
  PK4(p0, 0, pa0); PK4(p0, 8, pa1); PK4(p1, 0, pa2); PK4(p1, 8, pa3);
#undef PK4
}
__device__ __forceinline__ void qkt(f32x16& p0, f32x16& p1, const char* Ks, const bf16x8* qr, int r32, int hi, int s) {
  p0 = f32x16{}; p1 = f32x16{};
#pragma unroll
  for (int d0 = 0; d0 < 4; ++d0) { int cb = (s * 64 + d0 * 16 + hi * 8) * 2;
    bf16x8 b0 = *reinterpret_cast<const bf16x8*>(Ks + KSWZ(r32, cb));
    bf16x8 b1 = *reinterpret_cast<const bf16x8*>(Ks + KSWZ(32 + r32, cb));
    p0 = __builtin_amdgcn_mfma_f32_32x32x16_bf16(b0, qr[d0], p0, 0, 0, 0);
    p1 = __builtin_amdgcn_mfma_f32_32x32x16_bf16(b1, qr[d0], p1, 0, 0, 0); }
}
__device__ __forceinline__ int v_st(int k, int c) { const int kk = (k & ~0xC) | ((k & 4) << 1) | ((k & 8) >> 1); return ((kk >> 3) * 4 + (c >> 5)) * 512 + ((kk & 7) * 32 + (c & 31)) * 2; }
__device__ __forceinline__ int v_rd_base(int lane) { return ((lane & 3) << 3) | (((lane >> 2) & 3) << 6) | (((lane >> 4) & 1) << 5) | (((lane >> 5) & 1) << 8); }
constexpr int v_rd_off(int d0, int ks, int half) { return d0 * 512 + ks * 4096 + half * 2048; }
template <int OFF> __device__ __forceinline__ s16x4 tr_read(int vb) {
  s16x4 r; asm volatile("ds_read_b64_tr_b16 %0, %1 offset:%2" : "=&v"(r) : "v"(vb), "i"(OFF) : "memory"); return r;
}
template <int D0> __device__ __forceinline__ void pv_one(f32x16& od, int vb, bf16x8 pa0, bf16x8 pa1, bf16x8 pa2, bf16x8 pa3) {
  const s16x4 l0 = tr_read<v_rd_off(D0, 0, 0)>(vb), h0 = tr_read<v_rd_off(D0, 0, 1)>(vb), l1 = tr_read<v_rd_off(D0, 1, 0)>(vb), h1 = tr_read<v_rd_off(D0, 1, 1)>(vb);
  const s16x4 l2 = tr_read<v_rd_off(D0, 2, 0)>(vb), h2 = tr_read<v_rd_off(D0, 2, 1)>(vb), l3 = tr_read<v_rd_off(D0, 3, 0)>(vb), h3 = tr_read<v_rd_off(D0, 3, 1)>(vb);
  asm volatile("s_waitcnt lgkmcnt(0)" ::: "memory"); SBAR();
#define PK(L, H) (bf16x8){L[0], L[1], L[2], L[3], H[0], H[1], H[2], H[3]}
  od = __builtin_amdgcn_mfma_f32_32x32x16_bf16(pa0, PK(l0, h0), od, 0, 0, 0);
  od = __builtin_amdgcn_mfma_f32_32x32x16_bf16(pa1, PK(l1, h1), od, 0, 0, 0);
  od = __builtin_amdgcn_mfma_f32_32x32x16_bf16(pa2, PK(l2, h2), od, 0, 0, 0);
  od = __builtin_amdgcn_mfma_f32_32x32x16_bf16(pa3, PK(l3, h3), od, 0, 0, 0);
#undef PK
}
__device__ __forceinline__ void pv_d0(f32x16* o, int vb, bf16x8 pa0, bf16x8 pa1, bf16x8 pa2, bf16x8 pa3) {
  pv_one<0>(o[0], vb, pa0, pa1, pa2, pa3); pv_one<1>(o[1], vb, pa0, pa1, pa2, pa3); pv_one<2>(o[2], vb, pa0, pa1, pa2, pa3); pv_one<3>(o[3], vb, pa0, pa1, pa2, pa3);
}

__device__ __forceinline__ void diff_attn_unit(const u16* __restrict__ Qb, const u16* __restrict__ Kh, const u16* __restrict__ Vh, u16* __restrict__ Yb,
                                               float lam, const float* __restrict__ subg, char* lds) {
  const int tid = threadIdx.x, wid = tid >> 6, lane = tid & 63, r32 = lane & 31, hi = lane >> 5, qb = wid >> 1, s = wid & 1;
  char* V_lds = lds; char* K_lds = lds + 2 * SHM_V;
  float* wsl = (float*)(lds + 2 * SHM_V + 2 * SHM_K) + wid * 64; float* li_l = wsl; float* al_l = wsl + 32;
  float m_reg = -1e30f, l_reg = 0; f32x16 o[4] = {}; bf16x8 qr[4];
  const u16* Qw = Qb + (long)(qb * 32 + r32) * LDQ + s * 64 + hi * 8;
#pragma unroll
  for (int d0 = 0; d0 < 4; ++d0) qr[d0] = *reinterpret_cast<const bf16x8*>(Qw + d0 * 16);
  const int sr = tid >> 4, sc = (tid & 15) * 8, vst0 = v_st(sr, sc), vst1 = v_st(32 + sr, sc);
  const int vb0 = (int)(uintptr_t)V_lds + v_rd_base(lane);
  struct { bf16x8 vs0, vs1, ks0, ks1; } sr_[2];
#define LD8(ptr) (*reinterpret_cast<const bf16x8*>(ptr))
#define SLOAD(i, k0) do { sr_[i].vs0 = LD8(&Vh[(long)((k0) + sr) * LDK + sc]); sr_[i].vs1 = LD8(&Vh[(long)((k0) + 32 + sr) * LDK + sc]); \
    sr_[i].ks0 = LD8(&Kh[(long)((k0) + sr) * LDK + sc]); sr_[i].ks1 = LD8(&Kh[(long)((k0) + 32 + sr) * LDK + sc]); } while (0)
#define SWRITE(b, i) do { *(bf16x8*)(V_lds + (b) * SHM_V + vst0) = sr_[i].vs0;          \
    *(bf16x8*)(V_lds + (b) * SHM_V + vst1) = sr_[i].vs1; int kc = sc * 2;               \
    *(bf16x8*)(K_lds + (b) * SHM_K + KSWZ(sr, kc)) = sr_[i].ks0;                       \
    *(bf16x8*)(K_lds + (b) * SHM_K + KSWZ(32 + sr, kc)) = sr_[i].ks1; } while (0)
#define SWAIT() asm volatile("s_waitcnt vmcnt(4)" ::: "memory")
#define RESC(a) do { if (__any((a) < 1.f)) { if (hi == 0) al_l[r32] = (a); asm volatile("s_waitcnt lgkmcnt(0)" ::: "memory"); \
    _Pragma("unroll") for (int d = 0; d < 4; ++d) _Pragma("unroll") for (int r = 0; r < 16; ++r) o[d][r] *= al_l[crow(r, hi)]; } } while (0)
  f32x16 pA0, pA1, pB0, pB1; float mnA, mnB, alA, alB; bf16x8 pa0, pa1, pa2, pa3; constexpr int NT = NKEY / KVBLK;
  constexpr int SE = 0, SO = 1;
  SLOAD(SE, 0); asm volatile("s_waitcnt vmcnt(0)" ::: "memory"); SWRITE(0, SE); __syncthreads();
  qkt(pA0, pA1, K_lds, qr, r32, hi, s); partialSM(pA0, pA1, m_reg, mnA, alA);
  SLOAD(SO, KVBLK); SLOAD(SE, 2 * KVBLK);
  SWAIT(); SWRITE(1, SO); __syncthreads();
  for (int j = 1; j + 1 < NT; j += 2) {
    SBAR(); qkt(pB0, pB1, K_lds + SHM_K, qr, r32, hi, s);
    finishSM(pA0, pA1, alA, l_reg, pa0, pa1, pa2, pa3); SBAR();
    SLOAD(SO, (j + 2) * KVBLK); SBAR();
    pv_d0(o, vb0, pa0, pa1, pa2, pa3); partialSM(pB0, pB1, m_reg, mnB, alB);
    __syncthreads(); SWAIT(); SWRITE(0, SE);
    RESC(alB); __syncthreads();
    SBAR(); qkt(pA0, pA1, K_lds, qr, r32, hi, s);
    finishSM(pB0, pB1, alB, l_reg, pa0, pa1, pa2, pa3); SBAR();
    if (j + 3 < NT) SLOAD(SE, (j + 3) * KVBLK); SBAR();
    pv_d0(o, vb0 + SHM_V, pa0, pa1, pa2, pa3); partialSM(pA0, pA1, m_reg, mnA, alA);
    __syncthreads(); SWAIT(); SWRITE(1, SO);
    RESC(alA); __syncthreads();
  }
  SBAR(); qkt(pB0, pB1, K_lds + SHM_K, qr, r32, hi, s);
  finishSM(pA0, pA1, alA, l_reg, pa0, pa1, pa2, pa3); SBAR();
  pv_d0(o, vb0, pa0, pa1, pa2, pa3); partialSM(pB0, pB1, m_reg, mnB, alB);
  __syncthreads(); RESC(alB);
  finishSM(pB0, pB1, alB, l_reg, pa0, pa1, pa2, pa3); SBAR();
  pv_d0(o, vb0 + SHM_V, pa0, pa1, pa2, pa3);
  if (hi == 0) li_l[r32] = l_reg; asm volatile("s_waitcnt lgkmcnt(0)" ::: "memory");
  int hi2 = hi; asm volatile("" : "+v"(hi2));
  float rli[16];
#pragma unroll
  for (int r = 0; r < 16; ++r) rli[r] = 1.0f / li_l[crow(r, hi2)];
  __syncthreads();
  int xoff = qb * 4096 + r32, yoff = qb * 32 * 1024 + r32;
  asm volatile("" : "+v"(xoff), "+v"(yoff));
  float* X = (float*)lds + xoff;
  if (s == 1) {
#pragma unroll
    for (int r = 0; r < 16; ++r)
#pragma unroll
      for (int d0 = 0; d0 < 4; ++d0) X[crow(r, hi2) * 128 + d0 * 32] = lam * o[d0][r] * rli[r];
  }
  __syncthreads();
  if (s == 0) {
    float gv[4];
#pragma unroll
    for (int d0 = 0; d0 < 4; ++d0) gv[d0] = subg[d0 * 32 + r32] * 0.8f;
#pragma unroll
    for (int r = 0; r < 16; ++r) {
      const int row = crow(r, hi2); float v[4]; float ss = 0.f;
#pragma unroll
      for (int d0 = 0; d0 < 4; ++d0) { v[d0] = o[d0][r] * rli[r] - X[row * 128 + d0 * 32]; ss += v[d0] * v[d0]; }
      ss += swz_xor<16>(ss); ss += swz_xor<8>(ss); ss += swz_xor<4>(ss); ss += swz_xor<2>(ss); ss += swz_xor<1>(ss);
      const float rs = rsqrtf(ss * (1.0f / 128.0f) + 1e-5f);
      u16* yp = Yb + (yoff + row * 1024);
#pragma unroll
      for (int d0 = 0; d0 < 4; ++d0) yp[d0 * 32] = f2bf(v[d0] * rs * gv[d0]);
    }
  }
  __syncthreads();
#undef LD8
#undef SLOAD
#undef SWRITE
#undef SWAIT
#undef RESC
}

#ifndef PROBE_ATT_VALU
#define PROBE_ATT_VALU 0
#endif
#ifndef PROBE_ATT_MFMA
#define PROBE_ATT_MFMA 0
#endif
__device__ __forceinline__ void sm_half(f32x16& p, float& m_reg, float& l_reg, float& alpha, bf16x8& paA, bf16x8& paB) {
  constexpr float C = SCALE * 1.4426950408889634f * (PROBE_ATT_MFMA ? 0.5f : 1.0f);
  float pmax = p[0];
#pragma unroll
  for (int r = 1; r < 16; ++r) pmax = fmaxf(pmax, p[r]);
  { auto rr = __builtin_amdgcn_permlane32_swap(__float_as_uint(pmax), __float_as_uint(pmax), false, false);
    pmax = fmaxf(__uint_as_float(rr[0]), __uint_as_float(rr[1])); }
  float mn;
  if (__builtin_expect(__all(pmax - m_reg <= THR / SCALE * (PROBE_ATT_MFMA ? 2.0f : 1.0f)), 1)) { mn = m_reg; alpha = 1.f; }
  else { mn = fmaxf(m_reg, pmax); alpha = __builtin_amdgcn_exp2f((m_reg - mn) * C); m_reg = mn; }
  const float mnC = -mn * C;
#if PROBE_ATT_VALU
  { float junk = 0.f;
#pragma unroll
    for (int r = 0; r < 16; ++r) junk += __builtin_amdgcn_exp2f(fmaf(p[r], C, mnC - 1.0f));
    l_reg += junk * 0.0f; }
#endif
#pragma unroll
  for (int r = 0; r < 16; ++r) p[r] = __builtin_amdgcn_exp2f(fmaf(p[r], C, mnC));
  float ps = 0;
#pragma unroll
  for (int r = 0; r < 16; ++r) ps += p[r];
  { auto rr = __builtin_amdgcn_permlane32_swap(__float_as_uint(ps), __float_as_uint(ps), false, false);
    ps = __uint_as_float(rr[0]) + __uint_as_float(rr[1]); }
  l_reg = l_reg * alpha + ps;
#define PK4(P, BASE, OUT) do { unsigned a0 = cvtpk(P[BASE + 0], P[BASE + 1]), a1 = cvtpk(P[BASE + 2], P[BASE + 3]);   \
    unsigned b0 = cvtpk(P[BASE + 4], P[BASE + 5]), b1 = cvtpk(P[BASE + 6], P[BASE + 7]);                              \
    auto r0 = __builtin_amdgcn_permlane32_swap(a0, b0, false, false); auto r1 = __builtin_amdgcn_permlane32_swap(a1, b1, false, false); \
    u32x4 w = {r0[0], r1[0], r0[1], r1[1]}; OUT = *reinterpret_cast<bf16x8*>(&w); } while (0)
  PK4(p, 0, paA); PK4(p, 8, paB);
#undef PK4
}

__device__ __forceinline__ void sm_half_b(f32x16& p, float mnC, float& l_reg, bf16x8& paA, bf16x8& paB) {
  constexpr float C = SCALE * 1.4426950408889634f;
#pragma unroll
  for (int r = 0; r < 16; ++r) p[r] = __builtin_amdgcn_exp2f(fmaf(p[r], C, mnC));
  float ps0 = p[0] + p[1], ps1 = p[2] + p[3], ps2 = p[4] + p[5], ps3 = p[6] + p[7];
  ps0 += p[8] + p[9]; ps1 += p[10] + p[11]; ps2 += p[12] + p[13]; ps3 += p[14] + p[15];
  float ps = (ps0 + ps1) + (ps2 + ps3);
  { auto rr = __builtin_amdgcn_permlane32_swap(__float_as_uint(ps), __float_as_uint(ps), false, false);
    ps = __uint_as_float(rr[0]) + __uint_as_float(rr[1]); }
  l_reg += ps;
#define PK4(P, BASE, OUT) do { unsigned a0 = cvtpk(P[BASE + 0], P[BASE + 1]), a1 = cvtpk(P[BASE + 2], P[BASE + 3]);   \
    unsigned b0 = cvtpk(P[BASE + 4], P[BASE + 5]), b1 = cvtpk(P[BASE + 6], P[BASE + 7]);                              \
    auto r0 = __builtin_amdgcn_permlane32_swap(a0, b0, false, false); auto r1 = __builtin_amdgcn_permlane32_swap(a1, b1, false, false); \
    u32x4 w = {r0[0], r1[0], r0[1], r1[1]}; OUT = *reinterpret_cast<bf16x8*>(&w); } while (0)
  PK4(p, 0, paA); PK4(p, 8, paB);
#undef PK4
}
__device__ __forceinline__ float sumsq8(bf16x8 v) {
  const u32x4 w = *reinterpret_cast<const u32x4*>(&v); float s = 0.f;
#pragma unroll
  for (int i = 0; i < 4; ++i) { const float lo = __uint_as_float(w[i] << 16), hi = __uint_as_float(w[i] & 0xffff0000u); s += lo * lo + hi * hi; }
  return s;
}
typedef short s16x4w __attribute__((ext_vector_type(4)));
template <int HF> __device__ __forceinline__ void pv_half2(f32x16* o0, f32x16* o1, LAS unsigned char* vbp, bf16x8 p0a, bf16x8 p0b, bf16x8 p1a, bf16x8 p1b) {
#define TR(off) __builtin_amdgcn_ds_read_tr16_b64_v4i16((LAS s16x4w*)(vbp + (off)))
#define PK(L, H) (bf16x8){L[0], L[1], L[2], L[3], H[0], H[1], H[2], H[3]}
  s16x4w la[4], ha[4], lb[4], hb[4];
#pragma unroll
  for (int d0 = 0; d0 < 4; ++d0) { la[d0] = TR(v_rd_off(d0, 2 * HF, 0)); ha[d0] = TR(v_rd_off(d0, 2 * HF, 1)); lb[d0] = TR(v_rd_off(d0, 2 * HF + 1, 0)); hb[d0] = TR(v_rd_off(d0, 2 * HF + 1, 1)); }
#pragma unroll
  for (int d0 = 0; d0 < 4; ++d0) { const bf16x8 va = PK(la[d0], ha[d0]);
    o0[d0] = __builtin_amdgcn_mfma_f32_32x32x16_bf16(p0a, va, o0[d0], 0, 0, 0); o1[d0] = __builtin_amdgcn_mfma_f32_32x32x16_bf16(p1a, va, o1[d0], 0, 0, 0); }
#pragma unroll
  for (int d0 = 0; d0 < 4; ++d0) { const bf16x8 vb = PK(lb[d0], hb[d0]);
    o0[d0] = __builtin_amdgcn_mfma_f32_32x32x16_bf16(p0b, vb, o0[d0], 0, 0, 0); o1[d0] = __builtin_amdgcn_mfma_f32_32x32x16_bf16(p1b, vb, o1[d0], 0, 0, 0); }
#undef TR
#undef PK
}
__device__ __forceinline__ void diff_attn_unit2(const u16* __restrict__ Qb, const u16* __restrict__ Kh, const u16* __restrict__ Vh, u16* __restrict__ Yb,
                                                float lam, const float* __restrict__ subg, const float* __restrict__ kn2, char* lds, LAS unsigned char* ldsl) {
  const int tid = threadIdx.x, wid = __builtin_amdgcn_readfirstlane(tid >> 6), lane = tid & 63, r32 = lane & 31, hi = lane >> 5;
  char* V_lds = lds; char* K_lds = lds + 2 * SHM_V;
  float* wsl = (float*)(lds + 2 * SHM_V + 2 * SHM_K) + wid * 96; float* li0 = wsl; float* li1 = wsl + 32; float* al_l = wsl + 64;
  float l0 = 0.f, l1 = 0.f; f32x16 o0[4] = {}, o1[4] = {}; bf16x8 q0[4], q1[4];
  { unsigned qoff = (unsigned)((wid * 32 + r32) * LDQ + hi * 8) * 2u; asm volatile("" : "+v"(qoff));
    const char* Qw = (const char*)Qb + qoff;
#pragma unroll
    for (int d0 = 0; d0 < 4; ++d0) { q0[d0] = *reinterpret_cast<const bf16x8*>(Qw + d0 * 32); q1[d0] = *reinterpret_cast<const bf16x8*>(Qw + 128 + d0 * 32); } }
  float mnC0, mnC1;
  {
    float* cmax = (float*)(lds + 2 * SHM_V + 2 * SHM_K + 8 * 96 * 4);
    int t_ = tid; asm volatile("" : "+v"(t_));
    const int ck = t_ >> 1, cs = t_ & 1; const char* kp_ = (const char*)Kh + (unsigned)(((SEQ + ck) * LDK + cs * 64) * 2); const u16* kp = (const u16*)kp_; float ss = 0.f;
#pragma unroll
    for (int i = 0; i < 8; ++i) ss += sumsq8(*reinterpret_cast<const bf16x8*>(kp + i * 8));
    ss = fmaxf(ss, swz_xor<2>(ss)); ss = fmaxf(ss, swz_xor<4>(ss)); ss = fmaxf(ss, swz_xor<8>(ss)); ss = fmaxf(ss, swz_xor<16>(ss));
    { auto rr = __builtin_amdgcn_permlane32_swap(__float_as_uint(ss), __float_as_uint(ss), false, false); ss = fmaxf(__uint_as_float(rr[0]), __uint_as_float(rr[1])); }
    if (lane < 2) cmax[wid * 2 + lane] = ss;
    __syncthreads();
    float c0 = cmax[0], c1 = cmax[1];
#pragma unroll
    for (int w = 1; w < 8; ++w) { c0 = fmaxf(c0, cmax[2 * w]); c1 = fmaxf(c1, cmax[2 * w + 1]); }
    const float kb0 = fmaxf(kn2[0], c0), kb1 = fmaxf(kn2[1], c1);
    float qa = 0.f, qb = 0.f;
#pragma unroll
    for (int d0 = 0; d0 < 4; ++d0) { qa += sumsq8(q0[d0]); qb += sumsq8(q1[d0]); }
    { auto rr = __builtin_amdgcn_permlane32_swap(__float_as_uint(qa), __float_as_uint(qa), false, false); qa = __uint_as_float(rr[0]) + __uint_as_float(rr[1]); }
    { auto rr = __builtin_amdgcn_permlane32_swap(__float_as_uint(qb), __float_as_uint(qb), false, false); qb = __uint_as_float(rr[0]) + __uint_as_float(rr[1]); }
    constexpr float C = SCALE * 1.4426950408889634f;
    mnC0 = -sqrtf(qa * kb0) * C * 1.0001f - 1e-6f; mnC1 = -sqrtf(qb * kb1) * C * 1.0001f - 1e-6f;
  }
  LAS unsigned char* vbl = ldsl + v_rd_base(lane);
  int kb[4];
#pragma unroll
  for (int d0 = 0; d0 < 4; ++d0) kb[d0] = r32 * 256 + ((d0 * 32 + hi * 16) ^ ((r32 & 7) << 4));
  unsigned koff[2], voff[2];
#pragma unroll
  for (int i = 0; i < 2; ++i) { const int L = (wid + 8 * i) * 64 + lane;
    { const int row = L >> 4, pos = L & 15; koff[i] = (unsigned)(row * 1024 + ((pos ^ (row & 7)) << 4)); }
    { const int sub = L >> 5, within = L & 31, kk = (sub >> 2) * 8 + (within >> 2), k = (kk & ~0xC) | ((kk & 4) << 1) | ((kk & 8) >> 1), c = (sub & 3) * 32 + (within & 3) * 8;
      voff[i] = (unsigned)(k * 1024 + c * 2); } }
#define SDMA(b, k0) do { const char* vg = (const char*)Vh + (size_t)(k0) * (LDK * 2); const char* kg = (const char*)Kh + (size_t)(k0) * (LDK * 2); \
    _Pragma("unroll") for (int i = 0; i < 2; ++i) {                                                                                                  \
      __builtin_amdgcn_global_load_lds((const unsigned*)(kg + i * 32768 + koff[0]), (LAS unsigned*)(ldsl + 2 * SHM_V + (b) * SHM_K + (wid + 8 * i) * 1024), 16, 0, 0); \
      __builtin_amdgcn_global_load_lds((const unsigned*)(vg + i * 32768 + voff[0]), (LAS unsigned*)(ldsl + (b) * SHM_V + (wid + 8 * i) * 1024), 16, 0, 0); } } while (0)
#define VWAIT() asm volatile("s_waitcnt vmcnt(0)" ::: "memory")
#define RESC(o, a) do { if (__any((a) < 1.f)) { if (hi == 0) al_l[r32] = (a); asm volatile("s_waitcnt lgkmcnt(0)" ::: "memory"); \
    _Pragma("unroll") for (int d = 0; d < 4; ++d) _Pragma("unroll") for (int r = 0; r < 16; ++r) o[d][r] *= al_l[crow(r, hi)]; } } while (0)
#define HALF(b, HF) do { const char* Kt = K_lds + (b) * SHM_K; f32x16 s0 = {}, s1 = {}; bf16x8 kf0[4], kf1[4];                  \
    _Pragma("unroll") for (int d0 = 0; d0 < 4; ++d0) {                                                                     \
      kf0[d0] = *reinterpret_cast<const bf16x8*>(Kt + kb[d0] + (HF) * 8192);                                               \
      kf1[d0] = *reinterpret_cast<const bf16x8*>(Kt + kb[d0] + (HF) * 8192 + 128); }                                       \
    _Pragma("unroll") for (int d0 = 0; d0 < 4; ++d0) {                                                                     \
      s0 = __builtin_amdgcn_mfma_f32_32x32x16_bf16(kf0[d0], q0[d0], s0, 0, 0, 0);                                           \
      s1 = __builtin_amdgcn_mfma_f32_32x32x16_bf16(kf1[d0], q1[d0], s1, 0, 0, 0); }                                         \
    bf16x8 p0a, p0b, p1a, p1b;                                                                                              \
    sm_half_b(s0, mnC0, l0, p0a, p0b);                                                                                      \
    sm_half_b(s1, mnC1, l1, p1a, p1b);                                                                                      \
    pv_half2<HF>(o0, o1, vbl + (b) * SHM_V, p0a, p0b, p1a, p1b); } while (0)
  constexpr int NT = NKEY / KVBLK;
  SDMA(0, 0); VWAIT(); __syncthreads();
  for (int j = 0; j < NT; j += 2) {
    SDMA(1, (j + 1) * KVBLK);
    HALF(0, 0); HALF(0, 1);
    VWAIT(); __syncthreads();
    if (j + 2 < NT) SDMA(0, (j + 2) * KVBLK);
    HALF(1, 0); HALF(1, 1);
    VWAIT(); __syncthreads();
  }
  if (hi == 0) { li0[r32] = l0; li1[r32] = l1; } asm volatile("s_waitcnt lgkmcnt(0)" ::: "memory");
  int hi2 = hi, yoff = wid * 32 * 1024 + r32; asm volatile("" : "+v"(hi2), "+v"(yoff));
  float gv[4];
#pragma unroll
  for (int d0 = 0; d0 < 4; ++d0) gv[d0] = subg[d0 * 32 + (yoff & 31)] * 0.8f;
#pragma unroll
  for (int r = 0; r < 16; ++r) {
    const int row = crow(r, hi2); const float r0 = 1.0f / li0[row], r1 = lam / li1[row]; float v[4]; float ss = 0.f;
#pragma unroll
    for (int d0 = 0; d0 < 4; ++d0) { v[d0] = o0[d0][r] * r0 - o1[d0][r] * r1; ss += v[d0] * v[d0]; }
    ss += swz_xor<16>(ss); ss += swz_xor<8>(ss); ss += swz_xor<4>(ss); ss += swz_xor<2>(ss); ss += swz_xor<1>(ss);
    const float rs = rsqrtf(ss * (1.0f / 128.0f) + 1e-5f);
    u16* yp = Yb + (yoff + row * 1024);
#pragma unroll
    for (int d0 = 0; d0 < 4; ++d0) yp[d0 * 32] = f2bf(v[d0] * rs * gv[d0]);
  }
  __syncthreads();
#undef SDMA
#undef VWAIT
#undef RESC
#undef HALF
}

constexpr int L3_V = 0, L3_K = 3 * SHM_V, L3_Q = L3_K + 2 * SHM_K, L3_S = L3_Q + 65536, L3_END = L3_S + 8 * 96 * 4;
typedef short s16x4v __attribute__((ext_vector_type(4)));
__device__ __forceinline__ void sm3(f32x16& p, float& m_reg, float& l_reg, float& alpha, bf16x8& paA, bf16x8& paB) {
  constexpr float C = SCALE * 1.4426950408889634f;
  float pmax = fmaxf(fmaxf(p[0], p[1]), fmaxf(p[2], p[3]));
#pragma unroll
  for (int r = 4; r < 16; r += 2) pmax = fmaxf(pmax, fmaxf(p[r], p[r + 1]));
  { auto rr = __builtin_amdgcn_permlane32_swap(__float_as_uint(pmax), __float_as_uint(pmax), false, false);
    pmax = fmaxf(__uint_as_float(rr[0]), __uint_as_float(rr[1])); }
  const float mn = (pmax - m_reg <= THR / SCALE) ? m_reg : fmaxf(m_reg, pmax);
  alpha = __builtin_amdgcn_exp2f((m_reg - mn) * C); m_reg = mn;
  const float mnC = -mn * C;
#pragma unroll
  for (int r = 0; r < 16; ++r) p[r] = __builtin_amdgcn_exp2f(fmaf(p[r], C, mnC));
  float ps0 = p[0] + p[1], ps1 = p[2] + p[3], ps2 = p[4] + p[5], ps3 = p[6] + p[7];
  ps0 += p[8] + p[9]; ps1 += p[10] + p[11]; ps2 += p[12] + p[13]; ps3 += p[14] + p[15];
  float ps = (ps0 + ps1) + (ps2 + ps3);
  { auto rr = __builtin_amdgcn_permlane32_swap(__float_as_uint(ps), __float_as_uint(ps), false, false);
    ps = __uint_as_float(rr[0]) + __uint_as_float(rr[1]); }
  l_reg = l_reg * alpha + ps;
#define PK4(P, BASE, OUT) do { unsigned a0 = cvtpk(P[BASE + 0], P[BASE + 1]), a1 = cvtpk(P[BASE + 2], P[BASE + 3]);   \
    unsigned b0 = cvtpk(P[BASE + 4], P[BASE + 5]), b1 = cvtpk(P[BASE + 6], P[BASE + 7]);                              \
    auto r0 = __builtin_amdgcn_permlane32_swap(a0, b0, false, false); auto r1 = __builtin_amdgcn_permlane32_swap(a1, b1, false, false); \
    u32x4 w = {r0[0], r1[0], r0[1], r1[1]}; OUT = *reinterpret_cast<bf16x8*>(&w); } while (0)
  PK4(p, 0, paA); PK4(p, 8, paB);
#undef PK4
}
template <int HF> __device__ __forceinline__ void pv_all(f32x16* o0, f32x16* o1, LAS unsigned char* vbp, bf16x8 p0a, bf16x8 p0b, bf16x8 p1a, bf16x8 p1b) {
#define TR(off) __builtin_amdgcn_ds_read_tr16_b64_v4i16((LAS s16x4v*)(vbp + (off)))
#define PK(L, H) (bf16x8){L[0], L[1], L[2], L[3], H[0], H[1], H[2], H[3]}
#pragma unroll
  for (int d0 = 0; d0 < 4; ++d0) {
    const s16x4v la = TR(v_rd_off(d0, 2 * HF, 0)), ha = TR(v_rd_off(d0, 2 * HF, 1)), lb = TR(v_rd_off(d0, 2 * HF + 1, 0)), hb = TR(v_rd_off(d0, 2 * HF + 1, 1));
    const bf16x8 va = PK(la, ha), vb = PK(lb, hb);
    o0[d0] = __builtin_amdgcn_mfma_f32_32x32x16_bf16(p0a, va, o0[d0], 0, 0, 0);
    o1[d0] = __builtin_amdgcn_mfma_f32_32x32x16_bf16(p1a, va, o1[d0], 0, 0, 0);
    o0[d0] = __builtin_amdgcn_mfma_f32_32x32x16_bf16(p0b, vb, o0[d0], 0, 0, 0);
    o1[d0] = __builtin_amdgcn_mfma_f32_32x32x16_bf16(p1b, vb, o1[d0], 0, 0, 0);
  }
#undef TR
#undef PK
}
__device__ __forceinline__ void diff_attn_unit3(const u16* __restrict__ Qb, const u16* __restrict__ Kh, const u16* __restrict__ Vh, u16* __restrict__ Yb,
                                                float lam, const float* __restrict__ subg, LAS unsigned char* ldsl) {
  const int tid = threadIdx.x, wid = __builtin_amdgcn_readfirstlane(tid >> 6), lane = tid & 63, r32 = lane & 31, hi = lane >> 5;
  LAS float* wsl = (LAS float*)(ldsl + L3_S) + wid * 96; LAS float* li0 = wsl; LAS float* li1 = wsl + 32; LAS float* al_l = wsl + 64;
  float m0 = -1e30f, l0 = 0.f, m1 = -1e30f, l1 = 0.f; f32x16 o0[4] = {}, o1[4] = {};
  int kb[4];
#pragma unroll
  for (int d0 = 0; d0 < 4; ++d0) kb[d0] = r32 * 256 + ((d0 * 32 + hi * 16) ^ ((r32 & 7) << 4));
  LAS unsigned char* Qw_l = ldsl + L3_Q + wid * 8192;
  { unsigned qoff = (unsigned)((wid * 32 + r32) * LDQ + hi * 8) * 2u; asm volatile("" : "+v"(qoff));
    const char* Qw = (const char*)Qb + qoff;
#pragma unroll
    for (int d0 = 0; d0 < 4; ++d0) { const bf16x8 a = *reinterpret_cast<const bf16x8*>(Qw + d0 * 32), b = *reinterpret_cast<const bf16x8*>(Qw + 128 + d0 * 32);
      *(LAS bf16x8*)(Qw_l + kb[d0]) = a; *(LAS bf16x8*)(Qw_l + kb[d0] + 128) = b; } }
  LAS unsigned char* vb0 = ldsl + L3_V + v_rd_base(lane);
  unsigned koff[2], voff[2];
#pragma unroll
  for (int i = 0; i < 2; ++i) { const int L = (wid + 8 * i) * 64 + lane;
    { const int row = L >> 4, pos = L & 15; koff[i] = (unsigned)(row * 1024 + ((pos ^ (row & 7)) << 4)); }
    { const int sub = L >> 5, within = L & 31, kk = (sub >> 2) * 8 + (within >> 2), k = (kk & ~0xC) | ((kk & 4) << 1) | ((kk & 8) >> 1), c = (sub & 3) * 32 + (within & 3) * 8;
      voff[i] = (unsigned)(k * 1024 + c * 2); } }
#define SDMA(ko, vo, k0) do { const char* vg = (const char*)Vh + (size_t)(k0) * (LDK * 2); const char* kg = (const char*)Kh + (size_t)(k0) * (LDK * 2); \
    _Pragma("unroll") for (int i = 0; i < 2; ++i) {                                                                                                  \
      __builtin_amdgcn_global_load_lds((const unsigned*)(kg + i * 32768 + koff[0]), (LAS unsigned*)(ldsl + L3_K + (ko) + (wid + 8 * i) * 1024), 16, 0, 0);      \
      __builtin_amdgcn_global_load_lds((const unsigned*)(vg + i * 32768 + voff[0]), (LAS unsigned*)(ldsl + L3_V + (vo) + (wid + 8 * i) * 1024), 16, 0, 0); } } while (0)
#define VWAIT() asm volatile("s_waitcnt vmcnt(0)" ::: "memory")
#define RESC(o, a) do { if (__any((a) < 1.f)) { if (hi == 0) al_l[r32] = (a); asm volatile("s_waitcnt lgkmcnt(0)" ::: "memory"); \
    _Pragma("unroll") for (int d = 0; d < 4; ++d) _Pragma("unroll") for (int r = 0; r < 16; ++r) o[d][r] *= al_l[crow(r, hi)]; } } while (0)
#define QKH(ko, HF) do { s0 = f32x16{}; s1 = f32x16{};                                                                      \
    _Pragma("unroll") for (int d0 = 0; d0 < 4; ++d0) {                                                                     \
      const bf16x8 k0 = *(const LAS bf16x8*)(ldsl + L3_K + (ko) + kb[d0] + (HF) * 8192);                                   \
      const bf16x8 k1 = *(const LAS bf16x8*)(ldsl + L3_K + (ko) + kb[d0] + (HF) * 8192 + 128);                             \
      const bf16x8 qa = *(const LAS bf16x8*)(Qw_l + kb[d0]); const bf16x8 qb = *(const LAS bf16x8*)(Qw_l + kb[d0] + 128);   \
      s0 = __builtin_amdgcn_mfma_f32_32x32x16_bf16(k0, qa, s0, 0, 0, 0);                                                    \
      s1 = __builtin_amdgcn_mfma_f32_32x32x16_bf16(k1, qb, s1, 0, 0, 0); } } while (0)
#define SMBOTH() do { float a0, a1; bf16x8 n0a, n0b, n1a, n1b;                                                              \
    sm3(s0, m0, l0, a0, n0a, n0b); sm3(s1, m1, l1, a1, n1a, n1b);                                                           \
    p0a = n0a; p0b = n0b; p1a = n1a; p1b = n1b; RESC(o0, a0); RESC(o1, a1); } while (0)
#define TR(off) __builtin_amdgcn_ds_read_tr16_b64_v4i16((LAS s16x4v*)(vp_ + (off)))
#define PKV(L, H) (bf16x8){L[0], L[1], L[2], L[3], H[0], H[1], H[2], H[3]}
#define TRD(S, d0, HF) do { S##0 = TR(v_rd_off(d0, 2 * (HF), 0)); S##1 = TR(v_rd_off(d0, 2 * (HF), 1)); S##2 = TR(v_rd_off(d0, 2 * (HF) + 1, 0)); S##3 = TR(v_rd_off(d0, 2 * (HF) + 1, 1)); } while (0)
#define PVD(S, d0) do { const bf16x8 va_ = PKV(S##0, S##1), vb_ = PKV(S##2, S##3);                                          \
    o0[d0] = __builtin_amdgcn_mfma_f32_32x32x16_bf16(p0a, va_, o0[d0], 0, 0, 0); o1[d0] = __builtin_amdgcn_mfma_f32_32x32x16_bf16(p1a, va_, o1[d0], 0, 0, 0); \
    o0[d0] = __builtin_amdgcn_mfma_f32_32x32x16_bf16(p0b, vb_, o0[d0], 0, 0, 0); o1[d0] = __builtin_amdgcn_mfma_f32_32x32x16_bf16(p1b, vb_, o1[d0], 0, 0, 0); } while (0)
#define ROWMAX(p, out) do { float t_ = fmaxf(fmaxf(p[0], p[1]), fmaxf(p[2], p[3]));                                        \
    _Pragma("unroll") for (int r = 4; r < 16; r += 2) t_ = fmaxf(t_, fmaxf(p[r], p[r + 1]));                               \
    auto rr_ = __builtin_amdgcn_permlane32_swap(__float_as_uint(t_), __float_as_uint(t_), false, false);                    \
    out = fmaxf(__uint_as_float(rr_[0]), __uint_as_float(rr_[1])); } while (0)
#define ROWSUM(p, out) do { float q0_ = p[0] + p[1], q1_ = p[2] + p[3], q2_ = p[4] + p[5], q3_ = p[6] + p[7];               \
    q0_ += p[8] + p[9]; q1_ += p[10] + p[11]; q2_ += p[12] + p[13]; q3_ += p[14] + p[15]; float t_ = (q0_ + q1_) + (q2_ + q3_); \
    auto rr_ = __builtin_amdgcn_permlane32_swap(__float_as_uint(t_), __float_as_uint(t_), false, false);                    \
    out = __uint_as_float(rr_[0]) + __uint_as_float(rr_[1]); } while (0)
#define PK4(P, BASE, OUT) do { unsigned a0_ = cvtpk(P[BASE + 0], P[BASE + 1]), a1_ = cvtpk(P[BASE + 2], P[BASE + 3]);       \
    unsigned b0_ = cvtpk(P[BASE + 4], P[BASE + 5]), b1_ = cvtpk(P[BASE + 6], P[BASE + 7]);                                  \
    auto r0_ = __builtin_amdgcn_permlane32_swap(a0_, b0_, false, false); auto r1_ = __builtin_amdgcn_permlane32_swap(a1_, b1_, false, false); \
    u32x4 w_ = {r0_[0], r1_[0], r0_[1], r1_[1]}; OUT = *reinterpret_cast<bf16x8*>(&w_); } while (0)
#define STEP(ko, QHF, vp, PVHF) do { LAS unsigned char* vp_ = (vp); constexpr float C_ = SCALE * 1.4426950408889634f;       \
    s16x4v A0, A1, A2, A3, B0, B1, B2, B3; float a0, a1, c0_, c1_; bf16x8 n0a, n0b, n1a, n1b;                                \
    TRD(A, 0, PVHF);                                                                                                        \
    QKH(ko, QHF);                                                                                                           \
    SBAR();                                                                                                                 \
    PVD(A, 0); TRD(B, 1, PVHF);                                                                                             \
    { float pm0, pm1; ROWMAX(s0, pm0); ROWMAX(s1, pm1);                                                                     \
      const float mn0 = (pm0 - m0 <= THR / SCALE) ? m0 : fmaxf(m0, pm0), mn1 = (pm1 - m1 <= THR / SCALE) ? m1 : fmaxf(m1, pm1); \
      a0 = __builtin_amdgcn_exp2f((m0 - mn0) * C_); a1 = __builtin_amdgcn_exp2f((m1 - mn1) * C_); m0 = mn0; m1 = mn1; c0_ = -mn0 * C_; c1_ = -mn1 * C_; } \
    SBAR();                                                                                                                 \
    PVD(B, 1); TRD(A, 2, PVHF);                                                                                             \
    _Pragma("unroll") for (int r = 0; r < 16; ++r) s0[r] = __builtin_amdgcn_exp2f(fmaf(s0[r], C_, c0_));                    \
    SBAR();                                                                                                                 \
    PVD(A, 2); TRD(B, 3, PVHF);                                                                                             \
    _Pragma("unroll") for (int r = 0; r < 16; ++r) s1[r] = __builtin_amdgcn_exp2f(fmaf(s1[r], C_, c1_));                    \
    SBAR();                                                                                                                 \
    PVD(B, 3);                                                                                                              \
    { float ps0, ps1; ROWSUM(s0, ps0); ROWSUM(s1, ps1); l0 = l0 * a0 + ps0; l1 = l1 * a1 + ps1;                             \
      PK4(s0, 0, n0a); PK4(s0, 8, n0b); PK4(s1, 0, n1a); PK4(s1, 8, n1b); }                                                  \
    SBAR();                                                                                                                 \
    p0a = n0a; p0b = n0b; p1a = n1a; p1b = n1b; RESC(o0, a0); RESC(o1, a1); } while (0)
  constexpr int NT = NKEY / KVBLK;
  f32x16 s0, s1; bf16x8 p0a, p0b, p1a, p1b;
  SDMA(0, 0, 0); VWAIT(); __syncthreads();
  SDMA(SHM_K, SHM_V, KVBLK);
  QKH(0, 0); SMBOTH();
  int vcur = 0;
  for (int j = 0; j < NT; ++j) {
    const int kcur = (j & 1) * SHM_K, knext = SHM_K - kcur;
    const int vnext = vcur == 2 * SHM_V ? 0 : vcur + SHM_V, vnn = vnext == 2 * SHM_V ? 0 : vnext + SHM_V;
    STEP(kcur, 1, vb0 + vcur, 0);
    VWAIT(); __syncthreads();
    if (j + 2 < NT) SDMA(kcur, vnn, (j + 2) * KVBLK);
    if (j + 1 < NT) { STEP(knext, 0, vb0 + vcur, 1); }
    else pv_all<1>(o0, o1, vb0 + vcur, p0a, p0b, p1a, p1b);
    vcur = vnext;
  }
  if (hi == 0) { li0[r32] = l0; li1[r32] = l1; } asm volatile("s_waitcnt lgkmcnt(0)" ::: "memory");
  int hi2 = hi, yoff = wid * 32 * 1024 + r32; asm volatile("" : "+v"(hi2), "+v"(yoff));
  float gv[4];
#pragma unroll
  for (int d0 = 0; d0 < 4; ++d0) gv[d0] = subg[d0 * 32 + (yoff & 31)] * 0.8f;
#pragma unroll
  for (int r = 0; r < 16; ++r) {
    const int row = crow(r, hi2); const float r0 = 1.0f / li0[row], r1 = lam / li1[row]; float v[4]; float ss = 0.f;
#pragma unroll
    for (int d0 = 0; d0 < 4; ++d0) { v[d0] = o0[d0][r] * r0 - o1[d0][r] * r1; ss += v[d0] * v[d0]; }
    ss += swz_xor<16>(ss); ss += swz_xor<8>(ss); ss += swz_xor<4>(ss); ss += swz_xor<2>(ss); ss += swz_xor<1>(ss);
    const float rs = rsqrtf(ss * (1.0f / 128.0f) + 1e-5f);
    u16* yp = Yb + (yoff + row * 1024);
#pragma unroll
    for (int d0 = 0; d0 < 4; ++d0) yp[d0 * 32] = f2bf(v[d0] * rs * gv[d0]);
  }
  __syncthreads();
#undef SDMA
#undef VWAIT
#undef RESC
#undef QKH
#undef SMBOTH
#undef STEP
#undef TR
#undef PKV
#undef TRD
#undef PVD
#undef ROWMAX
#undef ROWSUM
#undef PK4
}

__device__ __forceinline__ void diff_attn_unit4(const u16* __restrict__ Qb, const u16* __restrict__ Kh, const u16* __restrict__ Vh, u16* __restrict__ Yb,
                                                float lam, const float* __restrict__ subg, const float* __restrict__ kn2, LAS unsigned char* ldsl) {
  const int tid = threadIdx.x, wid = __builtin_amdgcn_readfirstlane(tid >> 6), lane = tid & 63, r32 = lane & 31, hi = lane >> 5;
  LAS float* wsl = (LAS float*)(ldsl + L3_S) + wid * 96; LAS float* li0 = wsl; LAS float* li1 = wsl + 32; LAS float* al_l = wsl + 64;
  float l0 = 0.f, l1 = 0.f; f32x16 o0[4] = {}, o1[4] = {}; bf16x8 q0[4], q1[4];
  int kb[4];
#pragma unroll
  for (int d0 = 0; d0 < 4; ++d0) kb[d0] = r32 * 256 + ((d0 * 32 + hi * 16) ^ ((r32 & 7) << 4));
  { unsigned qoff = (unsigned)((wid * 32 + r32) * LDQ + hi * 8) * 2u; asm volatile("" : "+v"(qoff));
    const char* Qw = (const char*)Qb + qoff;
#pragma unroll
    for (int d0 = 0; d0 < 4; ++d0) { q0[d0] = *reinterpret_cast<const bf16x8*>(Qw + d0 * 32); q1[d0] = *reinterpret_cast<const bf16x8*>(Qw + 128 + d0 * 32); } }
  float mnC0, mnC1;
  { LAS float* cmax = (LAS float*)(ldsl + L3_S) + 8 * 96 - 16;
    int t_ = tid; asm volatile("" : "+v"(t_));
    const int ck = t_ >> 1, cs = t_ & 1; const char* kp_ = (const char*)Kh + (unsigned)(((SEQ + ck) * LDK + cs * 64) * 2); const u16* kp = (const u16*)kp_; float ss = 0.f;
#pragma unroll
    for (int i = 0; i < 8; ++i) ss += sumsq8(*reinterpret_cast<const bf16x8*>(kp + i * 8));
    ss = fmaxf(ss, swz_xor<2>(ss)); ss = fmaxf(ss, swz_xor<4>(ss)); ss = fmaxf(ss, swz_xor<8>(ss)); ss = fmaxf(ss, swz_xor<16>(ss));
    { auto rr = __builtin_amdgcn_permlane32_swap(__float_as_uint(ss), __float_as_uint(ss), false, false); ss = fmaxf(__uint_as_float(rr[0]), __uint_as_float(rr[1])); }
    if (lane < 2) cmax[wid * 2 + lane] = ss;
    __syncthreads();
    float c0 = cmax[0], c1 = cmax[1];
#pragma unroll
    for (int w = 1; w < 8; ++w) { c0 = fmaxf(c0, cmax[2 * w]); c1 = fmaxf(c1, cmax[2 * w + 1]); }
    const float kb0 = fmaxf(kn2[0], c0), kb1 = fmaxf(kn2[1], c1);
    float qa = 0.f, qb = 0.f;
#pragma unroll
    for (int d0 = 0; d0 < 4; ++d0) { qa += sumsq8(q0[d0]); qb += sumsq8(q1[d0]); }
    { auto rr = __builtin_amdgcn_permlane32_swap(__float_as_uint(qa), __float_as_uint(qa), false, false); qa = __uint_as_float(rr[0]) + __uint_as_float(rr[1]); }
    { auto rr = __builtin_amdgcn_permlane32_swap(__float_as_uint(qb), __float_as_uint(qb), false, false); qb = __uint_as_float(rr[0]) + __uint_as_float(rr[1]); }
    constexpr float C = SCALE * 1.4426950408889634f;
    mnC0 = -sqrtf(qa * kb0) * C * 1.0001f - 1e-6f; mnC1 = -sqrtf(qb * kb1) * C * 1.0001f - 1e-6f;
    __syncthreads(); }
  LAS unsigned char* Qw_l = ldsl + L3_Q + wid * 8192;
#pragma unroll
  for (int d0 = 0; d0 < 4; ++d0) { *(LAS bf16x8*)(Qw_l + kb[d0]) = q0[d0]; *(LAS bf16x8*)(Qw_l + kb[d0] + 128) = q1[d0]; }
  LAS unsigned char* vb0 = ldsl + L3_V + v_rd_base(lane);
  unsigned koff[2], voff[2];
#pragma unroll
  for (int i = 0; i < 2; ++i) { const int L = (wid + 8 * i) * 64 + lane;
    { const int row = L >> 4, pos = L & 15; koff[i] = (unsigned)(row * 1024 + ((pos ^ (row & 7)) << 4)); }
    { const int sub = L >> 5, within = L & 31, kk = (sub >> 2) * 8 + (within >> 2), k = (kk & ~0xC) | ((kk & 4) << 1) | ((kk & 8) >> 1), c = (sub & 3) * 32 + (within & 3) * 8;
      voff[i] = (unsigned)(k * 1024 + c * 2); } }
#define SDMA(ko, vo, k0) do { const char* vg = (const char*)Vh + (size_t)(k0) * (LDK * 2); const char* kg = (const char*)Kh + (size_t)(k0) * (LDK * 2); \
    _Pragma("unroll") for (int i = 0; i < 2; ++i) {                                                                                                  \
      __builtin_amdgcn_global_load_lds((const unsigned*)(kg + i * 32768 + koff[0]), (LAS unsigned*)(ldsl + L3_K + (ko) + (wid + 8 * i) * 1024), 16, 0, 0);      \
      __builtin_amdgcn_global_load_lds((const unsigned*)(vg + i * 32768 + voff[0]), (LAS unsigned*)(ldsl + L3_V + (vo) + (wid + 8 * i) * 1024), 16, 0, 0); } } while (0)
#define VWAIT() asm volatile("s_waitcnt vmcnt(0)" ::: "memory")
#define RESC(o, a) do { if (__any((a) < 1.f)) { if (hi == 0) al_l[r32] = (a); asm volatile("s_waitcnt lgkmcnt(0)" ::: "memory"); \
    _Pragma("unroll") for (int d = 0; d < 4; ++d) _Pragma("unroll") for (int r = 0; r < 16; ++r) o[d][r] *= al_l[crow(r, hi)]; } } while (0)
#define QKH(ko, HF) do { s0 = f32x16{}; s1 = f32x16{}; int kx_ = kb[0]; asm volatile("" : "+v"(kx_));                            \
    _Pragma("unroll") for (int d0 = 0; d0 < 4; ++d0) { const int ka_ = kx_ ^ (d0 << 5);                                     \
      const bf16x8 k0 = *(const LAS bf16x8*)(ldsl + L3_K + (ko) + ka_ + (HF) * 8192);                                      \
      const bf16x8 k1 = *(const LAS bf16x8*)(ldsl + L3_K + (ko) + ka_ + (HF) * 8192 + 128);                                \
      const bf16x8 qa_ = *(const LAS bf16x8*)(Qw_l + ka_); const bf16x8 qb_ = *(const LAS bf16x8*)(Qw_l + ka_ + 128);       \
      s0 = __builtin_amdgcn_mfma_f32_32x32x16_bf16(k0, qa_, s0, 0, 0, 0);                                                  \
      s1 = __builtin_amdgcn_mfma_f32_32x32x16_bf16(k1, qb_, s1, 0, 0, 0); } } while (0)
#define SMBOTH() do { bf16x8 n0a, n0b, n1a, n1b; sm_half_b(s0, mnC0, l0, n0a, n0b); sm_half_b(s1, mnC1, l1, n1a, n1b);               \
    p0a = n0a; p0b = n0b; p1a = n1a; p1b = n1b; } while (0)
#define TR(off) __builtin_amdgcn_ds_read_tr16_b64_v4i16((LAS s16x4v*)(vp_ + (off)))
#define PKV(L, H) (bf16x8){L[0], L[1], L[2], L[3], H[0], H[1], H[2], H[3]}
#define TRD(S, d0, HF) do { S##0 = TR(v_rd_off(d0, 2 * (HF), 0)); S##1 = TR(v_rd_off(d0, 2 * (HF), 1)); S##2 = TR(v_rd_off(d0, 2 * (HF) + 1, 0)); S##3 = TR(v_rd_off(d0, 2 * (HF) + 1, 1)); } while (0)
#define PVD(S, d0) do { const bf16x8 va_ = PKV(S##0, S##1), vb_ = PKV(S##2, S##3);                                          \
    o0[d0] = __builtin_amdgcn_mfma_f32_32x32x16_bf16(p0a, va_, o0[d0], 0, 0, 0); o1[d0] = __builtin_amdgcn_mfma_f32_32x32x16_bf16(p1a, va_, o1[d0], 0, 0, 0); \
    o0[d0] = __builtin_amdgcn_mfma_f32_32x32x16_bf16(p0b, vb_, o0[d0], 0, 0, 0); o1[d0] = __builtin_amdgcn_mfma_f32_32x32x16_bf16(p1b, vb_, o1[d0], 0, 0, 0); } while (0)
#define ROWMAX(p, out) do { float t_ = fmaxf(fmaxf(p[0], p[1]), fmaxf(p[2], p[3]));                                        \
    _Pragma("unroll") for (int r = 4; r < 16; r += 2) t_ = fmaxf(t_, fmaxf(p[r], p[r + 1]));                               \
    auto rr_ = __builtin_amdgcn_permlane32_swap(__float_as_uint(t_), __float_as_uint(t_), false, false);                    \
    out = fmaxf(__uint_as_float(rr_[0]), __uint_as_float(rr_[1])); } while (0)
#define ROWSUM(p, out) do { float q0_ = p[0] + p[1], q1_ = p[2] + p[3], q2_ = p[4] + p[5], q3_ = p[6] + p[7];               \
    q0_ += p[8] + p[9]; q1_ += p[10] + p[11]; q2_ += p[12] + p[13]; q3_ += p[14] + p[15]; float t_ = (q0_ + q1_) + (q2_ + q3_); \
    auto rr_ = __builtin_amdgcn_permlane32_swap(__float_as_uint(t_), __float_as_uint(t_), false, false);                    \
    out = __uint_as_float(rr_[0]) + __uint_as_float(rr_[1]); } while (0)
#define PK4(P, BASE, OUT) do { unsigned a0_ = cvtpk(P[BASE + 0], P[BASE + 1]), a1_ = cvtpk(P[BASE + 2], P[BASE + 3]);       \
    unsigned b0_ = cvtpk(P[BASE + 4], P[BASE + 5]), b1_ = cvtpk(P[BASE + 6], P[BASE + 7]);                                  \
    auto r0_ = __builtin_amdgcn_permlane32_swap(a0_, b0_, false, false); auto r1_ = __builtin_amdgcn_permlane32_swap(a1_, b1_, false, false); \
    u32x4 w_ = {r0_[0], r1_[0], r0_[1], r1_[1]}; OUT = *reinterpret_cast<bf16x8*>(&w_); } while (0)
#define STEP(ko, QHF, vp, PVHF) do { LAS unsigned char* vp_ = (vp); constexpr float C_ = SCALE * 1.4426950408889634f;       \
    s16x4v A0, A1, A2, A3, B0, B1, B2, B3; bf16x8 n0a, n0b, n1a, n1b;                                                       \
    TRD(A, 0, PVHF);                                                                                                        \
    QKH(ko, QHF);                                                                                                           \
    SBAR();                                                                                                                 \
    PVD(A, 0); TRD(B, 1, PVHF);                                                                                             \
    _Pragma("unroll") for (int r = 0; r < 16; ++r) s0[r] = __builtin_amdgcn_exp2f(fmaf(s0[r], C_, mnC0));                   \
    SBAR();                                                                                                                 \
    PVD(B, 1); TRD(A, 2, PVHF);                                                                                             \
    _Pragma("unroll") for (int r = 0; r < 16; ++r) s1[r] = __builtin_amdgcn_exp2f(fmaf(s1[r], C_, mnC1));                   \
    SBAR();                                                                                                                 \
    PVD(A, 2); TRD(B, 3, PVHF);                                                                                             \
    { float ps0, ps1; ROWSUM(s0, ps0); ROWSUM(s1, ps1); l0 += ps0; l1 += ps1; PK4(s0, 0, n0a); PK4(s0, 8, n0b); }            \
    SBAR();                                                                                                                 \
    PVD(B, 3);                                                                                                              \
    { PK4(s1, 0, n1a); PK4(s1, 8, n1b); }                                                                                    \
    SBAR();                                                                                                                 \
    p0a = n0a; p0b = n0b; p1a = n1a; p1b = n1b; } while (0)
  constexpr int NT = NKEY / KVBLK;
  f32x16 s0, s1; bf16x8 p0a, p0b, p1a, p1b;
  SDMA(0, 0, 0); VWAIT(); __syncthreads();
  SDMA(SHM_K, SHM_V, KVBLK);
  QKH(0, 0); SMBOTH();
  int vcur = 0;
  for (int j = 0; j < NT; ++j) {
    const int kcur = (j & 1) * SHM_K, knext = SHM_K - kcur;
    const int vnext = vcur == 2 * SHM_V ? 0 : vcur + SHM_V, vnn = vnext == 2 * SHM_V ? 0 : vnext + SHM_V;
    STEP(kcur, 1, vb0 + vcur, 0);
    VWAIT(); __syncthreads();
    if (j + 2 < NT) SDMA(kcur, vnn, (j + 2) * KVBLK);
    if (j + 1 < NT) { STEP(knext, 0, vb0 + vcur, 1); }
    else pv_all<1>(o0, o1, vb0 + vcur, p0a, p0b, p1a, p1b);
    vcur = vnext;
  }
  int te = tid; asm volatile("" : "+v"(te));
  const int r32e = te & 31; int hi2 = (te >> 5) & 1, yoff = wid * 32 * 1024 + r32e;
  if (hi2 == 0) { li0[r32e] = l0; li1[r32e] = l1; } asm volatile("s_waitcnt lgkmcnt(0)" ::: "memory");
  float gv[4];
#pragma unroll
  for (int d0 = 0; d0 < 4; ++d0) gv[d0] = subg[d0 * 32 + (yoff & 31)] * 0.8f;
#pragma unroll
  for (int r = 0; r < 16; ++r) {
    const int row = crow(r, hi2); const float r0 = 1.0f / li0[row], r1 = lam / li1[row]; float v[4]; float ss = 0.f;
#pragma unroll
    for (int d0 = 0; d0 < 4; ++d0) { v[d0] = o0[d0][r] * r0 - o1[d0][r] * r1; ss += v[d0] * v[d0]; }
    ss += swz_xor<16>(ss); ss += swz_xor<8>(ss); ss += swz_xor<4>(ss); ss += swz_xor<2>(ss); ss += swz_xor<1>(ss);
    const float rs = rsqrtf(ss * (1.0f / 128.0f) + 1e-5f);
    u16* yp = Yb + (yoff + row * 1024);
#pragma unroll
    for (int d0 = 0; d0 < 4; ++d0) yp[d0 * 32] = f2bf(v[d0] * rs * gv[d0]);
  }
  __syncthreads();
#undef SDMA
#undef VWAIT
#undef RESC
#undef QKH
#undef SMBOTH
#undef STEP
#undef TR
#undef PKV
#undef TRD
#undef PVD
#undef ROWMAX
#undef ROWSUM
#undef PK4
}
}


__device__ __forceinline__ void key_norm_pass(const Params& p, int tid, int G, int bx) {
    const u16* K = (const u16*)(p.ws + WS_R2 + R2_K); int* KN = (int*)(p.ws + WS_KN2);
    const int lane = tid & 63, gw = bx * 8 + (tid >> 6), nw = G * 8;
    float mx0 = 0.f, mx1 = 0.f;
    for (int rb = gw; rb < 2 * SEQ; rb += 8 * nw) {
        att::bf16x8 v[8];
#pragma unroll
        for (int k = 0; k < 8; ++k) { const int r = rb + k * nw < 2 * SEQ ? rb + k * nw : rb; v[k] = *reinterpret_cast<const att::bf16x8*>(K + ((size_t)(r >> 14) * NKEY + (r & (SEQ - 1))) * 512 + lane * 8); }
#pragma unroll
        for (int k = 0; k < 8; ++k) { const int r = rb + k * nw < 2 * SEQ ? rb + k * nw : rb;
            float s = att::sumsq8(v[k]); s += att::swz_xor<1>(s); s += att::swz_xor<2>(s); s += att::swz_xor<4>(s);
            if (r >> 14) mx1 = fmaxf(mx1, s); else mx0 = fmaxf(mx0, s); }
    }
    if ((lane & 7) == 0) { if (mx0 > 0.f) atomicMax(KN + (lane >> 3), __float_as_int(mx0)); if (mx1 > 0.f) atomicMax(KN + 8 + (lane >> 3), __float_as_int(mx1)); }
}

__device__ __forceinline__ void attn_phase(const Params& p, char* lds, LAS unsigned char* ldsl, int tid, int G, int bx) {
    const int lane = tid & 63;
    float sa = p.lam[lane] * p.lam[64 + lane], sb = p.lam[128 + lane] * p.lam[192 + lane];
    sa += att::swz_xor<1>(sa); sa += att::swz_xor<2>(sa); sa += att::swz_xor<4>(sa); sa += att::swz_xor<8>(sa); sa += att::swz_xor<16>(sa);
    sb += att::swz_xor<1>(sb); sb += att::swz_xor<2>(sb); sb += att::swz_xor<4>(sb); sb += att::swz_xor<8>(sb); sb += att::swz_xor<16>(sb);
    { auto rr = __builtin_amdgcn_permlane32_swap(__float_as_uint(sa), __float_as_uint(sa), false, false); sa = __uint_as_float(rr[0]) + __uint_as_float(rr[1]); }
    { auto rr = __builtin_amdgcn_permlane32_swap(__float_as_uint(sb), __float_as_uint(sb), false, false); sb = __uint_as_float(rr[0]) + __uint_as_float(rr[1]); }
    const float lam = expf(sa) - expf(sb) + 0.2f;
    const u16* Q = (const u16*)(p.ws + WS_R2 + R2_Q); const u16* K = (const u16*)(p.ws + WS_R2 + R2_K); const u16* V = (const u16*)(p.ws + WS_R2 + R2_V);
    u16* Y = (u16*)(p.ws + WS_U);
#if ATT_V1
    for (int i = bx; i < 1024; i += G) {
        const int bh = i & 7, qblk = i >> 3, b = bh >> 2, h = bh & 3;
        att::diff_attn_unit(Q + ((size_t)b * SEQ + (size_t)qblk * 128) * 512 + h * 128, K + (size_t)b * NKEY * 512 + h * 128, V + (size_t)b * NKEY * 512 + h * 128,
                            Y + ((size_t)b * SEQ + (size_t)qblk * 128) * 1024 + 512 + h * 128, lam, p.subln_g, lds);
    }
#elif ATT_V2
    for (int i = bx; i < 512; i += G) {
        const int bh = i & 7, qblk = i >> 3, b = bh >> 2, h = bh & 3;
        att::diff_attn_unit2(Q + ((size_t)b * SEQ + (size_t)qblk * 256) * 512 + h * 128, K + (size_t)b * NKEY * 512 + h * 128, V + (size_t)b * NKEY * 512 + h * 128,
                             Y + ((size_t)b * SEQ + (size_t)qblk * 256) * 1024 + 512 + h * 128, lam, p.subln_g, (const float*)(p.ws + WS_KN2) + bh * 2, lds, ldsl);
    }
#elif ATT_V4
    for (int i = bx; i < 512; i += G) {
        const int bh = i & 7, qblk = i >> 3, b = bh >> 2, h = bh & 3;
        att::diff_attn_unit4(Q + ((size_t)b * SEQ + (size_t)qblk * 256) * 512 + h * 128, K + (size_t)b * NKEY * 512 + h * 128, V + (size_t)b * NKEY * 512 + h * 128,
                             Y + ((size_t)b * SEQ + (size_t)qblk * 256) * 1024 + 512 + h * 128, lam, p.subln_g, (const float*)(p.ws + WS_KN2) + bh * 2, ldsl);
    }
#else
    for (int i = bx; i < 512; i += G) {
        const int bh = i & 7, qblk = i >> 3, b = bh >> 2, h = bh & 3;
        att::diff_attn_unit3(Q + ((size_t)b * SEQ + (size_t)qblk * 256) * 512 + h * 128, K + (size_t)b * NKEY * 512 + h * 128, V + (size_t)b * NKEY * 512 + h * 128,
                             Y + ((size_t)b * SEQ + (size_t)qblk * 256) * 1024 + 512 + h * 128, lam, p.subln_g, ldsl);
    }
#endif
}

#define UNPK8(d, V_) do { const u32x4 q_ = (V_); d[0] = __uint_as_float(q_.x << 16); d[1] = __uint_as_float(q_.x & 0xffff0000u); d[2] = __uint_as_float(q_.y << 16); d[3] = __uint_as_float(q_.y & 0xffff0000u); \
    d[4] = __uint_as_float(q_.z << 16); d[5] = __uint_as_float(q_.z & 0xffff0000u); d[6] = __uint_as_float(q_.w << 16); d[7] = __uint_as_float(q_.w & 0xffff0000u); } while (0)
__device__ __forceinline__ void hy_t1(const Params& p, float* ldsf, int tid, int G, int bx) {
    const u16* Z = (const u16*)(p.ws + WS_R2 + R2_Z); float* W = (float*)(p.ws + WS_W);
    constexpr int BUF = 8704;
    u32x4 w[3];
#define T1_LOAD(it_) do { const int cb_ = (it_) & 7, tb_ = ((it_) >> 3) & 255, b_ = (it_) >> 11, t0_ = tb_ * 64, c0_ = cb_ * 64;                  \
        _Pragma("unroll") for (int k = 0; k < 3; ++k) { const int e = tid + 512 * k, piece = e & 7, seg = e >> 3, tensor = seg & 1, row = seg >> 1, t = t0_ - 1 + row; \
            w[k] = (e < 1056 && t >= 0 && t < SEQ) ? *(const u32x4*)(Z + ((size_t)b_ * SEQ + t) * 1536 + 512 + tensor * 512 + c0_ + piece * 8) : (u32x4){0u, 0u, 0u, 0u}; } } while (0)
#define T1_STORE(buf_) do { _Pragma("unroll") for (int k = 0; k < 3; ++k) { const int e = tid + 512 * k, piece = e & 7, seg = e >> 3, tensor = seg & 1, row = seg >> 1; \
            if (e < 1056) { float* d = (buf_) + tensor * (66 * 65) + row * 65 + piece * 8; UNPK8(d, w[k]); } } } while (0)
    int it = bx, cur = 0;
    if (it < 4096) { T1_LOAD(it); T1_STORE(ldsf); }
    __syncthreads();
    for (; it < 4096; it += G) {
        const int nxt = it + G;
        if (nxt < 4096) T1_LOAD(nxt);
        const int cb = it & 7, tb = (it >> 3) & 255, b = it >> 11, t0 = tb * 64, c0 = cb * 64;
        const float* lb = ldsf + cur * BUF;
        const int t = tid & 63, cg8 = tid >> 6;
#pragma unroll
        for (int i = 0; i < 8; ++i) { const int c = cg8 * 8 + i, ch1 = 512 + c0 + c, chv = 1024 + c0 + c;
            const float* a = lb + t * 65 + c; const float* v = a + 66 * 65;
            const float x1 = a[0] * p.conv_w[ch1] + a[65] * p.conv_w[1536 + ch1] + a[130] * p.conv_w[3072 + ch1] + p.conv_b[ch1];
            const float xv = v[0] * p.conv_w[chv] + v[65] * p.conv_w[1536 + chv] + v[130] * p.conv_w[3072 + chv] + p.conv_b[chv];
            W[((size_t)(c0 + c) * 2 + b) * SEQ + t0 + t] = x1 * xv; }
        if (nxt < 4096) T1_STORE(ldsf + (cur ^ 1) * BUF);
        __syncthreads();
        cur ^= 1;
    }
#undef T1_LOAD
#undef T1_STORE
}
__device__ __forceinline__ void hy_t2(const Params& p, float* ldsf, int tid, int G, int bx) {
    const u16* Z = (const u16*)(p.ws + WS_R2 + R2_Z); const float* W = (const float*)(p.ws + WS_W); u16* Y = (u16*)(p.ws + WS_U);
    constexpr int BUF = 8704;
    u32x4 w[2]; float yv[8];
#define T2_LOAD(it_) do { const int cb_ = (it_) & 7, tb_ = ((it_) >> 3) & 255, b_ = (it_) >> 11, t0_ = tb_ * 64, c0_ = cb_ * 64;                  \
        _Pragma("unroll") for (int k = 0; k < 2; ++k) { const int e = tid + 512 * k, piece = e & 7, row = e >> 3, t = t0_ - 1 + row;             \
            w[k] = (e < 528 && t >= 0 && t < SEQ) ? *(const u32x4*)(Z + ((size_t)b_ * SEQ + t) * 1536 + c0_ + piece * 8) : (u32x4){0u, 0u, 0u, 0u}; } \
        _Pragma("unroll") for (int i = 0; i < 8; ++i) yv[i] = W[((size_t)(c0_ + (tid >> 6) * 8 + i) * 2 + b_) * SEQ + t0_ + (tid & 63)]; } while (0)
#define T2_STORE(buf_) do { _Pragma("unroll") for (int k = 0; k < 2; ++k) { const int e = tid + 512 * k, piece = e & 7, row = e >> 3;           \
            if (e < 528) { float* d = (buf_) + row * 65 + piece * 8; UNPK8(d, w[k]); } }                                                       \
        _Pragma("unroll") for (int i = 0; i < 8; ++i) (buf_)[66 * 65 + ((tid >> 6) * 8 + i) * 65 + (tid & 63)] = yv[i]; } while (0)
    int it = bx, cur = 0;
    if (it < 4096) { T2_LOAD(it); T2_STORE(ldsf); }
    __syncthreads();
    for (; it < 4096; it += G) {
        const int nxt = it + G;
        if (nxt < 4096) T2_LOAD(nxt);
        const int cb = it & 7, tb = (it >> 3) & 255, b = it >> 11, t0 = tb * 64, c0 = cb * 64;
        const float* lb = ldsf + cur * BUF; const float* ly = lb + 66 * 65;
        const int c = tid & 63, tg = tid >> 6, ch0 = c0 + c;
        const float w0 = p.conv_w[ch0], w1 = p.conv_w[1536 + ch0], w2 = p.conv_w[3072 + ch0], bb = p.conv_b[ch0];
#pragma unroll
        for (int i = 0; i < 8; ++i) { const int t = tg * 8 + i; const float* a = lb + t * 65 + c;
            const float x0 = a[0] * w0 + a[65] * w1 + a[130] * w2 + bb;
            Y[((size_t)b * SEQ + t0 + t) * 1024 + ch0] = f2bf(x0 * ly[c * 65 + t]); }
        if (nxt < 4096) T2_STORE(ldsf + (cur ^ 1) * BUF);
        __syncthreads();
        cur ^= 1;
    }
#undef T2_LOAD
#undef T2_STORE
}

__device__ __forceinline__ int fsw(int i) { return i ^ ((i >> 5) & 3) ^ (((i >> 6) & 7) << 2); }
struct FftTw { float2 a1[8], b1[2], a2[4], b2, a3[4], b3; };
__device__ __forceinline__ void fft_load_tw(FftTw& T, const float2* __restrict__ tw, int tid) {
#pragma unroll
    for (int b = 0; b < 4; ++b) { T.a1[2 * b] = tw[b * 1024 + tid]; T.a1[2 * b + 1] = tw[b * 1024 + tid + 512];
        T.a2[b] = tw[b * 1024 + (tid & 63) * 16]; T.a3[b] = tw[b * 1024 + (tid & 3) * 256]; }
    T.b1[0] = tw[tid * 4]; T.b1[1] = tw[(tid + 512) * 4]; T.b2 = tw[(tid & 63) * 64]; T.b3 = tw[(tid & 3) * 1024];
}
__device__ __forceinline__ void bf4_fwd(float2& a0, float2& a1, float2& a2, float2& a3, float2 w1) {
    const float2 w2 = cmul(w1, w1), w3 = cmul(w2, w1);
    const float2 s02 = make_float2(a0.x + a2.x, a0.y + a2.y), d02 = make_float2(a0.x - a2.x, a0.y - a2.y);
    const float2 s13 = make_float2(a1.x + a3.x, a1.y + a3.y), d13 = make_float2(a1.x - a3.x, a1.y - a3.y);
    a0 = make_float2(s02.x + s13.x, s02.y + s13.y);
    a1 = cmul(make_float2(d02.x + d13.y, d02.y - d13.x), w1);
    a2 = cmul(make_float2(s02.x - s13.x, s02.y - s13.y), w2);
    a3 = cmul(make_float2(d02.x - d13.y, d02.y + d13.x), w3);
}
__device__ __forceinline__ void bf4_inv(float2& a0, float2& a1, float2& a2, float2& a3, float2 w1  ) {
    const float2 w2 = cmul(w1, w1), w3 = cmul(w2, w1);
    const float2 b1 = cmul(a1, w1), b2 = cmul(a2, w2), b3 = cmul(a3, w3);
    const float2 s02 = make_float2(a0.x + b2.x, a0.y + b2.y), d02 = make_float2(a0.x - b2.x, a0.y - b2.y);
    const float2 s13 = make_float2(b1.x + b3.x, b1.y + b3.y), d13 = make_float2(b1.x - b3.x, b1.y - b3.y);
    a0 = make_float2(s02.x + s13.x, s02.y + s13.y);
    a1 = make_float2(d02.x - d13.y, d02.y + d13.x);
    a2 = make_float2(s02.x - s13.x, s02.y - s13.y);
    a3 = make_float2(d02.x + d13.y, d02.y - d13.x);
}
template <int QB, int SHB, bool INV, int PAIR> __device__ __forceinline__ void fft_pair(float2* d, const FftTw& T, int tid_) {
    int tid = tid_; asm volatile("" : "+v"(tid));
    float2 wa[2][4], wb[2];
#pragma unroll
    for (int i = 0; i < 2; ++i) {
#pragma unroll
        for (int b = 0; b < 4; ++b) wa[i][b] = PAIR == 1 ? T.a1[2 * b + i] : (PAIR == 2 ? T.a2[b] : T.a3[b]);
        wb[i] = PAIR == 1 ? T.b1[i] : (PAIR == 2 ? T.b2 : T.b3); }
    asm volatile("" : "+v"(wa[0][0].x), "+v"(wa[0][0].y), "+v"(wa[0][1].x), "+v"(wa[0][1].y), "+v"(wa[0][2].x), "+v"(wa[0][2].y), "+v"(wa[0][3].x), "+v"(wa[0][3].y), "+v"(wb[0].x), "+v"(wb[0].y));
    if (PAIR == 1) asm volatile("" : "+v"(wa[1][0].x), "+v"(wa[1][0].y), "+v"(wa[1][1].x), "+v"(wa[1][1].y), "+v"(wa[1][2].x), "+v"(wa[1][2].y), "+v"(wa[1][3].x), "+v"(wa[1][3].y), "+v"(wb[1].x), "+v"(wb[1].y));
#pragma unroll
    for (int i = 0; i < 2; ++i) {
        const int ii = PAIR == 1 ? i : 0;
        const int G = tid + 512 * i, j = G & (QB - 1), g = G >> SHB, base = g * 16 * QB + j;
        float2 x[4][4];
#pragma unroll
        for (int a = 0; a < 4; ++a)
#pragma unroll
            for (int b = 0; b < 4; ++b) x[a][b] = d[fsw(base + (4 * a + b) * QB)];
        if (!INV) {
#pragma unroll
            for (int b = 0; b < 4; ++b) bf4_fwd(x[0][b], x[1][b], x[2][b], x[3][b], wa[ii][b]);
#pragma unroll
            for (int a = 0; a < 4; ++a) bf4_fwd(x[a][0], x[a][1], x[a][2], x[a][3], wb[ii]);
        } else {
#pragma unroll
            for (int a = 0; a < 4; ++a) bf4_inv(x[a][0], x[a][1], x[a][2], x[a][3], make_float2(wb[ii].x, -wb[ii].y));
#pragma unroll
            for (int b = 0; b < 4; ++b) bf4_inv(x[0][b], x[1][b], x[2][b], x[3][b], make_float2(wa[ii][b].x, -wa[ii][b].y));
        }
#pragma unroll
        for (int a = 0; a < 4; ++a)
#pragma unroll
            for (int b = 0; b < 4; ++b) d[fsw(base + (4 * a + b) * QB)] = x[a][b];
    }
    __syncthreads();
}
template <bool INV, int MODE> __device__ __forceinline__ void fft_q1(float2* d, int tid_, float2* __restrict__ KS) {
    int tid = tid_; asm volatile("" : "+v"(tid));
#pragma unroll
    for (int h = 0; h < 2; ++h) {
        float2 ks[4][4];
        if (MODE == 2) {
#pragma unroll
            for (int i = 0; i < 4; ++i) { const float4* kp = (const float4*)(KS + (tid + 512 * (4 * h + i)) * 4); const float4 k01 = kp[0], k23 = kp[1];
                ks[i][0] = make_float2(k01.x, k01.y); ks[i][1] = make_float2(k01.z, k01.w); ks[i][2] = make_float2(k23.x, k23.y); ks[i][3] = make_float2(k23.z, k23.w); } }
#pragma unroll
        for (int i = 0; i < 4; ++i) {
            const int i0 = (tid + 512 * (4 * h + i)) * 4, p0 = fsw(i0), p1 = fsw(i0 + 1), p2 = fsw(i0 + 2), p3 = fsw(i0 + 3);
            const float2 a0 = d[p0], a1 = d[p1], a2 = d[p2], a3 = d[p3];
            const float2 s02 = make_float2(a0.x + a2.x, a0.y + a2.y), d02 = make_float2(a0.x - a2.x, a0.y - a2.y);
            const float2 s13 = make_float2(a1.x + a3.x, a1.y + a3.y), d13 = make_float2(a1.x - a3.x, a1.y - a3.y);
            float2 u0 = make_float2(s02.x + s13.x, s02.y + s13.y), u2 = make_float2(s02.x - s13.x, s02.y - s13.y), u1, u3;
            if (!INV) { u1 = make_float2(d02.x + d13.y, d02.y - d13.x); u3 = make_float2(d02.x - d13.y, d02.y + d13.x); }
            else      { u1 = make_float2(d02.x - d13.y, d02.y + d13.x); u3 = make_float2(d02.x + d13.y, d02.y - d13.x); }
            if (MODE == 1) { float4* kp = (float4*)(KS + i0); kp[0] = make_float4(u0.x, u0.y, u1.x, u1.y); kp[1] = make_float4(u2.x, u2.y, u3.x, u3.y); }
            else {
                if (MODE == 2) { u0 = cmul(u0, ks[i][0]); u1 = cmul(u1, ks[i][1]); u2 = cmul(u2, ks[i][2]); u3 = cmul(u3, ks[i][3]); }
                d[p0] = u0; d[p1] = u1; d[p2] = u2; d[p3] = u3; }
        }
    }
    __syncthreads();
}
template <bool INV, int MODE> __device__ __forceinline__ void fft16k(float2* d, const FftTw& T, int tid, float2* KS) {
    if (!INV) { fft_pair<1024, 10, false, 1>(d, T, tid); fft_pair<64, 6, false, 2>(d, T, tid); fft_pair<4, 2, false, 3>(d, T, tid); fft_q1<false, MODE>(d, tid, KS); }
    else      { fft_q1<true, 0>(d, tid, KS); fft_pair<4, 2, true, 3>(d, T, tid); fft_pair<64, 6, true, 2>(d, T, tid); fft_pair<1024, 10, true, 1>(d, T, tid); }
}

__device__ __forceinline__ void hy_fft(const Params& p, float2* d, int tid, int G, int bx, bool dummy) {
    const u16* HF = (const u16*)(p.ws + WS_HFILT); float* W = (float*)(p.ws + WS_W); const float2* tw = (const float2*)(p.ws + WS_TW); const float2* OM = (const float2*)(p.ws + WS_OM);
    float2* KS = (float2*)(p.ws + WS_SCR + (size_t)bx * 262144); float2* P1 = KS + SEQ;
    FftTw T; fft_load_tw(T, tw, tid);
    for (int c = bx; c < 512; c += G) {
        const float bias = p.hy_bias[c];
        float* W0 = W + (size_t)(c * 2) * SEQ; float* W1 = W0 + SEQ;
        const u16* HFf = HF + (size_t)c * SEQ; const u16* HFb = HF + (size_t)(512 + c) * SEQ;
        for (int pass = 0; pass < 2; ++pass) {
            { int t_ = tid; asm volatile("" : "+v"(t_));
              for (int k0 = 0; k0 < 32; k0 += 8) {
                u16 hf[8], hb[8]; float2 om[8];
#pragma unroll
                for (int k = 0; k < 8; ++k) { const int n = t_ + 512 * (k0 + k); hf[k] = HFf[n]; hb[k] = HFb[(SEQ - n) & (SEQ - 1)]; om[k] = pass ? OM[n] : make_float2(1.f, 0.f); }
#pragma unroll
                for (int k = 0; k < 8; ++k) { const int n = t_ + 512 * (k0 + k); const float f = bf2f(hf[k]), g = n ? bf2f(hb[k]) : 0.f;
                    const float kv = pass ? (f - g) : (f + g); d[fsw(n)] = make_float2(kv * om[k].x, kv * om[k].y); }
              } }
            __syncthreads();
            fft16k<false, 1>(d, T, tid, KS);
            { int t_ = tid; asm volatile("" : "+v"(t_));
              for (int k0 = 0; k0 < 32; k0 += 8) {
                float w0[8], w1[8]; float2 om[8];
#pragma unroll
                for (int k = 0; k < 8; ++k) { const int n = t_ + 512 * (k0 + k); w0[k] = W0[n]; w1[k] = W1[n]; om[k] = pass ? OM[n] : make_float2(1.f, 0.f); }
#pragma unroll
                for (int k = 0; k < 8; ++k) { const int n = t_ + 512 * (k0 + k); d[fsw(n)] = cmul(make_float2(w0[k], w1[k]), om[k]); }
              } }
            __syncthreads();
            fft16k<false, 2>(d, T, tid, KS);
            fft16k<true, 0>(d, T, tid, KS);
            { int t_ = tid; asm volatile("" : "+v"(t_));
              if (pass == 0 || dummy) {
#pragma unroll 8
                for (int k = 0; k < 32; ++k) { const int n = t_ + 512 * k; float2 r = d[fsw(n)]; r.x *= (1.0f / SEQ); r.y *= (1.0f / SEQ); P1[n] = r; }
              } else {
                for (int k0 = 0; k0 < 32; k0 += 8) {
                    float w0[8], w1[8]; float2 om[8], p1[8];
#pragma unroll
                    for (int k = 0; k < 8; ++k) { const int n = t_ + 512 * (k0 + k); w0[k] = W0[n]; w1[k] = W1[n]; om[k] = OM[n]; p1[k] = P1[n]; }
#pragma unroll
                    for (int k = 0; k < 8; ++k) { const int n = t_ + 512 * (k0 + k); float2 r = d[fsw(n)]; r.x *= (1.0f / SEQ); r.y *= (1.0f / SEQ);
                        r = cmul(r, make_float2(om[k].x, -om[k].y));
                        W0[n] = 0.5f * (p1[k].x + r.x) + bias * w0[k]; W1[n] = 0.5f * (p1[k].y + r.y) + bias * w1[k]; }
                } } }
            __syncthreads();
        }
    }
}

__global__ void __launch_bounds__(512, 1) mega(Params p) {
    extern __shared__ __attribute__((aligned(16))) unsigned char lds[];
    cg::grid_group grid = cg::this_grid();
    const int tid = threadIdx.x, G = gridDim.x, bx = blockIdx.x;
    float* ldsf = (float*)lds;
    LAS unsigned char* ldsl = (LAS unsigned char*)lds;
    const int lo = p.ph_lo, hi = p.ph_hi;
    if (p.ph_hi > 1000) grid.sync();
    if (tid < 4) ((unsigned*)(lds + LDS_MAIN))[tid] = 0u;
    __syncthreads();
    XcdBarrier xbar = xcd_barrier_post((unsigned*)(p.ws + WS_BAR), (volatile XB_LAS unsigned*)(ldsl + LDS_MAIN));
#define mod ((const float*)(p.ws + WS_MOD))
#define U ((u16*)(p.ws + WS_U))
#define HID ((u16*)(p.ws + WS_R2))
#define HCTX ((float*)(p.ws + WS_HCTX))
#ifndef PHMASK
#define PHMASK 0xFFFF
#endif
#define IN(k) (((PHMASK >> (k)) & 1) && lo <= (k) && (k) < hi)
#ifndef PROBE_REP_MASK
#define PROBE_REP_MASK 0
#endif
#ifndef ATT_V1
#define ATT_V1 0
#endif
#ifndef PROBE_FFT
#define PROBE_FFT 0
#endif
#ifndef PROBE_SYNC
#define PROBE_SYNC 0
#endif
#define REPS(k) _Pragma("nounroll") for (int rep_ = 0; rep_ < 1 + ((PROBE_REP_MASK >> (k)) & 1); ++rep_)
#define SYNC(k) do { if (lo <= (k) && (k) + 1 < hi) { xcd_barrier(xbar); } } while (0)
    if (IN(0)) REPS(0) phase_prep(p, ldsf, tid, G, bx);
    SYNC(0);
    if (IN(1)) REPS(1) { adaln_rows(p, p.x, p.ctx, 0, MROWS, 0, 0, 1, U, HCTX, tid, G, bx); hfilt_items(p, ldsf, tid, G, bx); }
    SYNC(1);
    if (IN(2)) { pg8::Gemm g{U, (const u16*)(p.ws + WS_WB0), MROWS, 2 * FF, DM, DM}; pg8::StaticOrder S; S.init(MROWS, 2 * FF, G, bx); S.dsh = (PROBE_REP_MASK >> 2) & 1; EpiSwiGLU E{HID};
        pg8::gemm_phase<EpiSwiGLU, pg8::StaticOrder>(ldsl, g, S, E, nullptr); }
    SYNC(2);
    if (IN(3)) { pg8::Gemm g{HID, (const u16*)(p.ws + WS_WD0), NLAT, DM, FF, FF}; pg8::StaticOrder S; S.init(NLAT, DM, G, bx); S.dsh = (PROBE_REP_MASK >> 3) & 1; EpiResid E{p.x, p.ctx, p.out, HCTX, mod, 2, 0.5f};
        pg8::gemm_phase<EpiResid, pg8::StaticOrder>(ldsl, g, S, E, nullptr); }
    SYNC(3);
    if (IN(4)) { adaln_rows(p, p.out, HCTX, 0, NLAT, 1, 3, 4, U, nullptr, tid, G, bx);
        pg8::Gemm g{HID, (const u16*)(p.ws + WS_WD0), MROWS, DM, 256, FF}; CtxSplitOrder S{G, bx}; EpiCtxAtomic E{HCTX, mod, 2, 0.5f};
        pg8::gemm_phase<EpiCtxAtomic, CtxSplitOrder>(ldsl, g, S, E, nullptr); }
    SYNC(4);
    if (IN(5)) { pg8::Gemm g{U, (const u16*)(p.ws + WS_WIN), NLAT, DIN, DM, DM}; pg8::StaticOrder S; S.init(NLAT, DIN, G, bx); S.dsh = (PROBE_REP_MASK >> 5) & 1;
        EpiInProj E{(u16*)(p.ws + WS_R2 + R2_Z), (u16*)(p.ws + WS_R2 + R2_Q), (u16*)(p.ws + WS_R2 + R2_K), (u16*)(p.ws + WS_R2 + R2_V), (const float*)(p.ws + WS_ROPE)};
        pg8::gemm_phase<EpiInProj, pg8::StaticOrder>(ldsl, g, S, E, nullptr);
        adaln_rows(p, p.out, HCTX, NLAT, MROWS, 1, 3, 4, U, nullptr, tid, G, bx); }
    SYNC(5);
    if (IN(6)) { hy_t1(p, ldsf, tid, G, bx); key_norm_pass(p, tid, G, bx);
        pg8::Gemm g{U, (const u16*)(p.ws + WS_WIN), MROWS, DIN, DM, DM}; CtxKvOrder S{G, bx};
        EpiInProj E{(u16*)(p.ws + WS_R2 + R2_Z), (u16*)(p.ws + WS_R2 + R2_Q), (u16*)(p.ws + WS_R2 + R2_K), (u16*)(p.ws + WS_R2 + R2_V), (const float*)(p.ws + WS_ROPE)};
        pg8::gemm_phase<EpiInProj, CtxKvOrder>(ldsl, g, S, E, nullptr); }
    SYNC(6);
    if (IN(7)) {
#ifndef NO_ATT
        REPS(7) attn_phase(p, (char*)lds, ldsl, tid, G, bx);
#endif
#ifndef NO_FFT
#if PROBE_FFT
        hy_fft(p, (float2*)lds, tid, G, bx, true);
#endif
        hy_fft(p, (float2*)lds, tid, G, bx, false);
#endif
#if PROBE_SYNC
        for (int i_ = 0; i_ < 10; ++i_) grid.sync();
#endif
    }
    SYNC(7);
    if (IN(8)) REPS(8) hy_t2(p, ldsf, tid, G, bx);
    SYNC(8);
    if (IN(9)) { pg8::Gemm g{U, (const u16*)(p.ws + WS_WOUT), NLAT, DM, DM, DM}; pg8::StaticOrder S; S.init(NLAT, DM, G, bx); EpiResid E{p.out, p.out, p.out, p.out, mod, 5, 1.0f};
        pg8::gemm_phase<EpiResid, pg8::StaticOrder>(ldsl, g, S, E, nullptr); }
    SYNC(9);
    if (IN(10)) adaln_rows(p, p.out, HCTX, 0, NLAT, 2, 6, 7, U, nullptr, tid, G, bx);
    SYNC(10);
    if (IN(11)) { pg8::Gemm g{U, (const u16*)(p.ws + WS_WB1), NLAT, 2 * FF, DM, DM}; pg8::StaticOrder S; S.init(NLAT, 2 * FF, G, bx); S.dsh = (PROBE_REP_MASK >> 11) & 1; EpiSwiGLU E{HID};
        pg8::gemm_phase<EpiSwiGLU, pg8::StaticOrder>(ldsl, g, S, E, nullptr); }
    SYNC(11);
    if (IN(12)) { pg8::Gemm g{HID, (const u16*)(p.ws + WS_WD1), NLAT, DM, FF, FF}; pg8::StaticOrder S; S.init(NLAT, DM, G, bx); EpiResid E{p.out, p.out, p.out, p.out, mod, 8, 0.5f};
        pg8::gemm_phase<EpiResid, pg8::StaticOrder>(ldsl, g, S, E, nullptr); }
    SYNC(12);
    if (IN(13)) final_norm(p, tid, G, bx);
#undef IN
#undef SYNC
#undef mod
#undef U
#undef HID
#undef HCTX
}

extern "C" void kernel_launch(void* const* d_in, const int* in_sizes, int n_in, void* d_out, int out_size, void* d_ws, size_t ws_size, hipStream_t stream) {
    static int grid = 0;
    if (grid == 0) {
        if (n_in != 24 || ws_size < WS_END) { fprintf(stderr, "kernel_launch: n_in %d ws %zu (need %zu)\n", n_in, ws_size, (size_t)WS_END); grid = -1; return; }
        int dev = 0, cus = 0, per_cu = 0;
        hipGetDevice(&dev); hipDeviceGetAttribute(&cus, hipDeviceAttributeMultiprocessorCount, dev);
        if (hipFuncSetAttribute((const void*)mega, hipFuncAttributeMaxDynamicSharedMemorySize, LDS_BYTES) != hipSuccess) { fprintf(stderr, "kernel_launch: hipFuncSetAttribute failed\n"); grid = -1; return; }
        if (hipOccupancyMaxActiveBlocksPerMultiprocessor(&per_cu, (const void*)mega, 512, LDS_BYTES) != hipSuccess || per_cu < 1) { fprintf(stderr, "kernel_launch: occupancy query gives %d\n", per_cu); per_cu = 1; }
        (void)hipGetLastError();
        grid = cus * per_cu; if (grid > 256) grid = 256;
    }
    if (grid < 0) return;
    Params p{};
    const float** pp = (const float**)&p;
    for (int i = 0; i < 24; ++i) pp[i] = (const float*)d_in[i];
    p.out = (float*)d_out; p.ws = (unsigned char*)d_ws;
#if MULTI_LAUNCH
    for (int ph = 0; ph < NPHASE; ++ph) { p.ph_lo = ph; p.ph_hi = ph + 1; hipLaunchKernelGGL(mega, dim3(grid), dim3(512), LDS_BYTES, stream, p); }
#else
    p.ph_lo = 0; p.ph_hi = NPHASE;
    if (hipMemsetAsync((char*)d_ws + WS_BAR, 0, (size_t)XCD_BAR_WORDS * 4, stream) != hipSuccess) { fprintf(stderr, "kernel_launch: memset failed\n"); return; }
    void* args[] = {&p};
    hipError_t e = hipLaunchCooperativeKernel((const void*)mega, dim3(grid), dim3(512), args, LDS_BYTES, stream);
    if (e != hipSuccess) fprintf(stderr, "cooperative launch failed: %s (grid %d)\n", hipGetErrorString(e), grid);
#endif
}
```
